# Optimizing an MI355X kernel written in HIP

```python
import jax, jax.numpy as jnp
from jax import lax
import numpy as np

D_MODEL = 1024
BATCH = 16
SEQ = 4096
DEPTH = 2
DEC_BATCH = 32
DEC_SEQ = 64
PAST_LEN = 4096

CHUNK = 64
N_MIXERS = 2
N_POOL_LAYERS = (DEPTH + 1) // 2
N_GDN_LAYERS = DEPTH // 2
EPS = 1e-6

POOL_EXPAND = 2
POOL_WIDTH = POOL_EXPAND * D_MODEL
POOL_WINDOWS = (2, 4, 8, 16)
N_POOL_GROUPS = len(POOL_WINDOWS)
POOL_GROUP_DIM = POOL_WIDTH // N_POOL_GROUPS
POOL_BUF = max(POOL_WINDOWS) - 1

GDN_HEAD_DIM = 128
GDN_QK_HEADS = D_MODEL // GDN_HEAD_DIM
GDN_V_HEADS = 2 * GDN_QK_HEADS
GDN_KEY_DIM = GDN_QK_HEADS * GDN_HEAD_DIM
GDN_VALUE_DIM = GDN_V_HEADS * GDN_HEAD_DIM
GDN_CONV_DIM = 2 * GDN_KEY_DIM + GDN_VALUE_DIM
GDN_CONV_WIDTH = 4
GDN_IN_DIM = GDN_CONV_DIM + GDN_VALUE_DIM + 2 * GDN_V_HEADS

kernel_name = 'hybrid_pool_gdn_streaming_step'


def _rmsnorm(x, gain):
    xf = x.astype(jnp.float32)
    r = lax.rsqrt(jnp.mean(xf * xf, axis=-1, keepdims=True) + EPS)
    return xf * r * gain.astype(jnp.float32)


def _l2norm(x):
    xf = x.astype(jnp.float32)
    return xf * lax.rsqrt(jnp.sum(xf * xf, axis=-1, keepdims=True) + EPS)


def _pool_mixer(h, buf, start, w_in, w_group, scale, w_out):
    bsz, seqlen, _ = h.shape
    proj = h @ w_in
    u, z = proj[..., :POOL_WIDTH], proj[..., POOL_WIDTH:]
    ext = jnp.concatenate([buf.astype(u.dtype), u], axis=1)
    cs = jnp.cumsum(ext.astype(jnp.float32), axis=1)
    cs = jnp.pad(cs, ((0, 0), (1, 0), (0, 0)))
    pos = (start + jnp.arange(seqlen)).astype(jnp.float32)
    p = POOL_BUF
    pooled = []
    for gi, w in enumerate(POOL_WINDOWS):
        lo, hi = gi * POOL_GROUP_DIM, (gi + 1) * POOL_GROUP_DIM
        wsum = cs[:, p + 1:p + 1 + seqlen, lo:hi] - cs[:, p + 1 - w:p + 1 - w + seqlen, lo:hi]
        cnt = jnp.minimum(pos + 1.0, float(w))
        pooled.append(wsum / cnt[None, :, None])
    pooled = jnp.concatenate(pooled, axis=-1)
    d = (pooled - u.astype(jnp.float32)).reshape(bsz, seqlen, N_POOL_GROUPS, POOL_GROUP_DIM)
    y = jnp.einsum('blgc,gcd->blgd', d, w_group.astype(jnp.float32)).reshape(bsz, seqlen, POOL_WIDTH)
    y = y * scale.astype(jnp.float32) * jax.nn.silu(z.astype(jnp.float32))
    out = y.astype(h.dtype) @ w_out
    return out, ext[:, -POOL_BUF:]


def _chunked_gated_delta(q, k, v, g, beta, s0):
    bsz, seqlen, nh, dk = q.shape
    dv = v.shape[-1]
    c = min(CHUNK, seqlen)
    n = seqlen // c
    f32 = jnp.float32

    def blk(t):
        return t.astype(f32).reshape(bsz, n, c, nh, t.shape[-1]).transpose(0, 3, 1, 2, 4)

    qb, kb_, vb = blk(q), blk(k), blk(v)
    gb = g.astype(f32).reshape(bsz, n, c, nh).transpose(0, 3, 1, 2)
    bb = beta.astype(f32).reshape(bsz, n, c, nh).transpose(0, 3, 1, 2)
    gc = jnp.cumsum(gb, axis=-1)
    idx = jnp.arange(c)
    incl = idx[:, None] >= idx[None, :]
    strict = idx[:, None] > idx[None, :]
    diff = gc[..., :, None] - gc[..., None, :]
    decay = jnp.where(incl, jnp.exp(jnp.where(incl, diff, 0.0)), 0.0)
    kbeta = kb_ * bb[..., None]
    lmat = jnp.where(strict, jnp.einsum('bhncd,bhnjd->bhncj', kbeta, kb_) * decay, 0.0)
    rhs = jnp.concatenate([vb * bb[..., None], kbeta * jnp.exp(gc)[..., None]], axis=-1)
    sol = lax.linalg.triangular_solve(lmat, rhs, left_side=True, lower=True, unit_diagonal=True)
    value, kcd = sol[..., :dv], sol[..., dv:]
    aqk = jnp.einsum('bhncd,bhnjd->bhncj', qb, kb_) * decay
    qdec = qb * jnp.exp(gc)[..., None]
    glast = gc[..., -1]
    kdec = kb_ * jnp.exp(glast[..., None] - gc)[..., None]
    xs = tuple(jnp.moveaxis(t, 2, 0) for t in (value, kcd, aqk, qdec, kdec, glast))

    def step(s, inp):
        val, kc, a, qd, kd, gl = inp
        v_new = val - jnp.einsum('bhcd,bhde->bhce', kc, s)
        o = jnp.einsum('bhcd,bhde->bhce', qd, s) + jnp.einsum('bhcj,bhje->bhce', a, v_new)
        s = s * jnp.exp(gl)[..., None, None] + jnp.einsum('bhcd,bhce->bhde', kd, v_new)
        return s, o

    s_fin, o = lax.scan(step, s0.astype(f32), xs)
    o = o.transpose(1, 0, 3, 2, 4).reshape(bsz, seqlen, nh, dv)
    return o, s_fin


def _gdn_mixer(h, conv_buf, s0, w_in, conv_w, a_log, dt_bias, norm_w, w_out):
    bsz, seqlen, _ = h.shape
    proj = h @ w_in
    o1 = GDN_CONV_DIM
    o2 = o1 + GDN_VALUE_DIM
    o3 = o2 + GDN_V_HEADS
    qkv, z, a, b = proj[..., :o1], proj[..., o1:o2], proj[..., o2:o3], proj[..., o3:]
    ext = jnp.concatenate([conv_buf.astype(qkv.dtype), qkv], axis=1)
    conv = ext[:, 0:seqlen] * conv_w[0]
    for t in range(1, GDN_CONV_WIDTH):
        conv = conv + ext[:, t:t + seqlen] * conv_w[t]
    conv = jax.nn.silu(conv)
    q = conv[..., :GDN_KEY_DIM].reshape(bsz, seqlen, GDN_QK_HEADS, GDN_HEAD_DIM)
    k = conv[..., GDN_KEY_DIM:2 * GDN_KEY_DIM].reshape(bsz, seqlen, GDN_QK_HEADS, GDN_HEAD_DIM)
    v = conv[..., 2 * GDN_KEY_DIM:].reshape(bsz, seqlen, GDN_V_HEADS, GDN_HEAD_DIM)
    rep = GDN_V_HEADS // GDN_QK_HEADS
    q = jnp.repeat(_l2norm(q) * GDN_HEAD_DIM ** -0.5, rep, axis=2)
    k = jnp.repeat(_l2norm(k), rep, axis=2)
    beta = jax.nn.sigmoid(b.astype(jnp.float32))
    g = -jnp.exp(a_log.astype(jnp.float32)) * jax.nn.softplus(a.astype(jnp.float32) + dt_bias.astype(jnp.float32))
    o, s_new = _chunked_gated_delta(q, k, v, g, beta, s0)
    zg = jax.nn.silu(z.astype(jnp.float32)).reshape(bsz, seqlen, GDN_V_HEADS, GDN_HEAD_DIM)
    o = _rmsnorm(o, norm_w) * zg
    out = o.reshape(bsz, seqlen, GDN_VALUE_DIM).astype(h.dtype) @ w_out
    return out, ext[:, -(GDN_CONV_WIDTH - 1):], s_new


def _trunk(x, c, pool_bufs, conv_bufs, rec_states, start,
           norm_gain, ada_w, ada_b, pool_w_in, pool_w_group, pool_scale, pool_w_out,
           gdn_w_in, gdn_conv_w, gdn_a_log, gdn_dt_bias, gdn_norm_w, gdn_w_out, final_gain):
    new_pool, new_conv, new_rec = [], [], []
    for i in range(DEPTH):
        mod = jax.nn.silu(c) @ ada_w[i] + ada_b[i]
        shift, scale, gate = jnp.split(mod, 3, axis=-1)
        h = (_rmsnorm(x, norm_gain[i]) * (1.0 + scale[:, None, :]) + shift[:, None, :]).astype(x.dtype)
        j = i // N_MIXERS
        if i % N_MIXERS == 0:
            out, buf = _pool_mixer(h, pool_bufs[j], start, pool_w_in[j], pool_w_group[j],
                                   pool_scale[j], pool_w_out[j])
            new_pool.append(buf)
        else:
            out, cbuf, s_new = _gdn_mixer(h, conv_bufs[j], rec_states[j], gdn_w_in[j], gdn_conv_w[j],
                                          gdn_a_log[j], gdn_dt_bias[j], gdn_norm_w[j], gdn_w_out[j])
            new_conv.append(cbuf)
            new_rec.append(s_new)
        x = x + gate[:, None, :] * out
    y = _rmsnorm(x, final_gain).astype(x.dtype)
    return y, jnp.stack(new_pool), jnp.stack(new_conv), jnp.stack(new_rec)


def setup_inputs(seed: int = 0) -> dict:
    key = jax.random.key(seed)
    ks = jax.random.split(key, 24)
    f32 = jnp.float32

    def nrm(k, shape, s):
        return jax.random.normal(k, shape, f32) * s

    dt = jnp.exp(jax.random.uniform(ks[17], (N_GDN_LAYERS, GDN_V_HEADS), f32, np.log(0.001), np.log(0.1)))
    return {
        'x_prompt': nrm(ks[0], (BATCH, SEQ, D_MODEL), 1.0),
        'x_sample': nrm(ks[1], (DEC_BATCH, DEC_SEQ, D_MODEL), 1.0),
        'c_prompt': nrm(ks[2], (BATCH, D_MODEL), 1.0),
        'c_sample': nrm(ks[3], (DEC_BATCH, D_MODEL), 1.0),
        'state_pool': nrm(ks[4], (N_POOL_LAYERS, DEC_BATCH, POOL_BUF, POOL_WIDTH), 1.0),
        'state_conv': nrm(ks[5], (N_GDN_LAYERS, DEC_BATCH, GDN_CONV_WIDTH - 1, GDN_CONV_DIM), 1.0),
        'state_rec': nrm(ks[6], (N_GDN_LAYERS, DEC_BATCH, GDN_V_HEADS, GDN_HEAD_DIM, GDN_HEAD_DIM), GDN_HEAD_DIM ** -0.5),
        'norm_gain': 1.0 + nrm(ks[7], (DEPTH, D_MODEL), 0.05),
        'ada_w': nrm(ks[8], (DEPTH, D_MODEL, 3 * D_MODEL), 0.5 * D_MODEL ** -0.5),
        'ada_b': nrm(ks[9], (DEPTH, 3 * D_MODEL), 0.02),
        'pool_w_in': nrm(ks[10], (N_POOL_LAYERS, D_MODEL, 2 * POOL_WIDTH), D_MODEL ** -0.5),
        'pool_w_group': nrm(ks[11], (N_POOL_LAYERS, N_POOL_GROUPS, POOL_GROUP_DIM, POOL_GROUP_DIM), POOL_GROUP_DIM ** -0.5),
        'pool_scale': 1.0 + nrm(ks[12], (N_POOL_LAYERS, POOL_WIDTH), 0.1),
        'pool_w_out': nrm(ks[13], (N_POOL_LAYERS, POOL_WIDTH, D_MODEL), POOL_WIDTH ** -0.5),
        'gdn_w_in': nrm(ks[14], (N_GDN_LAYERS, D_MODEL, GDN_IN_DIM), D_MODEL ** -0.5),
        'gdn_conv_w': nrm(ks[15], (N_GDN_LAYERS, GDN_CONV_WIDTH, GDN_CONV_DIM), 0.5),
        'gdn_a_log': jnp.log(jax.random.uniform(ks[16], (N_GDN_LAYERS, GDN_V_HEADS), f32, 1.0, 16.0)),
        'gdn_dt_bias': jnp.log(jnp.expm1(dt)),
        'gdn_norm_w': 1.0 + nrm(ks[18], (N_GDN_LAYERS, GDN_HEAD_DIM), 0.05),
        'gdn_w_out': nrm(ks[19], (N_GDN_LAYERS, GDN_VALUE_DIM, D_MODEL), GDN_VALUE_DIM ** -0.5),
        'final_gain': 1.0 + nrm(ks[20], (D_MODEL,), 0.05),
    }


def reference(x_prompt, x_sample, c_prompt, c_sample, state_pool, state_conv, state_rec,
              norm_gain, ada_w, ada_b, pool_w_in, pool_w_group, pool_scale, pool_w_out,
              gdn_w_in, gdn_conv_w, gdn_a_log, gdn_dt_bias, gdn_norm_w, gdn_w_out, final_gain):
    nb = x_prompt.shape[0]
    zero_pool = jnp.zeros((N_POOL_LAYERS, nb, POOL_BUF, POOL_WIDTH), x_prompt.dtype)
    zero_conv = jnp.zeros((N_GDN_LAYERS, nb, GDN_CONV_WIDTH - 1, GDN_CONV_DIM), x_prompt.dtype)
    zero_rec = jnp.zeros((N_GDN_LAYERS, nb, GDN_V_HEADS, GDN_HEAD_DIM, GDN_HEAD_DIM), jnp.float32)
    y_prompt, pool_p, conv_p, rec_p = _trunk(
        x_prompt, c_prompt, zero_pool, zero_conv, zero_rec, 0,
        norm_gain, ada_w, ada_b, pool_w_in, pool_w_group, pool_scale, pool_w_out,
        gdn_w_in, gdn_conv_w, gdn_a_log, gdn_dt_bias, gdn_norm_w, gdn_w_out, final_gain)
    y_sample, pool_s, conv_s, rec_s = _trunk(
        x_sample, c_sample, state_pool, state_conv, state_rec, PAST_LEN,
        norm_gain, ada_w, ada_b, pool_w_in, pool_w_group, pool_scale, pool_w_out,
        gdn_w_in, gdn_conv_w, gdn_a_log, gdn_dt_bias, gdn_norm_w, gdn_w_out, final_gain)
    return (y_prompt, y_sample, pool_p, conv_p, rec_p, pool_s, conv_s, rec_s)
```

```cpp
#include <hip/hip_runtime.h>
#include <hip/hip_cooperative_groups.h>
#include <cstdio>
namespace cg = cooperative_groups;

#define LAS __attribute__((address_space(3)))
typedef unsigned short bf16_t;
typedef short bf16x8 __attribute__((ext_vector_type(8)));
typedef short bf16x4 __attribute__((ext_vector_type(4)));
typedef float f32x4 __attribute__((ext_vector_type(4)));
typedef unsigned u32x4 __attribute__((ext_vector_type(4)));
typedef unsigned u32x2 __attribute__((ext_vector_type(2)));

constexpr int DM = 1024, TP = 65536, TS = 2048, T = TP + TS, NSEQ = 48, NCHUNK = T / 64;
constexpr int NT = 512, LDS_BYTES = 147456;
constexpr float EPS = 1e-6f;

constexpr size_t SZ_BIG = (size_t)T * 2048 * 2;
constexpr size_t WS_W1T = 0;
constexpr size_t WS_WGT = WS_W1T + (size_t)4096 * 1024 * 2;
constexpr size_t WS_W2T = WS_WGT + (size_t)2048 * 512 * 2;
constexpr size_t WS_W3T = WS_W2T + (size_t)1024 * 2048 * 2;
constexpr size_t WS_W4T = WS_W3T + (size_t)6400 * 1024 * 2;
constexpr size_t WS_MOD = WS_W4T + (size_t)1024 * 2048 * 2;
constexpr size_t WS_AB = WS_MOD + (size_t)2 * 48 * 3072 * 4;
constexpr size_t WS_GC = WS_AB + (size_t)T * 32 * 4;
constexpr size_t WS_BETA = WS_GC + (size_t)T * 16 * 4;
constexpr size_t WS_STASH = WS_BETA + (size_t)T * 16 * 4;
constexpr size_t WS_H = WS_STASH + (size_t)NCHUNK * 3 * 4096 * 2;
constexpr size_t WS_R1 = WS_H + (size_t)T * 1024 * 2;
constexpr size_t WS_R2 = WS_R1 + SZ_BIG;
constexpr size_t WS_R3 = WS_R2 + SZ_BIG;
constexpr size_t WS_END = WS_R3 + SZ_BIG;

constexpr size_t O_Y = 0;
constexpr size_t O_POOL_P = (size_t)T * 1024;
constexpr size_t O_CONV_P = O_POOL_P + (size_t)16 * 15 * 2048;
constexpr size_t O_REC_P = O_CONV_P + (size_t)16 * 3 * 4096;
constexpr size_t O_POOL_S = O_REC_P + (size_t)16 * 16 * 16384;
constexpr size_t O_CONV_S = O_POOL_S + (size_t)32 * 15 * 2048;
constexpr size_t O_REC_S = O_CONV_S + (size_t)32 * 3 * 4096;

struct Params {
    const float* x_prompt; const float* x_sample; const float* c_prompt; const float* c_sample;
    const float* state_pool; const float* state_conv; const float* state_rec;
    const float* norm_gain; const float* ada_w; const float* ada_b;
    const float* pool_w_in; const float* pool_w_group; const float* pool_scale; const float* pool_w_out;
    const float* gdn_w_in; const float* gdn_conv_w; const float* gdn_a_log; const float* gdn_dt_bias; const float* gdn_norm_w; const float* gdn_w_out;
    const float* final_gain;
    float* out; unsigned char* ws;
};

__device__ __forceinline__ unsigned cvt_pk_bf16(float lo, float hi) { unsigned r; asm volatile("v_cvt_pk_bf16_f32 %0, %1, %2" : "=v"(r) : "v"(lo), "v"(hi)); return r; }
__device__ __forceinline__ float bf_lo(unsigned w) { return __uint_as_float(w << 16); }
__device__ __forceinline__ float bf_hi(unsigned w) { return __uint_as_float(w & 0xffff0000u); }
__device__ __forceinline__ float silu_f(float x) { return x * __builtin_amdgcn_rcpf(1.0f + __expf(-x)); }
__device__ __forceinline__ void unpack8(const u32x4 w, float (&f)[8]) { f[0] = bf_lo(w.x); f[1] = bf_hi(w.x); f[2] = bf_lo(w.y); f[3] = bf_hi(w.y); f[4] = bf_lo(w.z); f[5] = bf_hi(w.z); f[6] = bf_lo(w.w); f[7] = bf_hi(w.w); }
__device__ __forceinline__ u32x4 pack8(const float (&f)[8]) { u32x4 w; w.x = cvt_pk_bf16(f[0], f[1]); w.y = cvt_pk_bf16(f[2], f[3]); w.z = cvt_pk_bf16(f[4], f[5]); w.w = cvt_pk_bf16(f[6], f[7]); return w; }
__device__ __forceinline__ int seq_of_row(int row) { return row < TP ? (row >> 12) : 16 + ((row - TP) >> 6); }

namespace pg8 {
constexpr int BM = 256, BK = 64, HALF = 128, HTB = HALF * BK * 2, STAGE_BYTES = 8 * HTB, NXCD = 8, WGM = 8;
__device__ __forceinline__ int lds_byte(int r, int c) { const int st = (r >> 4) * 2 + (c >> 5), rr = r & 15, cc = c & 31, ob = rr * 64 + cc * 2; return st * 1024 + (ob ^ (((ob >> 9) & 1) << 5)); }
__device__ __forceinline__ void stage_rc(int b, int& R, int& C) { const int st = b / 1024, sb = b % 1024, swz = sb ^ (((sb >> 9) & 1) << 5); R = (st >> 1) * 16 + swz / 64; C = (st & 1) * 32 + (swz % 64) / 2; }
__device__ __forceinline__ int perm32(int rho) { const int n = rho >> 4, i = rho & 15; return 8 * (i >> 2) + 4 * n + (i & 3); }
struct Unit { int pm, pn; };
struct Gemm { const bf16_t* A; const bf16_t* Bt; int M, N, K, lda, ldb, a_grp_div; long a_gstride; };
struct StaticOrder {
    int nM, nN, nwg, G, c;
    __device__ void init(int M, int N, int G_, int c_) { nM = M / BM; nN = N / BM; nwg = nM * nN; G = G_; c = c_; }
    __device__ bool next(int i, Unit& u) const {
        const long L = (long)i * G + c; if (L >= nwg) return false;
        int wgid = (int)L; { const int q = nwg / NXCD, r = nwg % NXCD, xcd = wgid % NXCD, off = wgid / NXCD; wgid = (xcd < r ? xcd * (q + 1) : r * (q + 1) + (xcd - r) * q) + off; }
        const int nig = WGM * nN, gid = wgid / nig, fm = gid * WGM, gsz = (nM - fm) < WGM ? (nM - fm) : WGM;
        u.pm = fm + ((wgid % nig) % gsz); u.pn = (wgid % nig) / gsz; return true;
    }
};

template <class Epi>
__device__ __forceinline__ void gemm_phase(LAS unsigned char* lds, const Gemm g, const StaticOrder& S, const Epi& E) {
    const int tid = threadIdx.x, wid = __builtin_amdgcn_readfirstlane(tid >> 6), lane = tid & 63, wr = wid >> 2, wc = wid & 3, fr = lane & 15, fq = lane >> 4;
    const int K = g.K, nt = K / BK;
    unsigned voffA[2], voffB[2];
#pragma unroll
    for (int i = 0; i < 2; ++i) { int R, C; stage_rc(tid * 16 + i * 8192, R, C); const int Rb = Epi::PERM ? ((R & ~31) + perm32(R & 31)) : R;
        voffA[i] = (unsigned)(R * g.lda + C) * 2u; voffB[i] = (unsigned)(Rb * g.ldb + C) * 2u; }
    const size_t kstep = (size_t)(BK * 2);
    const size_t hsA = (size_t)HALF * g.lda * 2, hsB = (size_t)HALF * g.ldb * 2;
    const size_t tsA = 2 * hsA, tsB = 2 * hsB;
    const unsigned ldsw = (unsigned)wid * 1024u;
    const int aoff = lds_byte(wr * 64 + fr, fq * 8), boff = lds_byte(wc * 32 + fr, fq * 8);
#define PG8_SA(b, h) (((b) * 2 + (h)) * HTB)
#define PG8_SB(b, h) ((4 + (b) * 2 + (h)) * HTB)
#define PG8_STAGE(bufoff, gbase, voff) do { _Pragma("unroll") for (int _i = 0; _i < 2; ++_i) \
        __builtin_amdgcn_global_load_lds((const unsigned*)((const char*)(gbase) + (voff)[_i]), (LAS unsigned*)(lds + (bufoff) + ldsw + _i * 8192), 16, 0, 0); } while (0)
#define PG8_LDA(dst, b, h) do { _Pragma("unroll") for (int m = 0; m < 4; ++m) _Pragma("unroll") for (int k = 0; k < 2; ++k) dst[m][k] = *(const LAS bf16x8*)(lds + PG8_SA(b, h) + aoff + m * 2048 + k * 1024); } while (0)
#define PG8_LDB(dst, b, h) do { _Pragma("unroll") for (int n = 0; n < 2; ++n) _Pragma("unroll") for (int k = 0; k < 2; ++k) dst[n][k] = *(const LAS bf16x8*)(lds + PG8_SB(b, h) + boff + n * 2048 + k * 1024); } while (0)
#define PG8_MMA(ai, bj, At, Bt) do { __builtin_amdgcn_s_setprio(1); _Pragma("unroll") for (int m = 0; m < 4; ++m) _Pragma("unroll") for (int n = 0; n < 2; ++n) _Pragma("unroll") for (int k = 0; k < 2; ++k) \
        acc[ai][bj][m][n] = __builtin_amdgcn_mfma_f32_16x16x32_bf16(Bt[n][k], At[m][k], acc[ai][bj][m][n], 0, 0, 0); __builtin_amdgcn_s_setprio(0); } while (0)
#define PG8_WAIT_V(n) asm volatile("s_waitcnt vmcnt(" #n ")" ::: "memory")
#define PG8_WAIT_L(n) asm volatile("s_waitcnt lgkmcnt(" #n ")" ::: "memory")
#define PG8_BAR __builtin_amdgcn_s_barrier()
#define PG8_SCHED __builtin_amdgcn_sched_barrier(0)
#define PG8_APTR(u) ((const char*)g.A + (size_t)(u).pm * tsA + (g.a_grp_div ? (size_t)((u).pn / g.a_grp_div) * (size_t)g.a_gstride : (size_t)0))
#define PG8_BPTR(u) ((const char*)g.Bt + (size_t)(u).pn * tsB)
    Unit cur, nxt; int ui = 0;
    if (!S.next(0, cur)) return;
    f32x4 acc[2][2][4][2];
#pragma unroll
    for (int a = 0; a < 2; ++a)
#pragma unroll
        for (int b = 0; b < 2; ++b)
#pragma unroll
            for (int m = 0; m < 4; ++m)
#pragma unroll
                for (int n = 0; n < 2; ++n) acc[a][b][m][n] = (f32x4){0.f, 0.f, 0.f, 0.f};
    bf16x8 At[4][2], B0[2][2], B1[2][2];
    const char* cA = PG8_APTR(cur); const char* cB = PG8_BPTR(cur);
    PG8_STAGE(PG8_SB(0, 0), cB, voffB); PG8_STAGE(PG8_SA(0, 0), cA, voffA); PG8_STAGE(PG8_SB(0, 1), cB + hsB, voffB); PG8_STAGE(PG8_SA(0, 1), cA + hsA, voffA);
    if (wr == 1) PG8_BAR;
    PG8_WAIT_V(4); PG8_BAR;
    PG8_STAGE(PG8_SB(1, 0), cB + kstep, voffB); PG8_STAGE(PG8_SA(1, 0), cA + kstep, voffA); PG8_STAGE(PG8_SB(1, 1), cB + hsB + kstep, voffB);
    PG8_WAIT_V(6); PG8_BAR;
    for (;;) {
        const bool has_next = S.next(ui + 1, nxt);
        const char* nA = has_next ? PG8_APTR(nxt) : cA; const char* nB = has_next ? PG8_BPTR(nxt) : cB;
        for (int t = 0; t < nt; t += 2) {
            const bool last = (t == nt - 2);
            const char* a1 = cA + (size_t)(t + 1) * kstep;
            const char* a2 = last ? nA : cA + (size_t)(t + 2) * kstep; const char* b2 = last ? nB : cB + (size_t)(t + 2) * kstep;
            const char* a3 = a2 + kstep; const char* b3 = b2 + kstep;
            PG8_LDB(B0, 0, 0); PG8_SCHED; PG8_LDA(At, 0, 0); PG8_STAGE(PG8_SA(1, 1), a1 + hsA, voffA);
            PG8_WAIT_L(8); PG8_BAR; PG8_WAIT_L(0); PG8_MMA(0, 0, At, B0); PG8_BAR; PG8_SCHED;
            PG8_LDB(B1, 0, 1); PG8_STAGE(PG8_SB(0, 0), b2, voffB);
            PG8_BAR; PG8_WAIT_L(0); PG8_MMA(0, 1, At, B1); PG8_BAR;
            PG8_LDA(At, 0, 1); PG8_STAGE(PG8_SA(0, 0), a2, voffA);
            PG8_BAR; PG8_WAIT_L(0); PG8_MMA(1, 0, At, B0); PG8_BAR; PG8_SCHED;
            PG8_STAGE(PG8_SB(0, 1), b2 + hsB, voffB);
            PG8_WAIT_V(6); PG8_BAR; PG8_MMA(1, 1, At, B1); PG8_BAR;
            PG8_LDB(B0, 1, 0); PG8_SCHED; PG8_LDA(At, 1, 0); PG8_STAGE(PG8_SA(0, 1), a2 + hsA, voffA);
            PG8_WAIT_L(8); PG8_BAR; PG8_WAIT_L(0); PG8_MMA(0, 0, At, B0); PG8_BAR; PG8_SCHED;
            PG8_LDB(B1, 1, 1); PG8_STAGE(PG8_SB(1, 0), b3, voffB);
            PG8_BAR; PG8_WAIT_L(0); PG8_MMA(0, 1, At, B1); PG8_BAR;
            PG8_LDA(At, 1, 1); PG8_STAGE(PG8_SA(1, 0), a3, voffA);
            PG8_BAR; PG8_WAIT_L(0); PG8_MMA(1, 0, At, B0); PG8_BAR; PG8_SCHED;
            PG8_STAGE(PG8_SB(1, 1), b3 + hsB, voffB);
            PG8_WAIT_V(6); PG8_BAR; PG8_MMA(1, 1, At, B1); PG8_BAR;
        }
        E(acc, cur, wr, wc, fr, fq);
        if (!has_next) break;
#pragma unroll
        for (int a = 0; a < 2; ++a)
#pragma unroll
            for (int b = 0; b < 2; ++b)
#pragma unroll
                for (int m = 0; m < 4; ++m)
#pragma unroll
                    for (int n = 0; n < 2; ++n) acc[a][b][m][n] = (f32x4){0.f, 0.f, 0.f, 0.f};
        cur = nxt; cA = nA; cB = nB; ++ui;
    }
    PG8_WAIT_V(0);
    if (wr == 0) PG8_BAR;
    PG8_BAR;
#undef PG8_SA
#undef PG8_SB
#undef PG8_STAGE
#undef PG8_LDA
#undef PG8_LDB
#undef PG8_MMA
#undef PG8_WAIT_V
#undef PG8_WAIT_L
#undef PG8_BAR
#undef PG8_SCHED
#undef PG8_APTR
#undef PG8_BPTR
}

struct EpiL0In {
    static constexpr bool PERM = true;
    bf16_t* U; bf16_t* SZ;
    __device__ __forceinline__ void operator()(const f32x4 (&acc)[2][2][4][2], const Unit& u, int wr, int wc, int fr, int fq) const {
        const int row0 = u.pm * BM + wr * 64 + fr; const bool isz = u.pn >= 8;
        bf16_t* base = isz ? SZ : U; const int col0 = (isz ? u.pn - 8 : u.pn) * BM + wc * 32 + 8 * fq;
#pragma unroll
        for (int ai = 0; ai < 2; ++ai)
#pragma unroll
            for (int m = 0; m < 4; ++m) { bf16_t* rowp = base + (size_t)(row0 + ai * HALF + m * 16) * 2048 + col0;
#pragma unroll
                for (int bj = 0; bj < 2; ++bj) { f32x4 v0 = acc[ai][bj][m][0], v1 = acc[ai][bj][m][1];
                    if (isz) {
#pragma unroll
                        for (int j = 0; j < 4; ++j) { v0[j] = silu_f(v0[j]); v1[j] = silu_f(v1[j]); } }
                    u32x4 w; w.x = cvt_pk_bf16(v0[0], v0[1]); w.y = cvt_pk_bf16(v0[2], v0[3]); w.z = cvt_pk_bf16(v1[0], v1[1]); w.w = cvt_pk_bf16(v1[2], v1[3]);
                    *(u32x4*)(rowp + bj * HALF) = w; } }
    }
};
struct EpiGrp {
    static constexpr bool PERM = true;
    bf16_t* YY; const bf16_t* SZ; const float* scale;
    __device__ __forceinline__ void operator()(const f32x4 (&acc)[2][2][4][2], const Unit& u, int wr, int wc, int fr, int fq) const {
        const int row0 = u.pm * BM + wr * 64 + fr; const int col0 = u.pn * BM + wc * 32 + 8 * fq;
        f32x4 sc[2][2];
#pragma unroll
        for (int bj = 0; bj < 2; ++bj) { sc[bj][0] = *(const f32x4*)(scale + col0 + bj * HALF); sc[bj][1] = *(const f32x4*)(scale + col0 + bj * HALF + 4); }
#pragma unroll
        for (int ai = 0; ai < 2; ++ai)
#pragma unroll
            for (int m = 0; m < 4; ++m) { const size_t off = (size_t)(row0 + ai * HALF + m * 16) * 2048 + col0;
#pragma unroll
                for (int bj = 0; bj < 2; ++bj) { const u32x4 z = *(const u32x4*)(SZ + off + bj * HALF); float zf[8]; unpack8(z, zf);
                    const f32x4 v0 = acc[ai][bj][m][0] * sc[bj][0], v1 = acc[ai][bj][m][1] * sc[bj][1];
                    u32x4 w; w.x = cvt_pk_bf16(v0[0] * zf[0], v0[1] * zf[1]); w.y = cvt_pk_bf16(v0[2] * zf[2], v0[3] * zf[3]); w.z = cvt_pk_bf16(v1[0] * zf[4], v1[1] * zf[5]); w.w = cvt_pk_bf16(v1[2] * zf[6], v1[3] * zf[7]);
                    *(u32x4*)(YY + off + bj * HALF) = w; } }
    }
};
struct EpiRes {
    static constexpr bool PERM = false;
    const float* base_lo; const float* base_hi; float* OUT; const float* gate;
    __device__ __forceinline__ void operator()(const f32x4 (&acc)[2][2][4][2], const Unit& u, int wr, int wc, int fr, int fq) const {
        const int row0 = u.pm * BM + wr * 64 + fr, col0 = u.pn * BM + wc * 32 + 4 * fq;
#pragma unroll
        for (int ai = 0; ai < 2; ++ai)
#pragma unroll
            for (int m = 0; m < 4; ++m) { const int row = row0 + ai * HALF + m * 16; const float* gp = gate + (size_t)seq_of_row(row) * 3072 + col0;
                const float* bp = (row < TP ? base_lo + (size_t)row * 1024 : base_hi + (size_t)(row - TP) * 1024) + col0; float* op = OUT + (size_t)row * 1024 + col0;
#pragma unroll
                for (int bj = 0; bj < 2; ++bj)
#pragma unroll
                    for (int n = 0; n < 2; ++n) { const f32x4 gv = *(const f32x4*)(gp + bj * HALF + n * 16); const f32x4 bs = *(const f32x4*)(bp + bj * HALF + n * 16);
                        *(f32x4*)(op + bj * HALF + n * 16) = bs + gv * acc[ai][bj][m][n]; } }
    }
};
struct EpiL1In {
    static constexpr bool PERM = true;
    bf16_t* QKV; bf16_t* STASH; float* AB;
    __device__ __forceinline__ void operator()(const f32x4 (&acc)[2][2][4][2], const Unit& u, int wr, int wc, int fr, int fq) const {
        const int row0 = u.pm * BM + wr * 64 + fr;
        if (u.pn < 16) {
            const int col0 = u.pn * BM + wc * 32 + 8 * fq;
#pragma unroll
            for (int ai = 0; ai < 2; ++ai)
#pragma unroll
                for (int m = 0; m < 4; ++m) { const int row = row0 + ai * HALF + m * 16; bf16_t* rowp = QKV + (size_t)row * 4096 + col0; const int rl = row & 63;
#pragma unroll
                    for (int bj = 0; bj < 2; ++bj) { const f32x4 v0 = acc[ai][bj][m][0], v1 = acc[ai][bj][m][1];
                        u32x4 w; w.x = cvt_pk_bf16(v0[0], v0[1]); w.y = cvt_pk_bf16(v0[2], v0[3]); w.z = cvt_pk_bf16(v1[0], v1[1]); w.w = cvt_pk_bf16(v1[2], v1[3]);
                        *(u32x4*)(rowp + bj * HALF) = w;
                        if (rl >= 61) *(u32x4*)(STASH + ((size_t)(row >> 6) * 3 + (rl - 61)) * 4096 + col0 + bj * HALF) = w; } }
        } else if (wc == 0) {
#pragma unroll
            for (int ai = 0; ai < 2; ++ai)
#pragma unroll
                for (int m = 0; m < 4; ++m) { const int row = row0 + ai * HALF + m * 16; float* rowp = AB + (size_t)row * 32 + 8 * fq;
                    *(f32x4*)(rowp) = acc[ai][0][m][0]; *(f32x4*)(rowp + 4) = acc[ai][0][m][1]; }
        }
    }
};
struct EpiZ {
    static constexpr bool PERM = true;
    bf16_t* QKV;
    __device__ __forceinline__ void operator()(const f32x4 (&acc)[2][2][4][2], const Unit& u, int wr, int wc, int fr, int fq) const {
        const int row0 = u.pm * BM + wr * 64 + fr; const int col0 = 2048 + u.pn * BM + wc * 32 + 8 * fq;
#pragma unroll
        for (int ai = 0; ai < 2; ++ai)
#pragma unroll
            for (int m = 0; m < 4; ++m) { bf16_t* rowp = QKV + (size_t)(row0 + ai * HALF + m * 16) * 4096 + col0;
#pragma unroll
                for (int bj = 0; bj < 2; ++bj) { const u32x4 o = *(const u32x4*)(rowp + bj * HALF); float of[8]; unpack8(o, of);
                    const f32x4 v0 = acc[ai][bj][m][0], v1 = acc[ai][bj][m][1];
                    u32x4 w; w.x = cvt_pk_bf16(of[0] * silu_f(v0[0]), of[1] * silu_f(v0[1])); w.y = cvt_pk_bf16(of[2] * silu_f(v0[2]), of[3] * silu_f(v0[3]));
                    w.z = cvt_pk_bf16(of[4] * silu_f(v1[0]), of[5] * silu_f(v1[1])); w.w = cvt_pk_bf16(of[6] * silu_f(v1[2]), of[7] * silu_f(v1[3]));
                    *(u32x4*)(rowp + bj * HALF) = w; } }
    }
};
}

__device__ void transpose_tile(const float* src, int ld_src, int k0, int ncol0, int ncols_valid, bf16_t* dst, int ld_dst, int dst_row0, float* tile) {
    const int tid = threadIdx.x;
    { const int r = tid >> 4, c4 = (tid & 15) * 4;
#pragma unroll
        for (int i = 0; i < 2; ++i) { const int row = r + 32 * i; f32x4 v = (f32x4){0.f, 0.f, 0.f, 0.f};
            if (ncol0 + c4 < ncols_valid) v = *(const f32x4*)(src + (size_t)(k0 + row) * ld_src + ncol0 + c4);
            tile[row * 65 + c4 + 0] = v[0]; tile[row * 65 + c4 + 1] = v[1]; tile[row * 65 + c4 + 2] = v[2]; tile[row * 65 + c4 + 3] = v[3]; } }
    __syncthreads();
    { const int n = tid >> 3, k8 = (tid & 7) * 8; float f[8];
#pragma unroll
        for (int j = 0; j < 8; ++j) f[j] = tile[(k8 + j) * 65 + n];
        *(u32x4*)(dst + (size_t)(dst_row0 + n) * ld_dst + k0 + k8) = pack8(f); }
    __syncthreads();
}
__device__ void phase_prep(const Params& p, unsigned char* lds_g) {
    float* tile = (float*)lds_g;
    bf16_t* W1t = (bf16_t*)(p.ws + WS_W1T); bf16_t* Wgt = (bf16_t*)(p.ws + WS_WGT); bf16_t* W2t = (bf16_t*)(p.ws + WS_W2T); bf16_t* W3t = (bf16_t*)(p.ws + WS_W3T); bf16_t* W4t = (bf16_t*)(p.ws + WS_W4T);
    float* mod = (float*)(p.ws + WS_MOD);
    const int tid = threadIdx.x;
    constexpr int N_MOD = 72, N_W1 = 1024, N_WG = 256, N_W2 = 512, N_W3 = 1600, N_W4 = 512, N_ALL = N_MOD + N_W1 + N_WG + N_W2 + N_W3 + N_W4;
    for (int it = blockIdx.x; it < N_ALL; it += gridDim.x) {
        int i = it;
        if (i < N_MOD) {
            const int colchunk = i % 12, rg = i / 12; const int col = colchunk * 512 + tid, layer = col / 3072, cc = col % 3072;
            for (int idx = tid; idx < 8192; idx += NT) { const int k = idx >> 3, r = idx & 7, row = rg * 8 + r;
                const float cv = row < 16 ? p.c_prompt[row * 1024 + k] : p.c_sample[(row - 16) * 1024 + k]; tile[idx] = silu_f(cv); }
            __syncthreads();
            float a[8];
#pragma unroll
            for (int r = 0; r < 8; ++r) a[r] = 0.f;
            const float* wp = p.ada_w + (size_t)layer * 1024 * 3072 + cc;
#pragma unroll 4
            for (int k = 0; k < 1024; ++k) { const float w = wp[(size_t)k * 3072]; const f32x4 s0 = *(const f32x4*)(tile + k * 8), s1 = *(const f32x4*)(tile + k * 8 + 4);
                a[0] += w * s0[0]; a[1] += w * s0[1]; a[2] += w * s0[2]; a[3] += w * s0[3]; a[4] += w * s1[0]; a[5] += w * s1[1]; a[6] += w * s1[2]; a[7] += w * s1[3]; }
            const float bias = p.ada_b[layer * 3072 + cc];
#pragma unroll
            for (int r = 0; r < 8; ++r) mod[((size_t)layer * 48 + rg * 8 + r) * 3072 + cc] = a[r] + bias;
            __syncthreads();
            continue;
        }
        i -= N_MOD;
        if (i < N_W1) { const int kt = i & 15, ntile = i >> 4; transpose_tile(p.pool_w_in, 4096, kt * 64, ntile * 64, 4096, W1t, 1024, ntile * 64, tile); continue; }
        i -= N_W1;
        if (i < N_WG) { const int g = i >> 6, r = i & 63, kt = r & 7, ntile = r >> 3; transpose_tile(p.pool_w_group + (size_t)g * 512 * 512, 512, kt * 64, ntile * 64, 512, Wgt + (size_t)g * 512 * 512, 512, ntile * 64, tile); continue; }
        i -= N_WG;
        if (i < N_W2) { const int kt = i & 31, ntile = i >> 5; transpose_tile(p.pool_w_out, 1024, kt * 64, ntile * 64, 1024, W2t, 2048, ntile * 64, tile); continue; }
        i -= N_W2;
        if (i < N_W3) { const int kt = i & 15, ntile = i >> 4; const int n0 = ntile * 64;
            const int src0 = n0 < 4096 ? n0 : (n0 < 4352 ? 6144 + (n0 - 4096) : 4096 + (n0 - 4352));
            const int valid = (n0 >= 4096 && n0 < 4352) ? 6176 : 1 << 30;
            transpose_tile(p.gdn_w_in, 6176, kt * 64, src0, valid, W3t, 1024, n0, tile); continue; }
        i -= N_W3;
        { const int kt = i & 31, ntile = i >> 5; transpose_tile(p.gdn_w_out, 1024, kt * 64, ntile * 64, 1024, W4t, 2048, ntile * 64, tile); }
    }
}

__device__ void phase_norm_mod(const float* x_lo, const float* x_hi, const float* gain, const float* modl, bf16_t* H) {
    const int lane = threadIdx.x & 63, wid = threadIdx.x >> 6;
    for (int row = blockIdx.x * 8 + wid; row < T; row += gridDim.x * 8) {
        const float* xr = row < TP ? x_lo + (size_t)row * 1024 : x_hi + (size_t)(row - TP) * 1024;
        f32x4 v[4]; float ss = 0.f;
#pragma unroll
        for (int j = 0; j < 4; ++j) { v[j] = *(const f32x4*)(xr + j * 256 + lane * 4); ss += v[j][0] * v[j][0] + v[j][1] * v[j][1] + v[j][2] * v[j][2] + v[j][3] * v[j][3]; }
#pragma unroll
        for (int o = 32; o >= 1; o >>= 1) ss += __shfl_xor(ss, o);
        const float r = rsqrtf(ss * (1.0f / 1024.0f) + EPS);
        const float* ms = modl + (size_t)seq_of_row(row) * 3072;
#pragma unroll
        for (int j = 0; j < 4; ++j) { const int c = j * 256 + lane * 4; const f32x4 gn = *(const f32x4*)(gain + c), sh = *(const f32x4*)(ms + c), sc = *(const f32x4*)(ms + 1024 + c);
            const f32x4 o = v[j] * r * gn * (sc + 1.0f) + sh; u32x2 w; w.x = cvt_pk_bf16(o[0], o[1]); w.y = cvt_pk_bf16(o[2], o[3]); *(u32x2*)(H + (size_t)row * 1024 + c) = w; }
    }
}
__device__ void phase_norm_final(const float* X, const float* gain, float* out) {
    const int lane = threadIdx.x & 63, wid = threadIdx.x >> 6;
    for (int row = blockIdx.x * 8 + wid; row < T; row += gridDim.x * 8) {
        const float* xr = X + (size_t)row * 1024; f32x4 v[4]; float ss = 0.f;
#pragma unroll
        for (int j = 0; j < 4; ++j) { v[j] = *(const f32x4*)(xr + j * 256 + lane * 4); ss += v[j][0] * v[j][0] + v[j][1] * v[j][1] + v[j][2] * v[j][2] + v[j][3] * v[j][3]; }
#pragma unroll
        for (int o = 32; o >= 1; o >>= 1) ss += __shfl_xor(ss, o);
        const float r = rsqrtf(ss * (1.0f / 1024.0f) + EPS);
#pragma unroll
        for (int j = 0; j < 4; ++j) { const int c = j * 256 + lane * 4; const f32x4 gn = *(const f32x4*)(gain + c); *(f32x4*)(out + (size_t)row * 1024 + c) = v[j] * r * gn; }
    }
}

struct SeqInfo { int sq, lc, seq_t0; bool sample, last; };
__device__ __forceinline__ SeqInfo chunk_info(int chunk) { SeqInfo s; if (chunk < 1024) { s.sq = chunk >> 6; s.lc = chunk & 63; s.seq_t0 = s.sq * 4096; s.sample = false; s.last = (s.lc == 63); } else { const int cs = chunk - 1024; s.sq = 16 + cs; s.lc = 0; s.seq_t0 = TP + cs * 64; s.sample = true; s.last = true; } return s; }
__device__ __forceinline__ void pool_fetch(const bf16_t* U, const float* spool, const SeqInfo& si, int pos, int c, float (&f)[8]) {
    if (pos >= 0) { const u32x4 w = *(const u32x4*)(U + (size_t)(si.seq_t0 + pos) * 2048 + c); unpack8(w, f); }
    else if (si.sample) { const float* sp = spool + ((size_t)(si.sq - 16) * 15 + 15 + pos) * 2048 + c; const f32x4 a = *(const f32x4*)sp, b = *(const f32x4*)(sp + 4);
        f[0] = a[0]; f[1] = a[1]; f[2] = a[2]; f[3] = a[3]; f[4] = b[0]; f[5] = b[1]; f[6] = b[2]; f[7] = b[3]; }
    else {
#pragma unroll
        for (int j = 0; j < 8; ++j) f[j] = 0.f; }
}
__device__ void phase_pool(const Params& p) {
    const bf16_t* U = (const bf16_t*)(p.ws + WS_R1); bf16_t* D = (bf16_t*)(p.ws + WS_R3);
    const int tid = threadIdx.x, col8 = tid & 63, rs = tid >> 6;
    for (int it = blockIdx.x; it < NCHUNK * 4; it += gridDim.x) {
        const int chunk = it >> 2, g = it & 3, w = 2 << g; const SeqInfo si = chunk_info(chunk);
        const int c = g * 512 + col8 * 8; const int p0 = si.lc * 64 + rs * 8;
        float s[8], cur[8], old[8];
#pragma unroll
        for (int j = 0; j < 8; ++j) s[j] = 0.f;
        for (int q = p0 - w + 1; q < p0; ++q) { pool_fetch(U, p.state_pool, si, q, c, cur);
#pragma unroll
            for (int j = 0; j < 8; ++j) s[j] += cur[j]; }
#pragma unroll 1
        for (int i = 0; i < 8; ++i) { const int pos = p0 + i;
            pool_fetch(U, p.state_pool, si, pos, c, cur);
            if (i > 0) { pool_fetch(U, p.state_pool, si, pos - w, c, old);
#pragma unroll
                for (int j = 0; j < 8; ++j) s[j] -= old[j]; }
#pragma unroll
            for (int j = 0; j < 8; ++j) s[j] += cur[j];
            const float cnt = si.sample ? (float)w : fminf((float)(pos + 1), (float)w); const float inv = 1.0f / cnt;
            float d[8];
#pragma unroll
            for (int j = 0; j < 8; ++j) d[j] = s[j] * inv - cur[j];
            *(u32x4*)(D + (size_t)(si.seq_t0 + pos) * 2048 + c) = pack8(d);
            const int rl = rs * 8 + i;
            if (si.last && rl >= 49) { float* op = p.out + (si.sample ? O_POOL_S + ((size_t)(si.sq - 16) * 15 + (rl - 49)) * 2048 : O_POOL_P + ((size_t)si.sq * 15 + (rl - 49)) * 2048) + c;
                *(f32x4*)op = (f32x4){cur[0], cur[1], cur[2], cur[3]}; *(f32x4*)(op + 4) = (f32x4){cur[4], cur[5], cur[6], cur[7]}; }
        }
    }
}

__device__ void phase_conv(const Params& p) {
    bf16_t* QKV = (bf16_t*)(p.ws + WS_R1); const bf16_t* STASH = (const bf16_t*)(p.ws + WS_STASH); const float* AB = (const float*)(p.ws + WS_AB);
    float* GC = (float*)(p.ws + WS_GC); float* BETA = (float*)(p.ws + WS_BETA);
    const int tid = threadIdx.x, stream = tid >> 7, ct = tid & 127, lane = tid & 63, wid = tid >> 6;
    for (int it = blockIdx.x; it < NCHUNK * 4; it += gridDim.x) {
        const int chunk = it >> 2, qt = it & 3; const SeqInfo si = chunk_info(chunk); const int t0 = chunk * 64;
        const int ch = qt * 1024 + ct * 8; const int r0 = stream * 16;
        float wv[4][8];
#pragma unroll
        for (int t = 0; t < 4; ++t) { const f32x4 a = *(const f32x4*)(p.gdn_conv_w + t * 4096 + ch), b = *(const f32x4*)(p.gdn_conv_w + t * 4096 + ch + 4);
            wv[t][0] = a[0]; wv[t][1] = a[1]; wv[t][2] = a[2]; wv[t][3] = a[3]; wv[t][4] = b[0]; wv[t][5] = b[1]; wv[t][6] = b[2]; wv[t][7] = b[3]; }
        float h0[8], h1[8], h2[8];
        if (stream > 0) { unpack8(*(const u32x4*)(QKV + (size_t)(t0 + r0 - 3) * 4096 + ch), h0); unpack8(*(const u32x4*)(QKV + (size_t)(t0 + r0 - 2) * 4096 + ch), h1); unpack8(*(const u32x4*)(QKV + (size_t)(t0 + r0 - 1) * 4096 + ch), h2); }
        else if (si.lc > 0) { const bf16_t* sp = STASH + (size_t)(chunk - 1) * 3 * 4096 + ch; unpack8(*(const u32x4*)sp, h0); unpack8(*(const u32x4*)(sp + 4096), h1); unpack8(*(const u32x4*)(sp + 8192), h2); }
        else if (si.sample) { const float* sp = p.state_conv + (size_t)(si.sq - 16) * 3 * 4096 + ch;
#pragma unroll
            for (int j = 0; j < 8; ++j) { h0[j] = sp[j]; h1[j] = sp[4096 + j]; h2[j] = sp[8192 + j]; } }
        else {
#pragma unroll
            for (int j = 0; j < 8; ++j) { h0[j] = 0.f; h1[j] = 0.f; h2[j] = 0.f; } }
        __syncthreads();
#pragma unroll 1
        for (int i = 0; i < 16; ++i) {
            bf16_t* rp = QKV + (size_t)(t0 + r0 + i) * 4096 + ch; float x[8], o[8]; unpack8(*(const u32x4*)rp, x);
            float ss = 0.f;
#pragma unroll
            for (int j = 0; j < 8; ++j) { const float cv = wv[0][j] * h0[j] + wv[1][j] * h1[j] + wv[2][j] * h2[j] + wv[3][j] * x[j]; o[j] = silu_f(cv); ss += o[j] * o[j]; h0[j] = h1[j]; h1[j] = h2[j]; h2[j] = x[j]; }
            if (qt < 2) { ss += __shfl_xor(ss, 1); ss += __shfl_xor(ss, 2); ss += __shfl_xor(ss, 4); ss += __shfl_xor(ss, 8);
                const float sc = rsqrtf(ss + EPS) * (qt == 0 ? 0.08838834764831845f : 1.0f);
#pragma unroll
                for (int j = 0; j < 8; ++j) o[j] *= sc; }
            *(u32x4*)rp = pack8(o);
            if (si.last && stream == 3 && i >= 13) { float* op = p.out + (si.sample ? O_CONV_S + ((size_t)(si.sq - 16) * 3 + (i - 13)) * 4096 : O_CONV_P + ((size_t)si.sq * 3 + (i - 13)) * 4096) + ch;
                *(f32x4*)op = (f32x4){x[0], x[1], x[2], x[3]}; *(f32x4*)(op + 4) = (f32x4){x[4], x[5], x[6], x[7]}; }
        }
        if (qt == 0) {
#pragma unroll
            for (int hh = 0; hh < 2; ++hh) { const int h = wid * 2 + hh; const float a = AB[(size_t)(t0 + lane) * 32 + h], b = AB[(size_t)(t0 + lane) * 32 + 16 + h];
                const float xx = a + p.gdn_dt_bias[h]; const float sp = xx > 20.f ? xx : log1pf(expf(xx)); float g = -expf(p.gdn_a_log[h]) * sp;
#pragma unroll
                for (int o = 1; o < 64; o <<= 1) { const float t = __shfl_up(g, o); if (lane >= o) g += t; }
                GC[((size_t)chunk * 16 + h) * 64 + lane] = g; BETA[((size_t)chunk * 16 + h) * 64 + lane] = 1.0f / (1.0f + expf(-b)); }
        }
    }
}

__device__ void phase_j1(const Params& p, unsigned char* lds_g) {
    const bf16_t* QKV = (const bf16_t*)(p.ws + WS_R1); const float* GC = (const float*)(p.ws + WS_GC); const float* BETA = (const float*)(p.ws + WS_BETA);
    bf16_t* AH = (bf16_t*)(p.out + O_Y); bf16_t* AQK = AH + (size_t)NCHUNK * 16 * 4096;
    const int lane = threadIdx.x & 63, wid = threadIdx.x >> 6, c = lane & 15, q4 = lane >> 4;
    float* Lw = (float*)(lds_g + wid * 17408);
    for (int wi = blockIdx.x * 8 + wid; wi < NCHUNK * 16; wi += gridDim.x * 8) {
        const int chunk = wi >> 4, h = wi & 15, hk = h >> 1; const size_t t0 = (size_t)chunk * 64;
        const bf16_t* kb = QKV + t0 * 4096 + 1024 + hk * 128; const bf16_t* qb = QKV + t0 * 4096 + hk * 128;
        const float* gcp = GC + (size_t)wi * 64; const float* btp = BETA + (size_t)wi * 64;
        bf16x8 kf[4][4];
#pragma unroll
        for (int mt = 0; mt < 4; ++mt)
#pragma unroll
            for (int ks = 0; ks < 4; ++ks) kf[mt][ks] = *(const bf16x8*)(kb + (size_t)(16 * mt + c) * 4096 + 32 * ks + 8 * q4);
        float gcc[4];
#pragma unroll
        for (int nt = 0; nt < 4; ++nt) gcc[nt] = gcp[16 * nt + c];
#pragma unroll
        for (int mt = 0; mt < 4; ++mt) {
            bf16x8 qf[4];
#pragma unroll
            for (int ks = 0; ks < 4; ++ks) qf[ks] = *(const bf16x8*)(qb + (size_t)(16 * mt + c) * 4096 + 32 * ks + 8 * q4);
            const f32x4 gcr = *(const f32x4*)(gcp + 16 * mt + 4 * q4), btr = *(const f32x4*)(btp + 16 * mt + 4 * q4);
#pragma unroll
            for (int nt = 0; nt < 4; ++nt) {
                bf16_t* aq = AQK + ((size_t)wi * 64 + 16 * mt + 4 * q4) * 64 + 16 * nt + c;
                if (nt <= mt) {
                    f32x4 kk = (f32x4){0.f, 0.f, 0.f, 0.f}, qk = (f32x4){0.f, 0.f, 0.f, 0.f};
#pragma unroll
                    for (int ks = 0; ks < 4; ++ks) { kk = __builtin_amdgcn_mfma_f32_16x16x32_bf16(kf[mt][ks], kf[nt][ks], kk, 0, 0, 0); qk = __builtin_amdgcn_mfma_f32_16x16x32_bf16(qf[ks], kf[nt][ks], qk, 0, 0, 0); }
#pragma unroll
                    for (int e = 0; e < 4; ++e) { const int i = 16 * mt + 4 * q4 + e, j = 16 * nt + c; const float dec = __expf(fminf(gcr[e] - gcc[nt], 0.f));
                        Lw[i * 68 + j] = (i > j) ? btr[e] * kk[e] * dec : 0.f;
                        const float a = (i >= j) ? qk[e] * dec : 0.f; aq[e * 64] = (bf16_t)(cvt_pk_bf16(a, 0.f) & 0xffffu); }
                } else {
#pragma unroll
                    for (int e = 0; e < 4; ++e) aq[e * 64] = (bf16_t)0;
                }
            }
        }
        __builtin_amdgcn_fence(__ATOMIC_RELEASE, "wavefront"); __builtin_amdgcn_wave_barrier();
        float t[64];
#pragma unroll
        for (int i = 0; i < 64; ++i) {
            float s0 = (lane == i) ? 1.f : 0.f, s1 = 0.f, s2 = 0.f, s3 = 0.f;
#pragma unroll
            for (int j4 = 0; j4 < i; j4 += 4) { const f32x4 l = *(const f32x4*)(Lw + i * 68 + j4);
                s0 -= l[0] * t[j4]; if (j4 + 1 < i) s1 -= l[1] * t[j4 + 1]; if (j4 + 2 < i) s2 -= l[2] * t[j4 + 2]; if (j4 + 3 < i) s3 -= l[3] * t[j4 + 3]; }
            t[i] = (s0 + s1) + (s2 + s3);
        }
        const float bc = btp[lane];
        bf16_t* ah = AH + (size_t)wi * 4096 + lane;
#pragma unroll
        for (int i = 0; i < 64; ++i) ah[i * 64] = (bf16_t)(cvt_pk_bf16(t[i] * bc, 0.f) & 0xffffu);
        __builtin_amdgcn_wave_barrier();
    }
}

__device__ __forceinline__ bf16x8 pack_acc2(const f32x4 a, const f32x4 b) { u32x4 w; w.x = cvt_pk_bf16(a[0], a[1]); w.y = cvt_pk_bf16(a[2], a[3]); w.z = cvt_pk_bf16(b[0], b[1]); w.w = cvt_pk_bf16(b[2], b[3]); return __builtin_bit_cast(bf16x8, w); }
__device__ __forceinline__ bf16x8 ld_perm(const bf16_t* ptr) { const u32x2 a = *(const u32x2*)ptr, b = *(const u32x2*)(ptr + 16); u32x4 w; w.x = a.x; w.y = a.y; w.z = b.x; w.w = b.y; return __builtin_bit_cast(bf16x8, w); }
__device__ void phase_j2(const Params& p, unsigned char* lds_g) {
    bf16_t* QKV = (bf16_t*)(p.ws + WS_R1); const float* GC = (const float*)(p.ws + WS_GC);
    const bf16_t* AH = (const bf16_t*)(p.out + O_Y); const bf16_t* AQK = AH + (size_t)NCHUNK * 16 * 4096;
    const int tid = threadIdx.x, lane = tid & 63, w = tid >> 6, c = lane & 15, q4 = lane >> 4;
    bf16_t* KT = (bf16_t*)lds_g;
    float* SSQ = (float*)(lds_g + 36864);
    const float nw = p.gdn_norm_w[16 * w + c];
    int par = 0;
    for (int item = blockIdx.x; item < 768; item += gridDim.x) {
        int chunk0, nch, h; const float* s0 = nullptr; float* sout;
        if (item < 256) { const int b = item >> 4; h = item & 15; chunk0 = b * 64; nch = 64; sout = p.out + O_REC_P + ((size_t)b * 16 + h) * 16384; }
        else { const int b = (item - 256) >> 4; h = item & 15; chunk0 = 1024 + b; nch = 1; s0 = p.state_rec + ((size_t)b * 16 + h) * 16384; sout = p.out + O_REC_S + ((size_t)b * 16 + h) * 16384; }
        const int hk = h >> 1;
        f32x4 S[8];
#pragma unroll
        for (int mt = 0; mt < 8; ++mt) {
            if (s0) {
#pragma unroll
                for (int e = 0; e < 4; ++e) S[mt][e] = s0[(size_t)(16 * mt + 4 * q4 + e) * 128 + 16 * w + c]; }
            else S[mt] = (f32x4){0.f, 0.f, 0.f, 0.f};
        }
        for (int n = 0; n < nch; ++n, par ^= 1) {
            const int chunk = chunk0 + n; const size_t t0 = (size_t)chunk * 64; const size_t ci = (size_t)chunk * 16 + h;
            const bf16_t* kb = QKV + t0 * 4096 + 1024 + hk * 128; const bf16_t* qb = QKV + t0 * 4096 + hk * 128;
            bf16_t* vb = QKV + t0 * 4096 + 2048 + h * 128 + 16 * w + c;
            bf16_t* kt = KT + par * (128 * 72); float* ssq = SSQ + par * 512;
            { const int row = tid & 63, seg = tid >> 6; const u32x4 a = *(const u32x4*)(kb + (size_t)row * 4096 + seg * 16), b = *(const u32x4*)(kb + (size_t)row * 4096 + seg * 16 + 8);
              const unsigned ww[8] = {a.x, a.y, a.z, a.w, b.x, b.y, b.z, b.w};
#pragma unroll
              for (int j = 0; j < 8; ++j) { kt[(seg * 16 + 2 * j) * 72 + row] = (bf16_t)(ww[j] & 0xffffu); kt[(seg * 16 + 2 * j + 1) * 72 + row] = (bf16_t)(ww[j] >> 16); } }
            const float* gcp = GC + ci * 64; const float gl = gcp[63]; const float egl = __expf(gl);
            f32x4 egc[4], edl[4];
#pragma unroll
            for (int mt = 0; mt < 4; ++mt) { const f32x4 g4 = *(const f32x4*)(gcp + 16 * mt + 4 * q4);
#pragma unroll
                for (int e = 0; e < 4; ++e) { egc[mt][e] = __expf(g4[e]); edl[mt][e] = __expf(gl - g4[e]); } }
            bf16x8 Sb[4];
#pragma unroll
            for (int ks = 0; ks < 4; ++ks) Sb[ks] = pack_acc2(S[2 * ks], S[2 * ks + 1]);
            f32x4 P[4], QS[4];
#pragma unroll
            for (int mt = 0; mt < 4; ++mt) { P[mt] = (f32x4){0.f, 0.f, 0.f, 0.f}; QS[mt] = (f32x4){0.f, 0.f, 0.f, 0.f};
#pragma unroll
                for (int ks = 0; ks < 4; ++ks) { const bf16x8 ka = ld_perm(kb + (size_t)(16 * mt + c) * 4096 + 32 * ks + 4 * q4); P[mt] = __builtin_amdgcn_mfma_f32_16x16x32_bf16(ka, Sb[ks], P[mt], 0, 0, 0);
                    const bf16x8 qa = ld_perm(qb + (size_t)(16 * mt + c) * 4096 + 32 * ks + 4 * q4); QS[mt] = __builtin_amdgcn_mfma_f32_16x16x32_bf16(qa, Sb[ks], QS[mt], 0, 0, 0); } }
            f32x4 R[4];
#pragma unroll
            for (int mt = 0; mt < 4; ++mt)
#pragma unroll
                for (int e = 0; e < 4; ++e) { const float v = __uint_as_float(((unsigned)vb[(size_t)(16 * mt + 4 * q4 + e) * 4096]) << 16); R[mt][e] = v - egc[mt][e] * P[mt][e]; }
            bf16x8 Rb[2];
#pragma unroll
            for (int k2 = 0; k2 < 2; ++k2) Rb[k2] = pack_acc2(R[2 * k2], R[2 * k2 + 1]);
            f32x4 Vn[4];
#pragma unroll
            for (int mt = 0; mt < 4; ++mt) { Vn[mt] = (f32x4){0.f, 0.f, 0.f, 0.f};
#pragma unroll
                for (int k2 = 0; k2 < 2; ++k2) { const bf16x8 aa = ld_perm(AH + (ci * 64 + 16 * mt + c) * 64 + 32 * k2 + 4 * q4); Vn[mt] = __builtin_amdgcn_mfma_f32_16x16x32_bf16(aa, Rb[k2], Vn[mt], 0, 0, 0); } }
            bf16x8 Vb[2], Vsb[2];
#pragma unroll
            for (int k2 = 0; k2 < 2; ++k2) { Vb[k2] = pack_acc2(Vn[2 * k2], Vn[2 * k2 + 1]); Vsb[k2] = pack_acc2(Vn[2 * k2] * edl[2 * k2], Vn[2 * k2 + 1] * edl[2 * k2 + 1]); }
            f32x4 O[4];
#pragma unroll
            for (int mt = 0; mt < 4; ++mt) { O[mt] = QS[mt] * egc[mt];
#pragma unroll
                for (int k2 = 0; k2 < 2; ++k2) { const bf16x8 aa = ld_perm(AQK + (ci * 64 + 16 * mt + c) * 64 + 32 * k2 + 4 * q4); O[mt] = __builtin_amdgcn_mfma_f32_16x16x32_bf16(aa, Vb[k2], O[mt], 0, 0, 0); } }
#pragma unroll
            for (int mt = 0; mt < 4; ++mt) { f32x4 sq = O[mt] * O[mt];
#pragma unroll
                for (int o = 1; o < 16; o <<= 1) { sq[0] += __shfl_xor(sq[0], o); sq[1] += __shfl_xor(sq[1], o); sq[2] += __shfl_xor(sq[2], o); sq[3] += __shfl_xor(sq[3], o); }
                if (c == 0) *(f32x4*)(ssq + w * 64 + 16 * mt + 4 * q4) = sq; }
            __syncthreads();
#pragma unroll
            for (int mt = 0; mt < 8; ++mt) { S[mt] = S[mt] * egl;
#pragma unroll
                for (int k2 = 0; k2 < 2; ++k2) { const bf16_t* kp = kt + (16 * mt + c) * 72 + 32 * k2 + 4 * q4; const u32x2 a = *(const u32x2*)kp, b = *(const u32x2*)(kp + 16); u32x4 ww; ww.x = a.x; ww.y = a.y; ww.z = b.x; ww.w = b.y;
                    S[mt] = __builtin_amdgcn_mfma_f32_16x16x32_bf16(__builtin_bit_cast(bf16x8, ww), Vsb[k2], S[mt], 0, 0, 0); } }
#pragma unroll
            for (int mt = 0; mt < 4; ++mt) { f32x4 tot = (f32x4){0.f, 0.f, 0.f, 0.f};
#pragma unroll
                for (int ww = 0; ww < 8; ++ww) tot += *(const f32x4*)(ssq + ww * 64 + 16 * mt + 4 * q4);
#pragma unroll
                for (int e = 0; e < 4; ++e) { const float r = rsqrtf(tot[e] * (1.0f / 128.0f) + EPS); vb[(size_t)(16 * mt + 4 * q4 + e) * 4096] = (bf16_t)(cvt_pk_bf16(O[mt][e] * r * nw, 0.f) & 0xffffu); } }
            __syncthreads();
        }
#pragma unroll
        for (int mt = 0; mt < 8; ++mt)
#pragma unroll
            for (int e = 0; e < 4; ++e) sout[(size_t)(16 * mt + 4 * q4 + e) * 128 + 16 * w + c] = S[mt][e];
    }
}

constexpr int N_PHASES = 14;
#ifndef PH_MASK
#define PH_MASK 0x3fff
#endif
#define PH_ON(n) (((PH_MASK) >> (n)) & 1)
__global__ void __launch_bounds__(NT, 2) mega(Params p, int ph_lo, int ph_hi) {
    extern __shared__ __attribute__((aligned(16))) unsigned char lds[];
    LAS unsigned char* ldsl = (LAS unsigned char*)lds;
    cg::grid_group grid = cg::this_grid();
    unsigned char* ws = p.ws;
    bf16_t* W1t = (bf16_t*)(ws + WS_W1T); bf16_t* Wgt = (bf16_t*)(ws + WS_WGT); bf16_t* W2t = (bf16_t*)(ws + WS_W2T); bf16_t* W3t = (bf16_t*)(ws + WS_W3T); bf16_t* W4t = (bf16_t*)(ws + WS_W4T);
    float* mod = (float*)(ws + WS_MOD); bf16_t* H = (bf16_t*)(ws + WS_H); bf16_t* R1 = (bf16_t*)(ws + WS_R1); bf16_t* R2 = (bf16_t*)(ws + WS_R2); bf16_t* R3 = (bf16_t*)(ws + WS_R3);
    float* X1 = (float*)(ws + WS_R3);
    const int G = gridDim.x, bid = blockIdx.x;
#define IN(k) (ph_lo <= (k) && (k) < ph_hi)
#define SEAM(k) do { if (IN(k) && IN((k) + 1)) grid.sync(); } while (0)
    if (PH_ON(0) && IN(0)) { phase_prep(p, lds); }
    SEAM(0);
    if (PH_ON(1) && IN(1)) { phase_norm_mod(p.x_prompt, p.x_sample, p.norm_gain, mod, H); }
    SEAM(1);
    if (PH_ON(2) && IN(2)) { { pg8::Gemm g{H, W1t, T, 4096, 1024, 1024, 1024, 0, 0}; pg8::StaticOrder S; S.init(T, 4096, G, bid); pg8::EpiL0In E{R1, R2}; pg8::gemm_phase(ldsl, g, S, E); } }
    SEAM(2);
    if (PH_ON(3) && IN(3)) { phase_pool(p); }
    SEAM(3);
    if (PH_ON(4) && IN(4)) { { pg8::Gemm g{R3, Wgt, T, 2048, 512, 2048, 512, 2, 1024}; pg8::StaticOrder S; S.init(T, 2048, G, bid); pg8::EpiGrp E{R1, R2, p.pool_scale}; pg8::gemm_phase(ldsl, g, S, E); } }
    SEAM(4);
    if (PH_ON(5) && IN(5)) { { pg8::Gemm g{R1, W2t, T, 1024, 2048, 2048, 2048, 0, 0}; pg8::StaticOrder S; S.init(T, 1024, G, bid); pg8::EpiRes E{p.x_prompt, p.x_sample, X1, mod + 2048}; pg8::gemm_phase(ldsl, g, S, E); } }
    SEAM(5);
    if (PH_ON(6) && IN(6)) { phase_norm_mod(X1, X1 + (size_t)TP * 1024, p.norm_gain + 1024, mod + 48 * 3072, H); }
    SEAM(6);
    if (PH_ON(7) && IN(7)) { { pg8::Gemm g{H, W3t, T, 4352, 1024, 1024, 1024, 0, 0}; pg8::StaticOrder S; S.init(T, 4352, G, bid); pg8::EpiL1In E{R1, (bf16_t*)(ws + WS_STASH), (float*)(ws + WS_AB)}; pg8::gemm_phase(ldsl, g, S, E); } }
    SEAM(7);
    if (PH_ON(8) && IN(8)) { phase_conv(p); }
    SEAM(8);
    if (PH_ON(9) && IN(9)) { phase_j1(p, lds); }
    SEAM(9);
    if (PH_ON(10) && IN(10)) { phase_j2(p, lds); }
    SEAM(10);
    if (PH_ON(11) && IN(11)) { { pg8::Gemm g{H, W3t + (size_t)4352 * 1024, T, 2048, 1024, 1024, 1024, 0, 0}; pg8::StaticOrder S; S.init(T, 2048, G, bid); pg8::EpiZ E{R1}; pg8::gemm_phase(ldsl, g, S, E); } }
    SEAM(11);
    if (PH_ON(12) && IN(12)) { { pg8::Gemm g{R1 + 2048, W4t, T, 1024, 2048, 4096, 2048, 0, 0}; pg8::StaticOrder S; S.init(T, 1024, G, bid); pg8::EpiRes E{X1, X1 + (size_t)TP * 1024, X1, mod + 48 * 3072 + 2048}; pg8::gemm_phase(ldsl, g, S, E); } }
    SEAM(12);
    if (PH_ON(13) && IN(13)) { phase_norm_final(X1, p.final_gain, p.out + O_Y); }
    SEAM(13);
#undef IN
#undef SEAM
}

#ifndef MK_ONE_LAUNCH
#define MK_ONE_LAUNCH 1
#endif
extern "C" void kernel_launch(void* const* d_in, const int* in_sizes, int n_in, void* d_out, int out_size, void* d_ws, size_t ws_size, hipStream_t stream) {
    static int grid = 0;
    if (grid == 0) {
        if (ws_size < WS_END) { fprintf(stderr, "kernel_launch: workspace too small: %zu < %zu\n", ws_size, (size_t)WS_END); grid = -1; return; }
        int dev = 0, cus = 0, per_cu = 0;
        hipGetDevice(&dev); hipDeviceGetAttribute(&cus, hipDeviceAttributeMultiprocessorCount, dev);
        if (hipFuncSetAttribute((const void*)mega, hipFuncAttributeMaxDynamicSharedMemorySize, LDS_BYTES) != hipSuccess) { fprintf(stderr, "kernel_launch: hipFuncSetAttribute failed\n"); grid = -1; return; }
        if (hipOccupancyMaxActiveBlocksPerMultiprocessor(&per_cu, (const void*)mega, NT, LDS_BYTES) != hipSuccess || per_cu < 1) { fprintf(stderr, "kernel_launch: occupancy query gave %d\n", per_cu); per_cu = 1; }
        (void)hipGetLastError();
        grid = cus * per_cu;
    }
    if (grid < 0) return;
    Params p{};
    p.x_prompt = (const float*)d_in[0]; p.x_sample = (const float*)d_in[1]; p.c_prompt = (const float*)d_in[2]; p.c_sample = (const float*)d_in[3];
    p.state_pool = (const float*)d_in[4]; p.state_conv = (const float*)d_in[5]; p.state_rec = (const float*)d_in[6];
    p.norm_gain = (const float*)d_in[7]; p.ada_w = (const float*)d_in[8]; p.ada_b = (const float*)d_in[9];
    p.pool_w_in = (const float*)d_in[10]; p.pool_w_group = (const float*)d_in[11]; p.pool_scale = (const float*)d_in[12]; p.pool_w_out = (const float*)d_in[13];
    p.gdn_w_in = (const float*)d_in[14]; p.gdn_conv_w = (const float*)d_in[15]; p.gdn_a_log = (const float*)d_in[16]; p.gdn_dt_bias = (const float*)d_in[17]; p.gdn_norm_w = (const float*)d_in[18]; p.gdn_w_out = (const float*)d_in[19];
    p.final_gain = (const float*)d_in[20];
    p.out = (float*)d_out; p.ws = (unsigned char*)d_ws;
#if MK_ONE_LAUNCH
    int lo = 0, hi = N_PHASES; void* args[] = {&p, &lo, &hi};
    hipError_t e = hipLaunchCooperativeKernel((const void*)mega, dim3(grid), dim3(NT), args, LDS_BYTES, stream);
    if (e != hipSuccess) fprintf(stderr, "cooperative launch failed: %s (grid %d)\n", hipGetErrorString(e), grid);
#else
    for (int ph = 0; ph < N_PHASES; ++ph) { hipLaunchKernelGGL(mega, dim3(grid), dim3(NT), LDS_BYTES, stream, p, ph, ph + 1); }
#endif
}
```

```cpp
#include <hip/hip_runtime.h>
#include <hip/hip_cooperative_groups.h>
#include <cstdio>
namespace cg = cooperative_groups;

#define LAS __attribute__((address_space(3)))
typedef unsigned short bf16_t;
typedef short bf16x8 __attribute__((ext_vector_type(8)));
typedef short bf16x4 __attribute__((ext_vector_type(4)));
typedef float f32x4 __attribute__((ext_vector_type(4)));
typedef unsigned u32x4 __attribute__((ext_vector_type(4)));
typedef unsigned u32x2 __attribute__((ext_vector_type(2)));

constexpr int DM = 1024, TP = 65536, TS = 2048, T = TP + TS, NSEQ = 48, NCHUNK = T / 64;
constexpr int NT = 512, LDS_BYTES = 147456;
constexpr float EPS = 1e-6f;

constexpr size_t SZ_BIG = (size_t)T * 2048 * 2;
constexpr size_t WS_W1T = 0;
constexpr size_t WS_WGT = WS_W1T + (size_t)4096 * 1024 * 2;
constexpr size_t WS_W2T = WS_WGT + (size_t)2048 * 512 * 2;
constexpr size_t WS_W3T = WS_W2T + (size_t)1024 * 2048 * 2;
constexpr size_t WS_W4T = WS_W3T + (size_t)6400 * 1024 * 2;
constexpr size_t WS_MOD = WS_W4T + (size_t)1024 * 2048 * 2;
constexpr size_t WS_AB = WS_MOD + (size_t)2 * 48 * 3072 * 4;
constexpr size_t WS_GC = WS_AB + (size_t)T * 32 * 4;
constexpr size_t WS_BETA = WS_GC + (size_t)T * 16 * 4;
constexpr size_t WS_STASH = WS_BETA + (size_t)T * 16 * 4;
constexpr size_t WS_H = WS_STASH + (size_t)NCHUNK * 3 * 4096 * 2;
constexpr size_t WS_R1 = WS_H + (size_t)T * 1024 * 2;
constexpr size_t WS_R2 = WS_R1 + SZ_BIG;
constexpr size_t WS_R3 = WS_R2 + SZ_BIG;
constexpr size_t WS_END = WS_R3 + SZ_BIG;

constexpr size_t O_Y = 0;
constexpr size_t O_POOL_P = (size_t)T * 1024;
constexpr size_t O_CONV_P = O_POOL_P + (size_t)16 * 15 * 2048;
constexpr size_t O_REC_P = O_CONV_P + (size_t)16 * 3 * 4096;
constexpr size_t O_POOL_S = O_REC_P + (size_t)16 * 16 * 16384;
constexpr size_t O_CONV_S = O_POOL_S + (size_t)32 * 15 * 2048;
constexpr size_t O_REC_S = O_CONV_S + (size_t)32 * 3 * 4096;

struct Params {
    const float* x_prompt; const float* x_sample; const float* c_prompt; const float* c_sample;
    const float* state_pool; const float* state_conv; const float* state_rec;
    const float* norm_gain; const float* ada_w; const float* ada_b;
    const float* pool_w_in; const float* pool_w_group; const float* pool_scale; const float* pool_w_out;
    const float* gdn_w_in; const float* gdn_conv_w; const float* gdn_a_log; const float* gdn_dt_bias; const float* gdn_norm_w; const float* gdn_w_out;
    const float* final_gain;
    float* out; unsigned char* ws;
};

__device__ __forceinline__ unsigned cvt_pk_bf16(float lo, float hi) { unsigned r; asm volatile("v_cvt_pk_bf16_f32 %0, %1, %2" : "=v"(r) : "v"(lo), "v"(hi)); return r; }
__device__ __forceinline__ float bf_lo(unsigned w) { return __uint_as_float(w << 16); }
__device__ __forceinline__ float bf_hi(unsigned w) { return __uint_as_float(w & 0xffff0000u); }
__device__ __forceinline__ float silu_f(float x) { return x * __builtin_amdgcn_rcpf(1.0f + __expf(-x)); }
__device__ __forceinline__ void unpack8(const u32x4 w, float (&f)[8]) { f[0] = bf_lo(w.x); f[1] = bf_hi(w.x); f[2] = bf_lo(w.y); f[3] = bf_hi(w.y); f[4] = bf_lo(w.z); f[5] = bf_hi(w.z); f[6] = bf_lo(w.w); f[7] = bf_hi(w.w); }
__device__ __forceinline__ u32x4 pack8(const float (&f)[8]) { u32x4 w; w.x = cvt_pk_bf16(f[0], f[1]); w.y = cvt_pk_bf16(f[2], f[3]); w.z = cvt_pk_bf16(f[4], f[5]); w.w = cvt_pk_bf16(f[6], f[7]); return w; }
__device__ __forceinline__ int seq_of_row(int row) { return row < TP ? (row >> 12) : 16 + ((row - TP) >> 6); }

namespace pg8 {
constexpr int BM = 256, BK = 64, HALF = 128, HTB = HALF * BK * 2, STAGE_BYTES = 8 * HTB, NXCD = 8, WGM = 8;
__device__ __forceinline__ int lds_byte(int r, int c) { const int st = (r >> 4) * 2 + (c >> 5), rr = r & 15, cc = c & 31, ob = rr * 64 + cc * 2; return st * 1024 + (ob ^ (((ob >> 9) & 1) << 5)); }
__device__ __forceinline__ void stage_rc(int b, int& R, int& C) { const int st = b / 1024, sb = b % 1024, swz = sb ^ (((sb >> 9) & 1) << 5); R = (st >> 1) * 16 + swz / 64; C = (st & 1) * 32 + (swz % 64) / 2; }
__device__ __forceinline__ int perm32(int rho) { const int n = rho >> 4, i = rho & 15; return 8 * (i >> 2) + 4 * n + (i & 3); }
struct Unit { int pm, pn; };
struct Gemm { const bf16_t* A; const bf16_t* Bt; int M, N, K, lda, ldb, a_grp_div; long a_gstride; };
struct StaticOrder {
    int nM, nN, nwg, G, c;
    __device__ void init(int M, int N, int G_, int c_) { nM = M / BM; nN = N / BM; nwg = nM * nN; G = G_; c = c_; }
    __device__ bool next(int i, Unit& u) const {
        const long L = (long)i * G + c; if (L >= nwg) return false;
        int wgid = (int)L; { const int q = nwg / NXCD, r = nwg % NXCD, xcd = wgid % NXCD, off = wgid / NXCD; wgid = (xcd < r ? xcd * (q + 1) : r * (q + 1) + (xcd - r) * q) + off; }
        const int nig = WGM * nN, gid = wgid / nig, fm = gid * WGM, gsz = (nM - fm) < WGM ? (nM - fm) : WGM;
        u.pm = fm + ((wgid % nig) % gsz); u.pn = (wgid % nig) / gsz; return true;
    }
};

template <class Epi>
__device__ __forceinline__ void gemm_phase(LAS unsigned char* lds, const Gemm g, const StaticOrder& S, const Epi& E) {
    const int tid = threadIdx.x, wid = __builtin_amdgcn_readfirstlane(tid >> 6), lane = tid & 63, wr = wid >> 2, wc = wid & 3, fr = lane & 15, fq = lane >> 4;
    const int K = g.K, nt = K / BK;
    unsigned voffA[2], voffB[2];
#pragma unroll
    for (int i = 0; i < 2; ++i) { int R, C; stage_rc(tid * 16 + i * 8192, R, C); const int Rb = Epi::PERM ? ((R & ~31) + perm32(R & 31)) : R;
        voffA[i] = (unsigned)(R * g.lda + C) * 2u; voffB[i] = (unsigned)(Rb * g.ldb + C) * 2u; }
    const size_t kstep = (size_t)(BK * 2);
    const size_t hsA = (size_t)HALF * g.lda * 2, hsB = (size_t)HALF * g.ldb * 2;
    const size_t tsA = 2 * hsA, tsB = 2 * hsB;
    const unsigned ldsw = (unsigned)wid * 1024u;
    const int aoff = lds_byte(wr * 64 + fr, fq * 8), boff = lds_byte(wc * 32 + fr, fq * 8);
#define PG8_SA(b, h) (((b) * 2 + (h)) * HTB)
#define PG8_SB(b, h) ((4 + (b) * 2 + (h)) * HTB)
#define PG8_STAGE(bufoff, gbase, voff) do { _Pragma("unroll") for (int _i = 0; _i < 2; ++_i) \
        __builtin_amdgcn_global_load_lds((const unsigned*)((const char*)(gbase) + (voff)[_i]), (LAS unsigned*)(lds + (bufoff) + ldsw + _i * 8192), 16, 0, 0); } while (0)
#define PG8_LDA(dst, b, h) do { _Pragma("unroll") for (int m = 0; m < 4; ++m) _Pragma("unroll") for (int k = 0; k < 2; ++k) dst[m][k] = *(const LAS bf16x8*)(lds + PG8_SA(b, h) + aoff + m * 2048 + k * 1024); } while (0)
#define PG8_LDB(dst, b, h) do { _Pragma("unroll") for (int n = 0; n < 2; ++n) _Pragma("unroll") for (int k = 0; k < 2; ++k) dst[n][k] = *(const LAS bf16x8*)(lds + PG8_SB(b, h) + boff + n * 2048 + k * 1024); } while (0)
#define PG8_MMA(ai, bj, At, Bt) do { __builtin_amdgcn_s_setprio(1); _Pragma("unroll") for (int m = 0; m < 4; ++m) _Pragma("unroll") for (int n = 0; n < 2; ++n) _Pragma("unroll") for (int k = 0; k < 2; ++k) \
        acc[ai][bj][m][n] = __builtin_amdgcn_mfma_f32_16x16x32_bf16(Bt[n][k], At[m][k], acc[ai][bj][m][n], 0, 0, 0); __builtin_amdgcn_s_setprio(0); } while (0)
#define PG8_WAIT_V(n) asm volatile("s_waitcnt vmcnt(" #n ")" ::: "memory")
#define PG8_WAIT_L(n) asm volatile("s_waitcnt lgkmcnt(" #n ")" ::: "memory")
#define PG8_BAR __builtin_amdgcn_s_barrier()
#define PG8_SCHED __builtin_amdgcn_sched_barrier(0)
#define PG8_APTR(u) ((const char*)g.A + (size_t)(u).pm * tsA + (g.a_grp_div ? (size_t)((u).pn / g.a_grp_div) * (size_t)g.a_gstride : (size_t)0))
#define PG8_BPTR(u) ((const char*)g.Bt + (size_t)(u).pn * tsB)
    Unit cur, nxt; int ui = 0;
    if (!S.next(0, cur)) return;
    f32x4 acc[2][2][4][2];
#pragma unroll
    for (int a = 0; a < 2; ++a)
#pragma unroll
        for (int b = 0; b < 2; ++b)
#pragma unroll
            for (int m = 0; m < 4; ++m)
#pragma unroll
                for (int n = 0; n < 2; ++n) acc[a][b][m][n] = (f32x4){0.f, 0.f, 0.f, 0.f};
    bf16x8 At[4][2], B0[2][2], B1[2][2];
    const char* cA = PG8_APTR(cur); const char* cB = PG8_BPTR(cur);
    PG8_STAGE(PG8_SB(0, 0), cB, voffB); PG8_STAGE(PG8_SA(0, 0), cA, voffA); PG8_STAGE(PG8_SB(0, 1), cB + hsB, voffB); PG8_STAGE(PG8_SA(0, 1), cA + hsA, voffA);
    if (wr == 1) PG8_BAR;
    PG8_WAIT_V(4); PG8_BAR;
    PG8_STAGE(PG8_SB(1, 0), cB + kstep, voffB); PG8_STAGE(PG8_SA(1, 0), cA + kstep, voffA); PG8_STAGE(PG8_SB(1, 1), cB + hsB + kstep, voffB);
    PG8_WAIT_V(6); PG8_BAR;
    for (;;) {
        const bool has_next = S.next(ui + 1, nxt);
        const char* nA = has_next ? PG8_APTR(nxt) : cA; const char* nB = has_next ? PG8_BPTR(nxt) : cB;
        for (int t = 0; t < nt; t += 2) {
            const bool last = (t == nt - 2);
            const char* a1 = cA + (size_t)(t + 1) * kstep;
            const char* a2 = last ? nA : cA + (size_t)(t + 2) * kstep; const char* b2 = last ? nB : cB + (size_t)(t + 2) * kstep;
            const char* a3 = a2 + kstep; const char* b3 = b2 + kstep;
            PG8_LDB(B0, 0, 0); PG8_SCHED; PG8_LDA(At, 0, 0); PG8_STAGE(PG8_SA(1, 1), a1 + hsA, voffA);
            PG8_WAIT_L(8); PG8_BAR; PG8_WAIT_L(0); PG8_MMA(0, 0, At, B0); PG8_BAR; PG8_SCHED;
            PG8_LDB(B1, 0, 1); PG8_STAGE(PG8_SB(0, 0), b2, voffB);
            PG8_BAR; PG8_WAIT_L(0); PG8_MMA(0, 1, At, B1); PG8_BAR;
            PG8_LDA(At, 0, 1); PG8_STAGE(PG8_SA(0, 0), a2, voffA);
            PG8_BAR; PG8_WAIT_L(0); PG8_MMA(1, 0, At, B0); PG8_BAR; PG8_SCHED;
            PG8_STAGE(PG8_SB(0, 1), b2 + hsB, voffB);
            PG8_WAIT_V(6); PG8_BAR; PG8_MMA(1, 1, At, B1); PG8_BAR;
            PG8_LDB(B0, 1, 0); PG8_SCHED; PG8_LDA(At, 1, 0); PG8_STAGE(PG8_SA(0, 1), a2 + hsA, voffA);
            PG8_WAIT_L(8); PG8_BAR; PG8_WAIT_L(0); PG8_MMA(0, 0, At, B0); PG8_BAR; PG8_SCHED;
            PG8_LDB(B1, 1, 1); PG8_STAGE(PG8_SB(1, 0), b3, voffB);
            PG8_BAR; PG8_WAIT_L(0); PG8_MMA(0, 1, At, B1); PG8_BAR;
            PG8_LDA(At, 1, 1); PG8_STAGE(PG8_SA(1, 0), a3, voffA);
            PG8_BAR; PG8_WAIT_L(0); PG8_MMA(1, 0, At, B0); PG8_BAR; PG8_SCHED;
            PG8_STAGE(PG8_SB(1, 1), b3 + hsB, voffB);
            PG8_WAIT_V(6); PG8_BAR; PG8_MMA(1, 1, At, B1); PG8_BAR;
        }
        E(acc, cur, wr, wc, fr, fq);
        if (!has_next) break;
#pragma unroll
        for (int a = 0; a < 2; ++a)
#pragma unroll
            for (int b = 0; b < 2; ++b)
#pragma unroll
                for (int m = 0; m < 4; ++m)
#pragma unroll
                    for (int n = 0; n < 2; ++n) acc[a][b][m][n] = (f32x4){0.f, 0.f, 0.f, 0.f};
        cur = nxt; cA = nA; cB = nB; ++ui;
    }
    PG8_WAIT_V(0);
    if (wr == 0) PG8_BAR;
    PG8_BAR;
#undef PG8_SA
#undef PG8_SB
#undef PG8_STAGE
#undef PG8_LDA
#undef PG8_LDB
#undef PG8_MMA
#undef PG8_WAIT_V
#undef PG8_WAIT_L
#undef PG8_BAR
#undef PG8_SCHED
#undef PG8_APTR
#undef PG8_BPTR
}

struct EpiL0In {
    static constexpr bool PERM = true;
    bf16_t* U; bf16_t* SZ;
    __device__ __forceinline__ void operator()(const f32x4 (&acc)[2][2][4][2], const Unit& u, int wr, int wc, int fr, int fq) const {
        const int row0 = u.pm * BM + wr * 64 + fr; const bool isz = u.pn >= 8;
        bf16_t* base = isz ? SZ : U; const int col0 = (isz ? u.pn - 8 : u.pn) * BM + wc * 32 + 8 * fq;
#pragma unroll
        for (int ai = 0; ai < 2; ++ai)
#pragma unroll
            for (int m = 0; m < 4; ++m) { bf16_t* rowp = base + (size_t)(row0 + ai * HALF + m * 16) * 2048 + col0;
#pragma unroll
                for (int bj = 0; bj < 2; ++bj) { f32x4 v0 = acc[ai][bj][m][0], v1 = acc[ai][bj][m][1];
                    if (isz) {
#pragma unroll
                        for (int j = 0; j < 4; ++j) { v0[j] = silu_f(v0[j]); v1[j] = silu_f(v1[j]); } }
                    u32x4 w; w.x = cvt_pk_bf16(v0[0], v0[1]); w.y = cvt_pk_bf16(v0[2], v0[3]); w.z = cvt_pk_bf16(v1[0], v1[1]); w.w = cvt_pk_bf16(v1[2], v1[3]);
                    *(u32x4*)(rowp + bj * HALF) = w; } }
    }
};
struct EpiGrp {
    static constexpr bool PERM = true;
    bf16_t* YY; const bf16_t* SZ; const float* scale;
    __device__ __forceinline__ void operator()(const f32x4 (&acc)[2][2][4][2], const Unit& u, int wr, int wc, int fr, int fq) const {
        const int row0 = u.pm * BM + wr * 64 + fr; const int col0 = u.pn * BM + wc * 32 + 8 * fq;
        f32x4 sc[2][2];
#pragma unroll
        for (int bj = 0; bj < 2; ++bj) { sc[bj][0] = *(const f32x4*)(scale + col0 + bj * HALF); sc[bj][1] = *(const f32x4*)(scale + col0 + bj * HALF + 4); }
#pragma unroll
        for (int ai = 0; ai < 2; ++ai)
#pragma unroll
            for (int m = 0; m < 4; ++m) { const size_t off = (size_t)(row0 + ai * HALF + m * 16) * 2048 + col0;
#pragma unroll
                for (int bj = 0; bj < 2; ++bj) { const u32x4 z = *(const u32x4*)(SZ + off + bj * HALF); float zf[8]; unpack8(z, zf);
                    const f32x4 v0 = acc[ai][bj][m][0] * sc[bj][0], v1 = acc[ai][bj][m][1] * sc[bj][1];
                    u32x4 w; w.x = cvt_pk_bf16(v0[0] * zf[0], v0[1] * zf[1]); w.y = cvt_pk_bf16(v0[2] * zf[2], v0[3] * zf[3]); w.z = cvt_pk_bf16(v1[0] * zf[4], v1[1] * zf[5]); w.w = cvt_pk_bf16(v1[2] * zf[6], v1[3] * zf[7]);
                    *(u32x4*)(YY + off + bj * HALF) = w; } }
    }
};
struct EpiRes {
    static constexpr bool PERM = false;
    const float* base_lo; const float* base_hi; float* OUT; const float* gate;
    __device__ __forceinline__ void operator()(const f32x4 (&acc)[2][2][4][2], const Unit& u, int wr, int wc, int fr, int fq) const {
        const int row0 = u.pm * BM + wr * 64 + fr, col0 = u.pn * BM + wc * 32 + 4 * fq;
#pragma unroll
        for (int ai = 0; ai < 2; ++ai)
#pragma unroll
            for (int m = 0; m < 4; ++m) { const int row = row0 + ai * HALF + m * 16; const float* gp = gate + (size_t)seq_of_row(row) * 3072 + col0;
                const float* bp = (row < TP ? base_lo + (size_t)row * 1024 : base_hi + (size_t)(row - TP) * 1024) + col0; float* op = OUT + (size_t)row * 1024 + col0;
#pragma unroll
                for (int bj = 0; bj < 2; ++bj)
#pragma unroll
                    for (int n = 0; n < 2; ++n) { const f32x4 gv = *(const f32x4*)(gp + bj * HALF + n * 16); const f32x4 bs = *(const f32x4*)(bp + bj * HALF + n * 16);
                        *(f32x4*)(op + bj * HALF + n * 16) = bs + gv * acc[ai][bj][m][n]; } }
    }
};
struct EpiL1In {
    static constexpr bool PERM = true;
    bf16_t* QKV; bf16_t* STASH; float* AB;
    __device__ __forceinline__ void operator()(const f32x4 (&acc)[2][2][4][2], const Unit& u, int wr, int wc, int fr, int fq) const {
        const int row0 = u.pm * BM + wr * 64 + fr;
        if (u.pn < 16) {
            const int col0 = u.pn * BM + wc * 32 + 8 * fq;
#pragma unroll
            for (int ai = 0; ai < 2; ++ai)
#pragma unroll
                for (int m = 0; m < 4; ++m) { const int row = row0 + ai * HALF + m * 16; bf16_t* rowp = QKV + (size_t)row * 4096 + col0; const int rl = row & 63;
#pragma unroll
                    for (int bj = 0; bj < 2; ++bj) { const f32x4 v0 = acc[ai][bj][m][0], v1 = acc[ai][bj][m][1];
                        u32x4 w; w.x = cvt_pk_bf16(v0[0], v0[1]); w.y = cvt_pk_bf16(v0[2], v0[3]); w.z = cvt_pk_bf16(v1[0], v1[1]); w.w = cvt_pk_bf16(v1[2], v1[3]);
                        *(u32x4*)(rowp + bj * HALF) = w;
                        if (rl >= 61) *(u32x4*)(STASH + ((size_t)(row >> 6) * 3 + (rl - 61)) * 4096 + col0 + bj * HALF) = w; } }
        } else if (wc == 0) {
#pragma unroll
            for (int ai = 0; ai < 2; ++ai)
#pragma unroll
                for (int m = 0; m < 4; ++m) { const int row = row0 + ai * HALF + m * 16; float* rowp = AB + (size_t)row * 32 + 8 * fq;
                    *(f32x4*)(rowp) = acc[ai][0][m][0]; *(f32x4*)(rowp + 4) = acc[ai][0][m][1]; }
        }
    }
};
struct EpiZ {
    static constexpr bool PERM = true;
    bf16_t* QKV;
    __device__ __forceinline__ void operator()(const f32x4 (&acc)[2][2][4][2], const Unit& u, int wr, int wc, int fr, int fq) const {
        const int row0 = u.pm * BM + wr * 64 + fr; const int col0 = 2048 + u.pn * BM + wc * 32 + 8 * fq;
#pragma unroll
        for (int ai = 0; ai < 2; ++ai)
#pragma unroll
            for (int m = 0; m < 4; ++m) { bf16_t* rowp = QKV + (size_t)(row0 + ai * HALF + m * 16) * 4096 + col0;
#pragma unroll
                for (int bj = 0; bj < 2; ++bj) { const u32x4 o = *(const u32x4*)(rowp + bj * HALF); float of[8]; unpack8(o, of);
                    const f32x4 v0 = acc[ai][bj][m][0], v1 = acc[ai][bj][m][1];
                    u32x4 w; w.x = cvt_pk_bf16(of[0] * silu_f(v0[0]), of[1] * silu_f(v0[1])); w.y = cvt_pk_bf16(of[2] * silu_f(v0[2]), of[3] * silu_f(v0[3]));
                    w.z = cvt_pk_bf16(of[4] * silu_f(v1[0]), of[5] * silu_f(v1[1])); w.w = cvt_pk_bf16(of[6] * silu_f(v1[2]), of[7] * silu_f(v1[3]));
                    *(u32x4*)(rowp + bj * HALF) = w; } }
    }
};
}

__device__ void transpose_tile(const float* src, int ld_src, int k0, int ncol0, int ncols_valid, bf16_t* dst, int ld_dst, int dst_row0, float* tile) {
    const int tid = threadIdx.x;
    { const int r = tid >> 4, c4 = (tid & 15) * 4;
#pragma unroll
        for (int i = 0; i < 2; ++i) { const int row = r + 32 * i; f32x4 v = (f32x4){0.f, 0.f, 0.f, 0.f};
            if (ncol0 + c4 < ncols_valid) v = *(const f32x4*)(src + (size_t)(k0 + row) * ld_src + ncol0 + c4);
            tile[row * 65 + c4 + 0] = v[0]; tile[row * 65 + c4 + 1] = v[1]; tile[row * 65 + c4 + 2] = v[2]; tile[row * 65 + c4 + 3] = v[3]; } }
    __syncthreads();
    { const int n = tid >> 3, k8 = (tid & 7) * 8; float f[8];
#pragma unroll
        for (int j = 0; j < 8; ++j) f[j] = tile[(k8 + j) * 65 + n];
        *(u32x4*)(dst + (size_t)(dst_row0 + n) * ld_dst + k0 + k8) = pack8(f); }
    __syncthreads();
}
__device__ void phase_prep(const Params& p, unsigned char* lds_g) {
    float* tile = (float*)lds_g;
    bf16_t* W1t = (bf16_t*)(p.ws + WS_W1T); bf16_t* Wgt = (bf16_t*)(p.ws + WS_WGT); bf16_t* W2t = (bf16_t*)(p.ws + WS_W2T); bf16_t* W3t = (bf16_t*)(p.ws + WS_W3T); bf16_t* W4t = (bf16_t*)(p.ws + WS_W4T);
    float* mod = (float*)(p.ws + WS_MOD);
    const int tid = threadIdx.x;
    constexpr int N_MOD = 288, N_W1 = 1024, N_WG = 256, N_W2 = 512, N_W3 = 1600, N_W4 = 512, N_ALL = N_MOD + N_W1 + N_WG + N_W2 + N_W3 + N_W4;
    for (int it = blockIdx.x; it < N_ALL; it += gridDim.x) {
        int i = it;
        if (i < N_MOD) {
            const int colchunk = i % 48, rg = i / 48; const int col = colchunk * 128 + (tid & 127), ksl = tid >> 7, layer = col / 3072, cc = col % 3072;
            for (int idx = tid; idx < 8192; idx += NT) { const int k = idx >> 3, r = idx & 7, row = rg * 8 + r;
                const float cv = row < 16 ? p.c_prompt[row * 1024 + k] : p.c_sample[(row - 16) * 1024 + k]; tile[idx] = silu_f(cv); }
            __syncthreads();
            float a[8];
#pragma unroll
            for (int r = 0; r < 8; ++r) a[r] = 0.f;
            const float* wp = p.ada_w + (size_t)layer * 1024 * 3072 + (size_t)(ksl * 256) * 3072 + cc; const float* tp = tile + ksl * 256 * 8;
#pragma unroll 16
            for (int k = 0; k < 256; ++k) { const float w = wp[(size_t)k * 3072]; const f32x4 s0 = *(const f32x4*)(tp + k * 8), s1 = *(const f32x4*)(tp + k * 8 + 4);
                a[0] += w * s0[0]; a[1] += w * s0[1]; a[2] += w * s0[2]; a[3] += w * s0[3]; a[4] += w * s1[0]; a[5] += w * s1[1]; a[6] += w * s1[2]; a[7] += w * s1[3]; }
            __syncthreads();
#pragma unroll
            for (int r = 0; r < 8; ++r) tile[(ksl * 8 + r) * 128 + (tid & 127)] = a[r];
            __syncthreads();
            if (tid < 128) { const float bias = p.ada_b[layer * 3072 + cc];
#pragma unroll
                for (int r = 0; r < 8; ++r) mod[((size_t)layer * 48 + rg * 8 + r) * 3072 + cc] = tile[r * 128 + tid] + tile[(8 + r) * 128 + tid] + tile[(16 + r) * 128 + tid] + tile[(24 + r) * 128 + tid] + bias; }
            __syncthreads();
            continue;
        }
        i -= N_MOD;
        if (i < N_W1) { const int kt = i & 15, ntile = i >> 4; transpose_tile(p.pool_w_in, 4096, kt * 64, ntile * 64, 4096, W1t, 1024, ntile * 64, tile); continue; }
        i -= N_W1;
        if (i < N_WG) { const int g = i >> 6, r = i & 63, kt = r & 7, ntile = r >> 3; transpose_tile(p.pool_w_group + (size_t)g * 512 * 512, 512, kt * 64, ntile * 64, 512, Wgt + (size_t)g * 512 * 512, 512, ntile * 64, tile); continue; }
        i -= N_WG;
        if (i < N_W2) { const int kt = i & 31, ntile = i >> 5; transpose_tile(p.pool_w_out, 1024, kt * 64, ntile * 64, 1024, W2t, 2048, ntile * 64, tile); continue; }
        i -= N_W2;
        if (i < N_W3) { const int kt = i & 15, ntile = i >> 4; const int n0 = ntile * 64;
            const int src0 = n0 < 4096 ? n0 : (n0 < 4352 ? 6144 + (n0 - 4096) : 4096 + (n0 - 4352));
            const int valid = (n0 >= 4096 && n0 < 4352) ? 6176 : 1 << 30;
            transpose_tile(p.gdn_w_in, 6176, kt * 64, src0, valid, W3t, 1024, n0, tile); continue; }
        i -= N_W3;
        { const int kt = i & 31, ntile = i >> 5; transpose_tile(p.gdn_w_out, 1024, kt * 64, ntile * 64, 1024, W4t, 2048, ntile * 64, tile); }
    }
}

__device__ void phase_norm_mod(const float* x_lo, const float* x_hi, const float* gain, const float* modl, bf16_t* H) {
    const int lane = threadIdx.x & 63, wid = threadIdx.x >> 6;
    for (int rp = blockIdx.x * 8 + wid; rp < T / 2; rp += gridDim.x * 8) {
        f32x4 v[2][4]; float ss[2];
#pragma unroll
        for (int q = 0; q < 2; ++q) { const int row = rp * 2 + q; const float* xr = row < TP ? x_lo + (size_t)row * 1024 : x_hi + (size_t)(row - TP) * 1024;
#pragma unroll
            for (int j = 0; j < 4; ++j) v[q][j] = *(const f32x4*)(xr + j * 256 + lane * 4); }
#pragma unroll
        for (int q = 0; q < 2; ++q) { float a = 0.f;
#pragma unroll
            for (int j = 0; j < 4; ++j) a += v[q][j][0] * v[q][j][0] + v[q][j][1] * v[q][j][1] + v[q][j][2] * v[q][j][2] + v[q][j][3] * v[q][j][3];
#pragma unroll
            for (int o = 32; o >= 1; o >>= 1) a += __shfl_xor(a, o);
            ss[q] = a; }
#pragma unroll
        for (int q = 0; q < 2; ++q) { const int row = rp * 2 + q; const float r = rsqrtf(ss[q] * (1.0f / 1024.0f) + EPS);
            const float* ms = modl + (size_t)seq_of_row(row) * 3072;
#pragma unroll
            for (int j = 0; j < 4; ++j) { const int c = j * 256 + lane * 4; const f32x4 gn = *(const f32x4*)(gain + c), sh = *(const f32x4*)(ms + c), sc = *(const f32x4*)(ms + 1024 + c);
                const f32x4 o = v[q][j] * r * gn * (sc + 1.0f) + sh; u32x2 w; w.x = cvt_pk_bf16(o[0], o[1]); w.y = cvt_pk_bf16(o[2], o[3]); *(u32x2*)(H + (size_t)row * 1024 + c) = w; } }
    }
}
__device__ void phase_norm_final(const float* X, const float* gain, float* out) {
    const int lane = threadIdx.x & 63, wid = threadIdx.x >> 6;
    for (int rp = blockIdx.x * 8 + wid; rp < T / 2; rp += gridDim.x * 8) {
        f32x4 v[2][4]; float ss[2];
#pragma unroll
        for (int q = 0; q < 2; ++q) { const float* xr = X + (size_t)(rp * 2 + q) * 1024;
#pragma unroll
            for (int j = 0; j < 4; ++j) v[q][j] = *(const f32x4*)(xr + j * 256 + lane * 4); }
#pragma unroll
        for (int q = 0; q < 2; ++q) { float a = 0.f;
#pragma unroll
            for (int j = 0; j < 4; ++j) a += v[q][j][0] * v[q][j][0] + v[q][j][1] * v[q][j][1] + v[q][j][2] * v[q][j][2] + v[q][j][3] * v[q][j][3];
#pragma unroll
            for (int o = 32; o >= 1; o >>= 1) a += __shfl_xor(a, o);
            ss[q] = a; }
#pragma unroll
        for (int q = 0; q < 2; ++q) { const float r = rsqrtf(ss[q] * (1.0f / 1024.0f) + EPS);
#pragma unroll
            for (int j = 0; j < 4; ++j) { const int c = j * 256 + lane * 4; const f32x4 gn = *(const f32x4*)(gain + c); *(f32x4*)(out + (size_t)(rp * 2 + q) * 1024 + c) = v[q][j] * r * gn; } }
    }
}

struct SeqInfo { int sq, lc, seq_t0; bool sample, last; };
__device__ __forceinline__ SeqInfo chunk_info(int chunk) { SeqInfo s; if (chunk < 1024) { s.sq = chunk >> 6; s.lc = chunk & 63; s.seq_t0 = s.sq * 4096; s.sample = false; s.last = (s.lc == 63); } else { const int cs = chunk - 1024; s.sq = 16 + cs; s.lc = 0; s.seq_t0 = TP + cs * 64; s.sample = true; s.last = true; } return s; }
__device__ __forceinline__ void pool_fetch(const bf16_t* U, const float* spool, const SeqInfo& si, int pos, int c, float (&f)[8]) {
    if (pos >= 0) { const u32x4 w = *(const u32x4*)(U + (size_t)(si.seq_t0 + pos) * 2048 + c); unpack8(w, f); }
    else if (si.sample) { const float* sp = spool + ((size_t)(si.sq - 16) * 15 + 15 + pos) * 2048 + c; const f32x4 a = *(const f32x4*)sp, b = *(const f32x4*)(sp + 4);
        f[0] = a[0]; f[1] = a[1]; f[2] = a[2]; f[3] = a[3]; f[4] = b[0]; f[5] = b[1]; f[6] = b[2]; f[7] = b[3]; }
    else {
#pragma unroll
        for (int j = 0; j < 8; ++j) f[j] = 0.f; }
}
template <int W>
__device__ __forceinline__ void pool_fast(const Params& p, const bf16_t* U, bf16_t* D, const SeqInfo& si, int g, int col8, int rs) {
    const int c = g * 512 + col8 * 8; const int p0 = si.lc * 64 + rs * 8;
    u32x4 raw[W + 7];
#pragma unroll
    for (int k = 0; k < W + 7; ++k) { const int pos = p0 - (W - 1) + k; raw[k] = pos >= 0 ? *(const u32x4*)(U + (size_t)(si.seq_t0 + pos) * 2048 + c) : (u32x4){0u, 0u, 0u, 0u}; }
    float s[8], cur[8], old[8];
#pragma unroll
    for (int j = 0; j < 8; ++j) s[j] = 0.f;
#pragma unroll
    for (int k = 0; k < W - 1; ++k) { unpack8(raw[k], cur);
#pragma unroll
        for (int j = 0; j < 8; ++j) s[j] += cur[j]; }
#pragma unroll
    for (int i = 0; i < 8; ++i) { const int pos = p0 + i; unpack8(raw[W - 1 + i], cur);
        if (i > 0) { unpack8(raw[i - 1], old);
#pragma unroll
            for (int j = 0; j < 8; ++j) s[j] -= old[j]; }
#pragma unroll
        for (int j = 0; j < 8; ++j) s[j] += cur[j];
        const float inv = 1.0f / fminf((float)(pos + 1), (float)W);
        float d[8];
#pragma unroll
        for (int j = 0; j < 8; ++j) d[j] = s[j] * inv - cur[j];
        *(u32x4*)(D + (size_t)(si.seq_t0 + pos) * 2048 + c) = pack8(d);
        const int rl = rs * 8 + i;
        if (si.last && rl >= 49) { float* op = p.out + O_POOL_P + ((size_t)si.sq * 15 + (rl - 49)) * 2048 + c;
            *(f32x4*)op = (f32x4){cur[0], cur[1], cur[2], cur[3]}; *(f32x4*)(op + 4) = (f32x4){cur[4], cur[5], cur[6], cur[7]}; }
    }
}
__device__ void phase_pool(const Params& p) {
    const bf16_t* U = (const bf16_t*)(p.ws + WS_R1); bf16_t* D = (bf16_t*)(p.ws + WS_R3);
    const int tid = threadIdx.x, col8 = tid & 63, rs = tid >> 6;
    for (int it = blockIdx.x; it < NCHUNK * 4; it += gridDim.x) {
        const int chunk = it >> 2, g = it & 3, w = 2 << g; const SeqInfo si = chunk_info(chunk);
        if (!si.sample) {
            if (g == 0) pool_fast<2>(p, U, D, si, g, col8, rs); else if (g == 1) pool_fast<4>(p, U, D, si, g, col8, rs); else if (g == 2) pool_fast<8>(p, U, D, si, g, col8, rs); else pool_fast<16>(p, U, D, si, g, col8, rs);
            continue;
        }
        const int c = g * 512 + col8 * 8; const int p0 = si.lc * 64 + rs * 8;
        float s[8], cur[8], old[8];
#pragma unroll
        for (int j = 0; j < 8; ++j) s[j] = 0.f;
        for (int q = p0 - w + 1; q < p0; ++q) { pool_fetch(U, p.state_pool, si, q, c, cur);
#pragma unroll
            for (int j = 0; j < 8; ++j) s[j] += cur[j]; }
#pragma unroll 1
        for (int i = 0; i < 8; ++i) { const int pos = p0 + i;
            pool_fetch(U, p.state_pool, si, pos, c, cur);
            if (i > 0) { pool_fetch(U, p.state_pool, si, pos - w, c, old);
#pragma unroll
                for (int j = 0; j < 8; ++j) s[j] -= old[j]; }
#pragma unroll
            for (int j = 0; j < 8; ++j) s[j] += cur[j];
            const float inv = 1.0f / (float)w;
            float d[8];
#pragma unroll
            for (int j = 0; j < 8; ++j) d[j] = s[j] * inv - cur[j];
            *(u32x4*)(D + (size_t)(si.seq_t0 + pos) * 2048 + c) = pack8(d);
            const int rl = rs * 8 + i;
            if (rl >= 49) { float* op = p.out + O_POOL_S + ((size_t)(si.sq - 16) * 15 + (rl - 49)) * 2048 + c;
                *(f32x4*)op = (f32x4){cur[0], cur[1], cur[2], cur[3]}; *(f32x4*)(op + 4) = (f32x4){cur[4], cur[5], cur[6], cur[7]}; }
        }
    }
}

__device__ void phase_conv(const Params& p) {
    bf16_t* QKV = (bf16_t*)(p.ws + WS_R1); const bf16_t* STASH = (const bf16_t*)(p.ws + WS_STASH); const float* AB = (const float*)(p.ws + WS_AB);
    float* GC = (float*)(p.ws + WS_GC); float* BETA = (float*)(p.ws + WS_BETA);
    const int tid = threadIdx.x, stream = tid >> 7, ct = tid & 127, lane = tid & 63, wid = tid >> 6;
    for (int it = blockIdx.x; it < NCHUNK * 4; it += gridDim.x) {
        const int chunk = it >> 2, qt = it & 3; const SeqInfo si = chunk_info(chunk); const int t0 = chunk * 64;
        const int ch = qt * 1024 + ct * 8; const int r0 = stream * 16;
        float wv[4][8];
#pragma unroll
        for (int t = 0; t < 4; ++t) { const f32x4 a = *(const f32x4*)(p.gdn_conv_w + t * 4096 + ch), b = *(const f32x4*)(p.gdn_conv_w + t * 4096 + ch + 4);
            wv[t][0] = a[0]; wv[t][1] = a[1]; wv[t][2] = a[2]; wv[t][3] = a[3]; wv[t][4] = b[0]; wv[t][5] = b[1]; wv[t][6] = b[2]; wv[t][7] = b[3]; }
        float h0[8], h1[8], h2[8];
        if (stream > 0) { unpack8(*(const u32x4*)(QKV + (size_t)(t0 + r0 - 3) * 4096 + ch), h0); unpack8(*(const u32x4*)(QKV + (size_t)(t0 + r0 - 2) * 4096 + ch), h1); unpack8(*(const u32x4*)(QKV + (size_t)(t0 + r0 - 1) * 4096 + ch), h2); }
        else if (si.lc > 0) { const bf16_t* sp = STASH + (size_t)(chunk - 1) * 3 * 4096 + ch; unpack8(*(const u32x4*)sp, h0); unpack8(*(const u32x4*)(sp + 4096), h1); unpack8(*(const u32x4*)(sp + 8192), h2); }
        else if (si.sample) { const float* sp = p.state_conv + (size_t)(si.sq - 16) * 3 * 4096 + ch;
#pragma unroll
            for (int j = 0; j < 8; ++j) { h0[j] = sp[j]; h1[j] = sp[4096 + j]; h2[j] = sp[8192 + j]; } }
        else {
#pragma unroll
            for (int j = 0; j < 8; ++j) { h0[j] = 0.f; h1[j] = 0.f; h2[j] = 0.f; } }
        u32x4 xr[16];
#pragma unroll
        for (int i = 0; i < 16; ++i) xr[i] = *(const u32x4*)(QKV + (size_t)(t0 + r0 + i) * 4096 + ch);
        __syncthreads();
#pragma unroll
        for (int i = 0; i < 16; ++i) {
            bf16_t* rp = QKV + (size_t)(t0 + r0 + i) * 4096 + ch; float x[8], o[8]; unpack8(xr[i], x);
            float ss = 0.f;
#pragma unroll
            for (int j = 0; j < 8; ++j) { const float cv = wv[0][j] * h0[j] + wv[1][j] * h1[j] + wv[2][j] * h2[j] + wv[3][j] * x[j]; o[j] = silu_f(cv); ss += o[j] * o[j]; h0[j] = h1[j]; h1[j] = h2[j]; h2[j] = x[j]; }
            if (qt < 2) { ss += __shfl_xor(ss, 1); ss += __shfl_xor(ss, 2); ss += __shfl_xor(ss, 4); ss += __shfl_xor(ss, 8);
                const float sc = rsqrtf(ss + EPS) * (qt == 0 ? 0.08838834764831845f : 1.0f);
#pragma unroll
                for (int j = 0; j < 8; ++j) o[j] *= sc; }
            *(u32x4*)rp = pack8(o);
            if (si.last && stream == 3 && i >= 13) { float* op = p.out + (si.sample ? O_CONV_S + ((size_t)(si.sq - 16) * 3 + (i - 13)) * 4096 : O_CONV_P + ((size_t)si.sq * 3 + (i - 13)) * 4096) + ch;
                *(f32x4*)op = (f32x4){x[0], x[1], x[2], x[3]}; *(f32x4*)(op + 4) = (f32x4){x[4], x[5], x[6], x[7]}; }
        }
        if (qt == 0) {
#pragma unroll
            for (int hh = 0; hh < 2; ++hh) { const int h = wid * 2 + hh; const float a = AB[(size_t)(t0 + lane) * 32 + h], b = AB[(size_t)(t0 + lane) * 32 + 16 + h];
                const float xx = a + p.gdn_dt_bias[h]; const float sp = xx > 20.f ? xx : log1pf(expf(xx)); float g = -expf(p.gdn_a_log[h]) * sp;
#pragma unroll
                for (int o = 1; o < 64; o <<= 1) { const float t = __shfl_up(g, o); if (lane >= o) g += t; }
                GC[((size_t)chunk * 16 + h) * 64 + lane] = g; BETA[((size_t)chunk * 16 + h) * 64 + lane] = 1.0f / (1.0f + expf(-b)); }
        }
    }
}

__device__ void phase_j1(const Params& p, unsigned char* lds_g) {
    const bf16_t* QKV = (const bf16_t*)(p.ws + WS_R1); const float* GC = (const float*)(p.ws + WS_GC); const float* BETA = (const float*)(p.ws + WS_BETA);
    bf16_t* AH = (bf16_t*)(p.out + O_Y); bf16_t* AQK = AH + (size_t)NCHUNK * 16 * 4096;
    const int lane = threadIdx.x & 63, wid = threadIdx.x >> 6, c = lane & 15, q4 = lane >> 4;
    float* Lw = (float*)(lds_g + wid * 17408);
    for (int wi = blockIdx.x * 8 + wid; wi < NCHUNK * 16; wi += gridDim.x * 8) {
        const int chunk = wi >> 4, h = wi & 15, hk = h >> 1; const size_t t0 = (size_t)chunk * 64;
        const bf16_t* kb = QKV + t0 * 4096 + 1024 + hk * 128; const bf16_t* qb = QKV + t0 * 4096 + hk * 128;
        const float* gcp = GC + (size_t)wi * 64; const float* btp = BETA + (size_t)wi * 64;
        bf16x8 kf[4][4];
#pragma unroll
        for (int mt = 0; mt < 4; ++mt)
#pragma unroll
            for (int ks = 0; ks < 4; ++ks) kf[mt][ks] = *(const bf16x8*)(kb + (size_t)(16 * mt + c) * 4096 + 32 * ks + 8 * q4);
        float gcc[4];
#pragma unroll
        for (int nt = 0; nt < 4; ++nt) gcc[nt] = gcp[16 * nt + c];
#pragma unroll
        for (int mt = 0; mt < 4; ++mt) {
            bf16x8 qf[4];
#pragma unroll
            for (int ks = 0; ks < 4; ++ks) qf[ks] = *(const bf16x8*)(qb + (size_t)(16 * mt + c) * 4096 + 32 * ks + 8 * q4);
            const f32x4 gcr = *(const f32x4*)(gcp + 16 * mt + 4 * q4), btr = *(const f32x4*)(btp + 16 * mt + 4 * q4);
#pragma unroll
            for (int nt = 0; nt < 4; ++nt) {
                bf16_t* aq = AQK + ((size_t)wi * 64 + 16 * mt + 4 * q4) * 64 + 16 * nt + c;
                if (nt <= mt) {
                    f32x4 kk = (f32x4){0.f, 0.f, 0.f, 0.f}, qk = (f32x4){0.f, 0.f, 0.f, 0.f};
#pragma unroll
                    for (int ks = 0; ks < 4; ++ks) { kk = __builtin_amdgcn_mfma_f32_16x16x32_bf16(kf[mt][ks], kf[nt][ks], kk, 0, 0, 0); qk = __builtin_amdgcn_mfma_f32_16x16x32_bf16(qf[ks], kf[nt][ks], qk, 0, 0, 0); }
#pragma unroll
                    for (int e = 0; e < 4; ++e) { const int i = 16 * mt + 4 * q4 + e, j = 16 * nt + c; const float dec = __expf(fminf(gcr[e] - gcc[nt], 0.f));
                        Lw[i * 68 + j] = (i > j) ? btr[e] * kk[e] * dec : 0.f;
                        const float a = (i >= j) ? qk[e] * dec : 0.f; aq[e * 64] = (bf16_t)(cvt_pk_bf16(a, 0.f) & 0xffffu); }
                } else {
#pragma unroll
                    for (int e = 0; e < 4; ++e) aq[e * 64] = (bf16_t)0;
                }
            }
        }
        __builtin_amdgcn_fence(__ATOMIC_RELEASE, "wavefront"); __builtin_amdgcn_wave_barrier();
        float t[64];
#pragma unroll
        for (int i = 0; i < 64; ++i) {
            float s0 = (lane == i) ? 1.f : 0.f, s1 = 0.f, s2 = 0.f, s3 = 0.f;
#pragma unroll
            for (int j4 = 0; j4 < i; j4 += 4) { const f32x4 l = *(const f32x4*)(Lw + i * 68 + j4);
                s0 -= l[0] * t[j4]; if (j4 + 1 < i) s1 -= l[1] * t[j4 + 1]; if (j4 + 2 < i) s2 -= l[2] * t[j4 + 2]; if (j4 + 3 < i) s3 -= l[3] * t[j4 + 3]; }
            t[i] = (s0 + s1) + (s2 + s3);
        }
        const float bc = btp[lane];
        bf16_t* ah = AH + (size_t)wi * 4096 + lane;
#pragma unroll
        for (int i = 0; i < 64; ++i) ah[i * 64] = (bf16_t)(cvt_pk_bf16(t[i] * bc, 0.f) & 0xffffu);
        __builtin_amdgcn_wave_barrier();
    }
}

__device__ __forceinline__ bf16x8 pack_acc2(const f32x4 a, const f32x4 b) { u32x4 w; w.x = cvt_pk_bf16(a[0], a[1]); w.y = cvt_pk_bf16(a[2], a[3]); w.z = cvt_pk_bf16(b[0], b[1]); w.w = cvt_pk_bf16(b[2], b[3]); return __builtin_bit_cast(bf16x8, w); }
__device__ __forceinline__ bf16x8 ld_perm(const bf16_t* ptr) { const u32x2 a = *(const u32x2*)ptr, b = *(const u32x2*)(ptr + 16); u32x4 w; w.x = a.x; w.y = a.y; w.z = b.x; w.w = b.y; return __builtin_bit_cast(bf16x8, w); }
__device__ void phase_j2(const Params& p, unsigned char* lds_g) {
    bf16_t* QKV = (bf16_t*)(p.ws + WS_R1); const float* GC = (const float*)(p.ws + WS_GC);
    const bf16_t* AH = (const bf16_t*)(p.out + O_Y); const bf16_t* AQK = AH + (size_t)NCHUNK * 16 * 4096;
    const int tid = threadIdx.x, lane = tid & 63, w = tid >> 6, c = lane & 15, q4 = lane >> 4;
    constexpr int KN_OFF = 0, QN_OFF = 17408, KT_OFF = 34816, VT_OFF = 53248, AH_OFF = 71680, AQ_OFF = 80896, OS_OFF = 90112, SSQ_OFF = 107520;
    LAS unsigned char* L = (LAS unsigned char*)lds_g;
    LAS bf16_t* KT = (LAS bf16_t*)(L + KT_OFF); LAS bf16_t* VT = (LAS bf16_t*)(L + VT_OFF); LAS bf16_t* OS = (LAS bf16_t*)(L + OS_OFF);
    LAS float* SSQ = (LAS float*)(L + SSQ_OFF);
    const float nw = p.gdn_norm_w[16 * w + c];
    const int rowl = tid & 63, seg = tid >> 6;
    int par = 0;
    u32x4 rk0, rk1, rq0, rq1, rv0, rv1, ra, rqk;
#define J2_LOAD(chunk_) do { const size_t t0_ = (size_t)(chunk_) * 64; const size_t ci_ = (size_t)(chunk_) * 16 + h; \
        const bf16_t* kb_ = QKV + (t0_ + rowl) * 4096 + 1024 + hk * 128 + seg * 16; const bf16_t* qb_ = QKV + (t0_ + rowl) * 4096 + hk * 128 + seg * 16; const bf16_t* vb_ = QKV + (t0_ + rowl) * 4096 + 2048 + h * 128 + seg * 16; \
        rk0 = *(const u32x4*)kb_; rk1 = *(const u32x4*)(kb_ + 8); rq0 = *(const u32x4*)qb_; rq1 = *(const u32x4*)(qb_ + 8); rv0 = *(const u32x4*)vb_; rv1 = *(const u32x4*)(vb_ + 8); \
        ra = *(const u32x4*)(AH + ci_ * 4096 + tid * 8); rqk = *(const u32x4*)(AQK + ci_ * 4096 + tid * 8); } while (0)
#define J2_STORE() do { *(LAS u32x4*)(L + KN_OFF + rowl * 272 + seg * 32) = rk0; *(LAS u32x4*)(L + KN_OFF + rowl * 272 + seg * 32 + 16) = rk1; \
        *(LAS u32x4*)(L + QN_OFF + rowl * 272 + seg * 32) = rq0; *(LAS u32x4*)(L + QN_OFF + rowl * 272 + seg * 32 + 16) = rq1; \
        { const unsigned kw_[8] = {rk0.x, rk0.y, rk0.z, rk0.w, rk1.x, rk1.y, rk1.z, rk1.w}; const unsigned vw_[8] = {rv0.x, rv0.y, rv0.z, rv0.w, rv1.x, rv1.y, rv1.z, rv1.w}; \
          _Pragma("unroll") for (int j_ = 0; j_ < 8; ++j_) { KT[(seg * 16 + 2 * j_) * 72 + rowl] = (bf16_t)(kw_[j_] & 0xffffu); KT[(seg * 16 + 2 * j_ + 1) * 72 + rowl] = (bf16_t)(kw_[j_] >> 16); \
              VT[(seg * 16 + 2 * j_) * 72 + rowl] = (bf16_t)(vw_[j_] & 0xffffu); VT[(seg * 16 + 2 * j_ + 1) * 72 + rowl] = (bf16_t)(vw_[j_] >> 16); } } \
        *(LAS u32x4*)(L + AH_OFF + (tid >> 3) * 144 + (tid & 7) * 16) = ra; *(LAS u32x4*)(L + AQ_OFF + (tid >> 3) * 144 + (tid & 7) * 16) = rqk; } while (0)
#define J2_FRAG(off_) ({ const u32x2 a_ = *(const LAS u32x2*)(L + (off_)); const u32x2 b_ = *(const LAS u32x2*)(L + (off_) + 32); u32x4 w_; w_.x = a_.x; w_.y = a_.y; w_.z = b_.x; w_.w = b_.y; __builtin_bit_cast(bf16x8, w_); })
    for (int item = blockIdx.x; item < 768; item += gridDim.x) {
        int chunk0, nch, h; const float* s0 = nullptr; float* sout;
        if (item < 256) { const int b = item >> 4; h = item & 15; chunk0 = b * 64; nch = 64; sout = p.out + O_REC_P + ((size_t)b * 16 + h) * 16384; }
        else { const int b = (item - 256) >> 4; h = item & 15; chunk0 = 1024 + b; nch = 1; s0 = p.state_rec + ((size_t)b * 16 + h) * 16384; sout = p.out + O_REC_S + ((size_t)b * 16 + h) * 16384; }
        const int hk = h >> 1;
        f32x4 S[8];
#pragma unroll
        for (int mt = 0; mt < 8; ++mt) {
            if (s0) {
#pragma unroll
                for (int e = 0; e < 4; ++e) S[mt][e] = s0[(size_t)(16 * mt + 4 * q4 + e) * 128 + 16 * w + c]; }
            else S[mt] = (f32x4){0.f, 0.f, 0.f, 0.f};
        }
        J2_LOAD(chunk0);
        __syncthreads();
        J2_STORE();
        __syncthreads();
        for (int n = 0; n < nch; ++n, par ^= 1) {
            const int chunk = chunk0 + n; const size_t t0 = (size_t)chunk * 64; const size_t ci = (size_t)chunk * 16 + h;
            if (n + 1 < nch) J2_LOAD(chunk + 1);
            LAS float* ssq = SSQ + par * 512;
            const float* gcp = GC + ci * 64; const float gl = gcp[63]; const float egl = __expf(gl);
            f32x4 egc[4], edl[4];
#pragma unroll
            for (int mt = 0; mt < 4; ++mt) { const f32x4 g4 = *(const f32x4*)(gcp + 16 * mt + 4 * q4);
#pragma unroll
                for (int e = 0; e < 4; ++e) { egc[mt][e] = __expf(g4[e]); edl[mt][e] = __expf(gl - g4[e]); } }
            bf16x8 Sb[4];
#pragma unroll
            for (int ks = 0; ks < 4; ++ks) Sb[ks] = pack_acc2(S[2 * ks], S[2 * ks + 1]);
            f32x4 P[4], QS[4];
#pragma unroll
            for (int mt = 0; mt < 4; ++mt) { P[mt] = (f32x4){0.f, 0.f, 0.f, 0.f}; QS[mt] = (f32x4){0.f, 0.f, 0.f, 0.f};
#pragma unroll
                for (int ks = 0; ks < 4; ++ks) { const int o_ = (16 * mt + c) * 272 + (32 * ks + 4 * q4) * 2;
                    P[mt] = __builtin_amdgcn_mfma_f32_16x16x32_bf16(J2_FRAG(KN_OFF + o_), Sb[ks], P[mt], 0, 0, 0);
                    QS[mt] = __builtin_amdgcn_mfma_f32_16x16x32_bf16(J2_FRAG(QN_OFF + o_), Sb[ks], QS[mt], 0, 0, 0); } }
            f32x4 R[4];
#pragma unroll
            for (int mt = 0; mt < 4; ++mt) { const u32x2 vv = *(const LAS u32x2*)(L + VT_OFF + (16 * w + c) * 144 + (16 * mt + 4 * q4) * 2);
                R[mt][0] = bf_lo(vv.x) - egc[mt][0] * P[mt][0]; R[mt][1] = bf_hi(vv.x) - egc[mt][1] * P[mt][1]; R[mt][2] = bf_lo(vv.y) - egc[mt][2] * P[mt][2]; R[mt][3] = bf_hi(vv.y) - egc[mt][3] * P[mt][3]; }
            bf16x8 Rb[2];
#pragma unroll
            for (int k2 = 0; k2 < 2; ++k2) Rb[k2] = pack_acc2(R[2 * k2], R[2 * k2 + 1]);
            f32x4 Vn[4];
#pragma unroll
            for (int mt = 0; mt < 4; ++mt) { Vn[mt] = (f32x4){0.f, 0.f, 0.f, 0.f};
#pragma unroll
                for (int k2 = 0; k2 < 2; ++k2) Vn[mt] = __builtin_amdgcn_mfma_f32_16x16x32_bf16(J2_FRAG(AH_OFF + (16 * mt + c) * 144 + (32 * k2 + 4 * q4) * 2), Rb[k2], Vn[mt], 0, 0, 0); }
            bf16x8 Vb[2], Vsb[2];
#pragma unroll
            for (int k2 = 0; k2 < 2; ++k2) { Vb[k2] = pack_acc2(Vn[2 * k2], Vn[2 * k2 + 1]); Vsb[k2] = pack_acc2(Vn[2 * k2] * edl[2 * k2], Vn[2 * k2 + 1] * edl[2 * k2 + 1]); }
            f32x4 O[4];
#pragma unroll
            for (int mt = 0; mt < 4; ++mt) { O[mt] = QS[mt] * egc[mt];
#pragma unroll
                for (int k2 = 0; k2 < 2; ++k2) O[mt] = __builtin_amdgcn_mfma_f32_16x16x32_bf16(J2_FRAG(AQ_OFF + (16 * mt + c) * 144 + (32 * k2 + 4 * q4) * 2), Vb[k2], O[mt], 0, 0, 0); }
#pragma unroll
            for (int mt = 0; mt < 4; ++mt) { f32x4 sq = O[mt] * O[mt];
#pragma unroll
                for (int o = 1; o < 16; o <<= 1) { sq[0] += __shfl_xor(sq[0], o); sq[1] += __shfl_xor(sq[1], o); sq[2] += __shfl_xor(sq[2], o); sq[3] += __shfl_xor(sq[3], o); }
                if (c == 0) *(LAS f32x4*)(ssq + w * 64 + 16 * mt + 4 * q4) = sq; }
#pragma unroll
            for (int mt = 0; mt < 8; ++mt) { S[mt] = S[mt] * egl;
#pragma unroll
                for (int k2 = 0; k2 < 2; ++k2) S[mt] = __builtin_amdgcn_mfma_f32_16x16x32_bf16(J2_FRAG(KT_OFF + (16 * mt + c) * 144 + (32 * k2 + 4 * q4) * 2), Vsb[k2], S[mt], 0, 0, 0); }
            __syncthreads();
#pragma unroll
            for (int mt = 0; mt < 4; ++mt) { f32x4 tot = (f32x4){0.f, 0.f, 0.f, 0.f};
#pragma unroll
                for (int ww = 0; ww < 8; ++ww) tot += *(const LAS f32x4*)(ssq + ww * 64 + 16 * mt + 4 * q4);
#pragma unroll
                for (int e = 0; e < 4; ++e) { const float r = rsqrtf(tot[e] * (1.0f / 128.0f) + EPS); OS[(16 * mt + 4 * q4 + e) * 136 + 16 * w + c] = (bf16_t)(cvt_pk_bf16(O[mt][e] * r * nw, 0.f) & 0xffffu); } }
            __syncthreads();
            { const int row = tid >> 3, s8 = tid & 7; const u32x4 o0 = *(const LAS u32x4*)(L + OS_OFF + row * 272 + s8 * 32), o1 = *(const LAS u32x4*)(L + OS_OFF + row * 272 + s8 * 32 + 16);
              bf16_t* op = QKV + (t0 + row) * 4096 + 2048 + h * 128 + s8 * 16; *(u32x4*)op = o0; *(u32x4*)(op + 8) = o1; }
            if (n + 1 < nch) J2_STORE();
            __syncthreads();
        }
#pragma unroll
        for (int mt = 0; mt < 8; ++mt)
#pragma unroll
            for (int e = 0; e < 4; ++e) sout[(size_t)(16 * mt + 4 * q4 + e) * 128 + 16 * w + c] = S[mt][e];
    }
#undef J2_LOAD
#undef J2_STORE
#undef J2_FRAG
}

constexpr int N_PHASES = 14;
#ifndef PH_MASK
#define PH_MASK 0x3fff
#endif
#define PH_ON(n) (((PH_MASK) >> (n)) & 1)
#ifndef REP_MASK
#define REP_MASK 0
#endif
#define REP_ON(n) (((REP_MASK) >> (n)) & 1)
__global__ void __launch_bounds__(NT, 2) mega(Params p, int ph_lo, int ph_hi, int rep_mask) {
    extern __shared__ __attribute__((aligned(16))) unsigned char lds[];
    LAS unsigned char* ldsl = (LAS unsigned char*)lds;
    cg::grid_group grid = cg::this_grid();
    unsigned char* ws = p.ws;
    bf16_t* W1t = (bf16_t*)(ws + WS_W1T); bf16_t* Wgt = (bf16_t*)(ws + WS_WGT); bf16_t* W2t = (bf16_t*)(ws + WS_W2T); bf16_t* W3t = (bf16_t*)(ws + WS_W3T); bf16_t* W4t = (bf16_t*)(ws + WS_W4T);
    float* mod = (float*)(ws + WS_MOD); bf16_t* H = (bf16_t*)(ws + WS_H); bf16_t* R1 = (bf16_t*)(ws + WS_R1); bf16_t* R2 = (bf16_t*)(ws + WS_R2); bf16_t* R3 = (bf16_t*)(ws + WS_R3);
    float* X1 = (float*)(ws + WS_R3);
    const int G = gridDim.x, bid = blockIdx.x;
#define IN(k) (ph_lo <= (k) && (k) < ph_hi)
#define SEAM(k) do { if (IN(k) && IN((k) + 1)) grid.sync(); } while (0)
    if (PH_ON(0) && IN(0)) { phase_prep(p, lds); }
    SEAM(0);
    if (PH_ON(1) && IN(1)) { phase_norm_mod(p.x_prompt, p.x_sample, p.norm_gain, mod, H); }
    SEAM(1);
    if (PH_ON(2) && IN(2)) { { pg8::Gemm g{H, W1t, T, 4096, 1024, 1024, 1024, 0, 0}; pg8::StaticOrder S; S.init(T, 4096, G, bid); pg8::EpiL0In E{R1, R2}; pg8::gemm_phase(ldsl, g, S, E); } }
    SEAM(2);
    if (PH_ON(3) && IN(3)) { phase_pool(p); }
    SEAM(3);
    if (PH_ON(4) && IN(4)) { { pg8::Gemm g{R3, Wgt, T, 2048, 512, 2048, 512, 2, 1024}; pg8::StaticOrder S; S.init(T, 2048, G, bid); pg8::EpiGrp E{R1, R2, p.pool_scale}; pg8::gemm_phase(ldsl, g, S, E); } }
    SEAM(4);
    if (PH_ON(5) && IN(5)) { { pg8::Gemm g{R1, W2t, T, 1024, 2048, 2048, 2048, 0, 0}; pg8::StaticOrder S; S.init(T, 1024, G, bid); pg8::EpiRes E{p.x_prompt, p.x_sample, X1, mod + 2048}; pg8::gemm_phase(ldsl, g, S, E); } }
    SEAM(5);
    if (PH_ON(6) && IN(6)) { phase_norm_mod(X1, X1 + (size_t)TP * 1024, p.norm_gain + 1024, mod + 48 * 3072, H); }
    SEAM(6);
    if (PH_ON(7) && IN(7)) { { pg8::Gemm g{H, W3t, T, 4352, 1024, 1024, 1024, 0, 0}; pg8::StaticOrder S; S.init(T, 4352, G, bid); pg8::EpiL1In E{R1, (bf16_t*)(ws + WS_STASH), (float*)(ws + WS_AB)}; pg8::gemm_phase(ldsl, g, S, E); } }
    SEAM(7);
    if (PH_ON(8) && IN(8)) { phase_conv(p); }
    SEAM(8);
    if (PH_ON(9) && IN(9)) { for (int r_ = 0; r_ <= ((rep_mask >> 9) & 1); ++r_) { if (r_) grid.sync(); phase_j1(p, lds); } }
    SEAM(9);
    if (PH_ON(10) && IN(10)) { phase_j2(p, lds); }
    SEAM(10);
    if (PH_ON(11) && IN(11)) { { pg8::Gemm g{H, W3t + (size_t)4352 * 1024, T, 2048, 1024, 1024, 1024, 0, 0}; pg8::StaticOrder S; S.init(T, 2048, G, bid); pg8::EpiZ E{R1}; pg8::gemm_phase(ldsl, g, S, E); } }
    SEAM(11);
    if (PH_ON(12) && IN(12)) { { pg8::Gemm g{R1 + 2048, W4t, T, 1024, 2048, 4096, 2048, 0, 0}; pg8::StaticOrder S; S.init(T, 1024, G, bid); pg8::EpiRes E{X1, X1 + (size_t)TP * 1024, X1, mod + 48 * 3072 + 2048}; pg8::gemm_phase(ldsl, g, S, E); } }
    SEAM(12);
    if (PH_ON(13) && IN(13)) { phase_norm_final(X1, p.final_gain, p.out + O_Y); }
    SEAM(13);
#undef IN
#undef SEAM
}

#ifndef MK_ONE_LAUNCH
#define MK_ONE_LAUNCH 1
#endif
extern "C" void kernel_launch(void* const* d_in, const int* in_sizes, int n_in, void* d_out, int out_size, void* d_ws, size_t ws_size, hipStream_t stream) {
    static int grid = 0;
    if (grid == 0) {
        if (ws_size < WS_END) { fprintf(stderr, "kernel_launch: workspace too small: %zu < %zu\n", ws_size, (size_t)WS_END); grid = -1; return; }
        int dev = 0, cus = 0, per_cu = 0;
        hipGetDevice(&dev); hipDeviceGetAttribute(&cus, hipDeviceAttributeMultiprocessorCount, dev);
        if (hipFuncSetAttribute((const void*)mega, hipFuncAttributeMaxDynamicSharedMemorySize, LDS_BYTES) != hipSuccess) { fprintf(stderr, "kernel_launch: hipFuncSetAttribute failed\n"); grid = -1; return; }
        if (hipOccupancyMaxActiveBlocksPerMultiprocessor(&per_cu, (const void*)mega, NT, LDS_BYTES) != hipSuccess || per_cu < 1) { fprintf(stderr, "kernel_launch: occupancy query gave %d\n", per_cu); per_cu = 1; }
        (void)hipGetLastError();
        grid = cus * per_cu;
    }
    if (grid < 0) return;
    Params p{};
    p.x_prompt = (const float*)d_in[0]; p.x_sample = (const float*)d_in[1]; p.c_prompt = (const float*)d_in[2]; p.c_sample = (const float*)d_in[3];
    p.state_pool = (const float*)d_in[4]; p.state_conv = (const float*)d_in[5]; p.state_rec = (const float*)d_in[6];
    p.norm_gain = (const float*)d_in[7]; p.ada_w = (const float*)d_in[8]; p.ada_b = (const float*)d_in[9];
    p.pool_w_in = (const float*)d_in[10]; p.pool_w_group = (const float*)d_in[11]; p.pool_scale = (const float*)d_in[12]; p.pool_w_out = (const float*)d_in[13];
    p.gdn_w_in = (const float*)d_in[14]; p.gdn_conv_w = (const float*)d_in[15]; p.gdn_a_log = (const float*)d_in[16]; p.gdn_dt_bias = (const float*)d_in[17]; p.gdn_norm_w = (const float*)d_in[18]; p.gdn_w_out = (const float*)d_in[19];
    p.final_gain = (const float*)d_in[20];
    p.out = (float*)d_out; p.ws = (unsigned char*)d_ws;
#if MK_ONE_LAUNCH
    int lo = 0, hi = N_PHASES, rep = REP_MASK; void* args[] = {&p, &lo, &hi, &rep};
    hipError_t e = hipLaunchCooperativeKernel((const void*)mega, dim3(grid), dim3(NT), args, LDS_BYTES, stream);
    if (e != hipSuccess) fprintf(stderr, "cooperative launch failed: %s (grid %d)\n", hipGetErrorString(e), grid);
#else
    for (int ph = 0; ph < N_PHASES; ++ph) { hipLaunchKernelGGL(mega, dim3(grid), dim3(NT), LDS_BYTES, stream, p, ph, ph + 1, 0); }
#endif
}
```

```cpp
#include <hip/hip_runtime.h>
#include <hip/hip_cooperative_groups.h>
#include <cstdio>
namespace cg = cooperative_groups;

#define LAS __attribute__((address_space(3)))
typedef unsigned short bf16_t;
typedef short bf16x8 __attribute__((ext_vector_type(8)));
typedef short bf16x4 __attribute__((ext_vector_type(4)));
typedef float f32x4 __attribute__((ext_vector_type(4)));
typedef unsigned u32x4 __attribute__((ext_vector_type(4)));
typedef unsigned u32x2 __attribute__((ext_vector_type(2)));

constexpr int DM = 1024, TP = 65536, TS = 2048, T = TP + TS, NSEQ = 48, NCHUNK = T / 64;
constexpr int NT = 512, LDS_BYTES = 147456;
constexpr float EPS = 1e-6f;

constexpr size_t SZ_BIG = (size_t)T * 2048 * 2;
constexpr size_t WS_W1T = 0;
constexpr size_t WS_WGT = WS_W1T + (size_t)4096 * 1024 * 2;
constexpr size_t WS_W2T = WS_WGT + (size_t)2048 * 512 * 2;
constexpr size_t WS_W3T = WS_W2T + (size_t)1024 * 2048 * 2;
constexpr size_t WS_W4T = WS_W3T + (size_t)6400 * 1024 * 2;
constexpr size_t WS_MOD = WS_W4T + (size_t)1024 * 2048 * 2;
constexpr size_t WS_AB = WS_MOD + (size_t)2 * 48 * 3072 * 4;
constexpr size_t WS_GC = WS_AB + (size_t)T * 32 * 4;
constexpr size_t WS_BETA = WS_GC + (size_t)T * 16 * 4;
constexpr size_t WS_STASH = WS_BETA + (size_t)T * 16 * 4;
constexpr size_t WS_H = WS_STASH + (size_t)NCHUNK * 3 * 4096 * 2;
constexpr size_t WS_R1 = WS_H + (size_t)T * 1024 * 2;
constexpr size_t WS_R2 = WS_R1 + SZ_BIG;
constexpr size_t WS_R3 = WS_R2 + SZ_BIG;
constexpr size_t WS_END = WS_R3 + SZ_BIG;

constexpr size_t O_Y = 0;
constexpr size_t O_POOL_P = (size_t)T * 1024;
constexpr size_t O_CONV_P = O_POOL_P + (size_t)16 * 15 * 2048;
constexpr size_t O_REC_P = O_CONV_P + (size_t)16 * 3 * 4096;
constexpr size_t O_POOL_S = O_REC_P + (size_t)16 * 16 * 16384;
constexpr size_t O_CONV_S = O_POOL_S + (size_t)32 * 15 * 2048;
constexpr size_t O_REC_S = O_CONV_S + (size_t)32 * 3 * 4096;

struct Params {
    const float* x_prompt; const float* x_sample; const float* c_prompt; const float* c_sample;
    const float* state_pool; const float* state_conv; const float* state_rec;
    const float* norm_gain; const float* ada_w; const float* ada_b;
    const float* pool_w_in; const float* pool_w_group; const float* pool_scale; const float* pool_w_out;
    const float* gdn_w_in; const float* gdn_conv_w; const float* gdn_a_log; const float* gdn_dt_bias; const float* gdn_norm_w; const float* gdn_w_out;
    const float* final_gain;
    float* out; unsigned char* ws;
};

__device__ __forceinline__ unsigned cvt_pk_bf16(float lo, float hi) { unsigned r; asm volatile("v_cvt_pk_bf16_f32 %0, %1, %2" : "=v"(r) : "v"(lo), "v"(hi)); return r; }
__device__ __forceinline__ float bf_lo(unsigned w) { return __uint_as_float(w << 16); }
__device__ __forceinline__ float bf_hi(unsigned w) { return __uint_as_float(w & 0xffff0000u); }
__device__ __forceinline__ float silu_f(float x) { return x * __builtin_amdgcn_rcpf(1.0f + __expf(-x)); }
__device__ __forceinline__ void unpack8(const u32x4 w, float (&f)[8]) { f[0] = bf_lo(w.x); f[1] = bf_hi(w.x); f[2] = bf_lo(w.y); f[3] = bf_hi(w.y); f[4] = bf_lo(w.z); f[5] = bf_hi(w.z); f[6] = bf_lo(w.w); f[7] = bf_hi(w.w); }
__device__ __forceinline__ u32x4 pack8(const float (&f)[8]) { u32x4 w; w.x = cvt_pk_bf16(f[0], f[1]); w.y = cvt_pk_bf16(f[2], f[3]); w.z = cvt_pk_bf16(f[4], f[5]); w.w = cvt_pk_bf16(f[6], f[7]); return w; }
__device__ __forceinline__ int seq_of_row(int row) { return row < TP ? (row >> 12) : 16 + ((row - TP) >> 6); }

__device__ __forceinline__ float dpp_sum16(float v) {
    v += __int_as_float(__builtin_amdgcn_update_dpp(0, __float_as_int(v), 0xB1, 0xF, 0xF, true));
    v += __int_as_float(__builtin_amdgcn_update_dpp(0, __float_as_int(v), 0x4E, 0xF, 0xF, true));
    v += __int_as_float(__builtin_amdgcn_update_dpp(0, __float_as_int(v), 0x141, 0xF, 0xF, true));
    v += __int_as_float(__builtin_amdgcn_update_dpp(0, __float_as_int(v), 0x140, 0xF, 0xF, true));
    return v;
}
namespace pg8 {
constexpr int BM = 256, BK = 64, HALF = 128, HTB = HALF * BK * 2, STAGE_BYTES = 8 * HTB, NXCD = 8, WGM = 4;
__device__ __forceinline__ int lds_byte(int r, int c) { const int st = (r >> 4) * 2 + (c >> 5), rr = r & 15, cc = c & 31, ob = rr * 64 + cc * 2; return st * 1024 + (ob ^ (((ob >> 9) & 1) << 5)); }
__device__ __forceinline__ void stage_rc(int b, int& R, int& C) { const int st = b / 1024, sb = b % 1024, swz = sb ^ (((sb >> 9) & 1) << 5); R = (st >> 1) * 16 + swz / 64; C = (st & 1) * 32 + (swz % 64) / 2; }
__device__ __forceinline__ int perm32(int rho) { const int n = rho >> 4, i = rho & 15; return 8 * (i >> 2) + 4 * n + (i & 3); }
struct Unit { int pm, pn; };
struct Gemm { const bf16_t* A; const bf16_t* Bt; int M, N, K, lda, ldb, a_grp_div; long a_gstride; int pm_mask = 0xffff; };
struct StaticOrder {
    int nM, nN, nwg, G, c;
    __device__ void init(int M, int N, int G_, int c_) { nM = M / BM; nN = N / BM; nwg = nM * nN; G = G_; c = c_; }
    __device__ bool next(int i, Unit& u) const {
        const long L = (long)i * G + c; if (L >= nwg) return false;
        int wgid = (int)L; { const int q = nwg / NXCD, r = nwg % NXCD, xcd = wgid % NXCD, off = wgid / NXCD; wgid = (xcd < r ? xcd * (q + 1) : r * (q + 1) + (xcd - r) * q) + off; }
        const int nig = WGM * nN, gid = wgid / nig, fm = gid * WGM, gsz = (nM - fm) < WGM ? (nM - fm) : WGM;
        u.pm = fm + ((wgid % nig) % gsz); u.pn = (wgid % nig) / gsz; return true;
    }
};

template <class Epi>
__device__ __forceinline__ void gemm_phase(LAS unsigned char* lds, const Gemm g, const StaticOrder& S, const Epi& E) {
    const int tid = threadIdx.x, wid = __builtin_amdgcn_readfirstlane(tid >> 6), lane = tid & 63, wr = wid >> 2, wc = wid & 3, fr = lane & 15, fq = lane >> 4;
    const int K = g.K, nt = K / BK;
    unsigned voffA[2], voffB[2];
#pragma unroll
    for (int i = 0; i < 2; ++i) { int R, C; stage_rc(tid * 16 + i * 8192, R, C); const int Rb = Epi::PERM ? ((R & ~31) + perm32(R & 31)) : R;
        voffA[i] = (unsigned)(R * g.lda + C) * 2u; voffB[i] = (unsigned)(Rb * g.ldb + C) * 2u; }
    const size_t kstep = (size_t)(BK * 2);
    const size_t hsA = (size_t)HALF * g.lda * 2, hsB = (size_t)HALF * g.ldb * 2;
    const size_t tsA = 2 * hsA, tsB = 2 * hsB;
    const unsigned ldsw = (unsigned)wid * 1024u;
    const int aoff = lds_byte(wr * 64 + fr, fq * 8), boff = lds_byte(wc * 32 + fr, fq * 8);
#define PG8_SA(b, h) (((b) * 2 + (h)) * HTB)
#define PG8_SB(b, h) ((4 + (b) * 2 + (h)) * HTB)
#define PG8_STAGE(bufoff, gbase, voff) do { _Pragma("unroll") for (int _i = 0; _i < 2; ++_i) \
        __builtin_amdgcn_global_load_lds((const unsigned*)((const char*)(gbase) + (voff)[_i]), (LAS unsigned*)(lds + (bufoff) + ldsw + _i * 8192), 16, 0, 0); } while (0)
#define PG8_LDA(dst, b, h) do { _Pragma("unroll") for (int m = 0; m < 4; ++m) _Pragma("unroll") for (int k = 0; k < 2; ++k) dst[m][k] = *(const LAS bf16x8*)(lds + PG8_SA(b, h) + aoff + m * 2048 + k * 1024); } while (0)
#define PG8_LDB(dst, b, h) do { _Pragma("unroll") for (int n = 0; n < 2; ++n) _Pragma("unroll") for (int k = 0; k < 2; ++k) dst[n][k] = *(const LAS bf16x8*)(lds + PG8_SB(b, h) + boff + n * 2048 + k * 1024); } while (0)
#define PG8_MMA(ai, bj, At, Bt) do { __builtin_amdgcn_s_setprio(1); _Pragma("unroll") for (int m = 0; m < 4; ++m) _Pragma("unroll") for (int n = 0; n < 2; ++n) _Pragma("unroll") for (int k = 0; k < 2; ++k) \
        acc[ai][bj][m][n] = __builtin_amdgcn_mfma_f32_16x16x32_bf16(Bt[n][k], At[m][k], acc[ai][bj][m][n], 0, 0, 0); __builtin_amdgcn_s_setprio(0); } while (0)
#define PG8_WAIT_V(n) asm volatile("s_waitcnt vmcnt(" #n ")" ::: "memory")
#define PG8_WAIT_L(n) asm volatile("s_waitcnt lgkmcnt(" #n ")" ::: "memory")
#define PG8_BAR __builtin_amdgcn_s_barrier()
#define PG8_SCHED __builtin_amdgcn_sched_barrier(0)
#define PG8_APTR(u) ((const char*)g.A + (size_t)((u).pm & g.pm_mask) * tsA + (g.a_grp_div ? (size_t)((u).pn / g.a_grp_div) * (size_t)g.a_gstride : (size_t)0))
#define PG8_BPTR(u) ((const char*)g.Bt + (size_t)(u).pn * tsB)
    Unit cur, nxt; int ui = 0;
    if (!S.next(0, cur)) return;
    f32x4 acc[2][2][4][2];
#pragma unroll
    for (int a = 0; a < 2; ++a)
#pragma unroll
        for (int b = 0; b < 2; ++b)
#pragma unroll
            for (int m = 0; m < 4; ++m)
#pragma unroll
                for (int n = 0; n < 2; ++n) acc[a][b][m][n] = (f32x4){0.f, 0.f, 0.f, 0.f};
    bf16x8 At[4][2], B0[2][2], B1[2][2];
    const char* cA = PG8_APTR(cur); const char* cB = PG8_BPTR(cur);
    PG8_STAGE(PG8_SB(0, 0), cB, voffB); PG8_STAGE(PG8_SA(0, 0), cA, voffA); PG8_STAGE(PG8_SB(0, 1), cB + hsB, voffB); PG8_STAGE(PG8_SA(0, 1), cA + hsA, voffA);
    if (wr == 1) PG8_BAR;
    PG8_WAIT_V(4); PG8_BAR;
    PG8_STAGE(PG8_SB(1, 0), cB + kstep, voffB); PG8_STAGE(PG8_SA(1, 0), cA + kstep, voffA); PG8_STAGE(PG8_SB(1, 1), cB + hsB + kstep, voffB);
    PG8_WAIT_V(6); PG8_BAR;
    for (;;) {
        const bool has_next = S.next(ui + 1, nxt);
        const char* nA = has_next ? PG8_APTR(nxt) : cA; const char* nB = has_next ? PG8_BPTR(nxt) : cB;
        for (int t = 0; t < nt; t += 2) {
            const bool last = (t == nt - 2);
            const char* a1 = cA + (size_t)(t + 1) * kstep;
            const char* a2 = last ? nA : cA + (size_t)(t + 2) * kstep; const char* b2 = last ? nB : cB + (size_t)(t + 2) * kstep;
            const char* a3 = a2 + kstep; const char* b3 = b2 + kstep;
            PG8_LDB(B0, 0, 0); PG8_SCHED; PG8_LDA(At, 0, 0); PG8_STAGE(PG8_SA(1, 1), a1 + hsA, voffA);
            PG8_WAIT_L(8); PG8_BAR; PG8_WAIT_L(0); PG8_MMA(0, 0, At, B0); PG8_BAR; PG8_SCHED;
            PG8_LDB(B1, 0, 1); PG8_STAGE(PG8_SB(0, 0), b2, voffB);
            PG8_BAR; PG8_WAIT_L(0); PG8_MMA(0, 1, At, B1); PG8_BAR;
            PG8_LDA(At, 0, 1); PG8_STAGE(PG8_SA(0, 0), a2, voffA);
            PG8_BAR; PG8_WAIT_L(0); PG8_MMA(1, 0, At, B0); PG8_BAR; PG8_SCHED;
            PG8_STAGE(PG8_SB(0, 1), b2 + hsB, voffB);
            PG8_WAIT_V(6); PG8_BAR; PG8_MMA(1, 1, At, B1); PG8_BAR;
            PG8_LDB(B0, 1, 0); PG8_SCHED; PG8_LDA(At, 1, 0); PG8_STAGE(PG8_SA(0, 1), a2 + hsA, voffA);
            PG8_WAIT_L(8); PG8_BAR; PG8_WAIT_L(0); PG8_MMA(0, 0, At, B0); PG8_BAR; PG8_SCHED;
            PG8_LDB(B1, 1, 1); PG8_STAGE(PG8_SB(1, 0), b3, voffB);
            PG8_BAR; PG8_WAIT_L(0); PG8_MMA(0, 1, At, B1); PG8_BAR;
            PG8_LDA(At, 1, 1); PG8_STAGE(PG8_SA(1, 0), a3, voffA);
            PG8_BAR; PG8_WAIT_L(0); PG8_MMA(1, 0, At, B0); PG8_BAR; PG8_SCHED;
            PG8_STAGE(PG8_SB(1, 1), b3 + hsB, voffB);
            PG8_WAIT_V(6); PG8_BAR; PG8_MMA(1, 1, At, B1); PG8_BAR;
        }
        E(acc, cur, wr, wc, fr, fq);
        if (!has_next) break;
#pragma unroll
        for (int a = 0; a < 2; ++a)
#pragma unroll
            for (int b = 0; b < 2; ++b)
#pragma unroll
                for (int m = 0; m < 4; ++m)
#pragma unroll
                    for (int n = 0; n < 2; ++n) acc[a][b][m][n] = (f32x4){0.f, 0.f, 0.f, 0.f};
        cur = nxt; cA = nA; cB = nB; ++ui;
    }
    PG8_WAIT_V(0);
    if (wr == 0) PG8_BAR;
    PG8_BAR;
#undef PG8_SA
#undef PG8_SB
#undef PG8_STAGE
#undef PG8_LDA
#undef PG8_LDB
#undef PG8_MMA
#undef PG8_WAIT_V
#undef PG8_WAIT_L
#undef PG8_BAR
#undef PG8_SCHED
#undef PG8_APTR
#undef PG8_BPTR
}

struct EpiL0In {
    static constexpr bool PERM = true;
    bf16_t* U; bf16_t* SZ;
    __device__ __forceinline__ void operator()(const f32x4 (&acc)[2][2][4][2], const Unit& u, int wr, int wc, int fr, int fq) const {
        const int row0 = u.pm * BM + wr * 64 + fr; const bool isz = u.pn >= 8;
        bf16_t* base = isz ? SZ : U; const int col0 = (isz ? u.pn - 8 : u.pn) * BM + wc * 32 + 8 * fq;
#pragma unroll
        for (int ai = 0; ai < 2; ++ai)
#pragma unroll
            for (int m = 0; m < 4; ++m) { bf16_t* rowp = base + (size_t)(row0 + ai * HALF + m * 16) * 2048 + col0;
#pragma unroll
                for (int bj = 0; bj < 2; ++bj) { f32x4 v0 = acc[ai][bj][m][0], v1 = acc[ai][bj][m][1];
                    if (isz) {
#pragma unroll
                        for (int j = 0; j < 4; ++j) { v0[j] = silu_f(v0[j]); v1[j] = silu_f(v1[j]); } }
                    u32x4 w; w.x = cvt_pk_bf16(v0[0], v0[1]); w.y = cvt_pk_bf16(v0[2], v0[3]); w.z = cvt_pk_bf16(v1[0], v1[1]); w.w = cvt_pk_bf16(v1[2], v1[3]);
                    *(u32x4*)(rowp + bj * HALF) = w; } }
    }
};
struct EpiGrp {
    static constexpr bool PERM = true;
    bf16_t* YY; const bf16_t* SZ; const float* scale;
    __device__ __forceinline__ void operator()(const f32x4 (&acc)[2][2][4][2], const Unit& u, int wr, int wc, int fr, int fq) const {
        const int row0 = u.pm * BM + wr * 64 + fr; const int col0 = u.pn * BM + wc * 32 + 8 * fq;
        f32x4 sc[2][2];
#pragma unroll
        for (int bj = 0; bj < 2; ++bj) { sc[bj][0] = *(const f32x4*)(scale + col0 + bj * HALF); sc[bj][1] = *(const f32x4*)(scale + col0 + bj * HALF + 4); }
#pragma unroll
        for (int ai = 0; ai < 2; ++ai)
#pragma unroll
            for (int m = 0; m < 4; ++m) { const size_t off = (size_t)(row0 + ai * HALF + m * 16) * 2048 + col0;
#pragma unroll
                for (int bj = 0; bj < 2; ++bj) { const u32x4 z = *(const u32x4*)(SZ + off + bj * HALF); float zf[8]; unpack8(z, zf);
                    const f32x4 v0 = acc[ai][bj][m][0] * sc[bj][0], v1 = acc[ai][bj][m][1] * sc[bj][1];
                    u32x4 w; w.x = cvt_pk_bf16(v0[0] * zf[0], v0[1] * zf[1]); w.y = cvt_pk_bf16(v0[2] * zf[2], v0[3] * zf[3]); w.z = cvt_pk_bf16(v1[0] * zf[4], v1[1] * zf[5]); w.w = cvt_pk_bf16(v1[2] * zf[6], v1[3] * zf[7]);
                    *(u32x4*)(YY + off + bj * HALF) = w; } }
    }
};
struct EpiRes {
    static constexpr bool PERM = false;
    const float* base_lo; const float* base_hi; float* OUT; const float* gate;
    __device__ __forceinline__ void operator()(const f32x4 (&acc)[2][2][4][2], const Unit& u, int wr, int wc, int fr, int fq) const {
        const int row0 = u.pm * BM + wr * 64 + fr, col0 = u.pn * BM + wc * 32 + 4 * fq;
#pragma unroll
        for (int ai = 0; ai < 2; ++ai)
#pragma unroll
            for (int m = 0; m < 4; ++m) { const int row = row0 + ai * HALF + m * 16; const float* gp = gate + (size_t)seq_of_row(row) * 3072 + col0;
                const float* bp = (row < TP ? base_lo + (size_t)row * 1024 : base_hi + (size_t)(row - TP) * 1024) + col0; float* op = OUT + (size_t)row * 1024 + col0;
#pragma unroll
                for (int bj = 0; bj < 2; ++bj)
#pragma unroll
                    for (int n = 0; n < 2; ++n) { const f32x4 gv = *(const f32x4*)(gp + bj * HALF + n * 16); const f32x4 bs = *(const f32x4*)(bp + bj * HALF + n * 16);
                        *(f32x4*)(op + bj * HALF + n * 16) = bs + gv * acc[ai][bj][m][n]; } }
    }
};
struct EpiL1In {
    static constexpr bool PERM = true;
    bf16_t* QKV; bf16_t* STASH; float* AB;
    __device__ __forceinline__ void operator()(const f32x4 (&acc)[2][2][4][2], const Unit& u, int wr, int wc, int fr, int fq) const {
        const int row0 = u.pm * BM + wr * 64 + fr;
        if (u.pn < 16) {
            const int col0 = u.pn * BM + wc * 32 + 8 * fq;
#pragma unroll
            for (int ai = 0; ai < 2; ++ai)
#pragma unroll
                for (int m = 0; m < 4; ++m) { const int row = row0 + ai * HALF + m * 16; bf16_t* rowp = QKV + (size_t)row * 4096 + col0; const int rl = row & 63;
#pragma unroll
                    for (int bj = 0; bj < 2; ++bj) { const f32x4 v0 = acc[ai][bj][m][0], v1 = acc[ai][bj][m][1];
                        u32x4 w; w.x = cvt_pk_bf16(v0[0], v0[1]); w.y = cvt_pk_bf16(v0[2], v0[3]); w.z = cvt_pk_bf16(v1[0], v1[1]); w.w = cvt_pk_bf16(v1[2], v1[3]);
                        *(u32x4*)(rowp + bj * HALF) = w;
                        if (rl >= 61) *(u32x4*)(STASH + ((size_t)(row >> 6) * 3 + (rl - 61)) * 4096 + col0 + bj * HALF) = w; } }
        } else if (wc == 0) {
#pragma unroll
            for (int ai = 0; ai < 2; ++ai)
#pragma unroll
                for (int m = 0; m < 4; ++m) { const int row = row0 + ai * HALF + m * 16; float* rowp = AB + (size_t)row * 32 + 8 * fq;
                    *(f32x4*)(rowp) = acc[ai][0][m][0]; *(f32x4*)(rowp + 4) = acc[ai][0][m][1]; }
        }
    }
};
struct EpiZ {
    static constexpr bool PERM = true;
    bf16_t* QKV;
    __device__ __forceinline__ void operator()(const f32x4 (&acc)[2][2][4][2], const Unit& u, int wr, int wc, int fr, int fq) const {
        const int row0 = u.pm * BM + wr * 64 + fr; const int col0 = 2048 + u.pn * BM + wc * 32 + 8 * fq;
#pragma unroll
        for (int ai = 0; ai < 2; ++ai)
#pragma unroll
            for (int m = 0; m < 4; ++m) { bf16_t* rowp = QKV + (size_t)(row0 + ai * HALF + m * 16) * 4096 + col0;
#pragma unroll
                for (int bj = 0; bj < 2; ++bj) { const u32x4 o = *(const u32x4*)(rowp + bj * HALF); float of[8]; unpack8(o, of);
                    const f32x4 v0 = acc[ai][bj][m][0], v1 = acc[ai][bj][m][1];
                    u32x4 w; w.x = cvt_pk_bf16(of[0] * silu_f(v0[0]), of[1] * silu_f(v0[1])); w.y = cvt_pk_bf16(of[2] * silu_f(v0[2]), of[3] * silu_f(v0[3]));
                    w.z = cvt_pk_bf16(of[4] * silu_f(v1[0]), of[5] * silu_f(v1[1])); w.w = cvt_pk_bf16(of[6] * silu_f(v1[2]), of[7] * silu_f(v1[3]));
                    *(u32x4*)(rowp + bj * HALF) = w; } }
    }
};
struct EpiNull {
    static constexpr bool PERM = true;
    float* sink;
    __device__ __forceinline__ void operator()(const f32x4 (&acc)[2][2][4][2], const Unit& u, int wr, int wc, int fr, int fq) const {
        float t = 0.f;
#pragma unroll
        for (int ai = 0; ai < 2; ++ai)
#pragma unroll
            for (int bj = 0; bj < 2; ++bj)
#pragma unroll
                for (int m = 0; m < 4; ++m)
#pragma unroll
                    for (int n = 0; n < 2; ++n) t += acc[ai][bj][m][n][0] + acc[ai][bj][m][n][1] + acc[ai][bj][m][n][2] + acc[ai][bj][m][n][3];
        if (t == 12345.678f) sink[0] = t;
    }
};
}

__device__ void transpose_tile(const float* src, int ld_src, int k0, int ncol0, int ncols_valid, bf16_t* dst, int ld_dst, int dst_row0, float* tile) {
    const int tid = threadIdx.x;
    { const int r = tid >> 4, c4 = (tid & 15) * 4;
#pragma unroll
        for (int i = 0; i < 2; ++i) { const int row = r + 32 * i; f32x4 v = (f32x4){0.f, 0.f, 0.f, 0.f};
            if (ncol0 + c4 < ncols_valid) v = *(const f32x4*)(src + (size_t)(k0 + row) * ld_src + ncol0 + c4);
            tile[row * 65 + c4 + 0] = v[0]; tile[row * 65 + c4 + 1] = v[1]; tile[row * 65 + c4 + 2] = v[2]; tile[row * 65 + c4 + 3] = v[3]; } }
    __syncthreads();
    { const int n = tid >> 3, k8 = (tid & 7) * 8; float f[8];
#pragma unroll
        for (int j = 0; j < 8; ++j) f[j] = tile[(k8 + j) * 65 + n];
        *(u32x4*)(dst + (size_t)(dst_row0 + n) * ld_dst + k0 + k8) = pack8(f); }
    __syncthreads();
}
__device__ void phase_prep(const Params& p, unsigned char* lds_g) {
    float* tile = (float*)lds_g;
    bf16_t* W1t = (bf16_t*)(p.ws + WS_W1T); bf16_t* Wgt = (bf16_t*)(p.ws + WS_WGT); bf16_t* W2t = (bf16_t*)(p.ws + WS_W2T); bf16_t* W3t = (bf16_t*)(p.ws + WS_W3T); bf16_t* W4t = (bf16_t*)(p.ws + WS_W4T);
    float* mod = (float*)(p.ws + WS_MOD);
    const int tid = threadIdx.x;
    constexpr int N_MOD = 288, N_W1 = 1024, N_WG = 256, N_W2 = 512, N_W3 = 1600, N_W4 = 512, N_ALL = N_MOD + N_W1 + N_WG + N_W2 + N_W3 + N_W4;
    for (int it = blockIdx.x; it < N_ALL; it += gridDim.x) {
        int i = it;
        if (i < N_MOD) {
            const int colchunk = i % 48, rg = i / 48; const int col = colchunk * 128 + (tid & 127), ksl = tid >> 7, layer = col / 3072, cc = col % 3072;
            for (int idx = tid; idx < 8192; idx += NT) { const int k = idx >> 3, r = idx & 7, row = rg * 8 + r;
                const float cv = row < 16 ? p.c_prompt[row * 1024 + k] : p.c_sample[(row - 16) * 1024 + k]; tile[idx] = silu_f(cv); }
            __syncthreads();
            float a[8];
#pragma unroll
            for (int r = 0; r < 8; ++r) a[r] = 0.f;
            const float* wp = p.ada_w + (size_t)layer * 1024 * 3072 + (size_t)(ksl * 256) * 3072 + cc; const float* tp = tile + ksl * 256 * 8;
#pragma unroll 16
            for (int k = 0; k < 256; ++k) { const float w = wp[(size_t)k * 3072]; const f32x4 s0 = *(const f32x4*)(tp + k * 8), s1 = *(const f32x4*)(tp + k * 8 + 4);
                a[0] += w * s0[0]; a[1] += w * s0[1]; a[2] += w * s0[2]; a[3] += w * s0[3]; a[4] += w * s1[0]; a[5] += w * s1[1]; a[6] += w * s1[2]; a[7] += w * s1[3]; }
            __syncthreads();
#pragma unroll
            for (int r = 0; r < 8; ++r) tile[(ksl * 8 + r) * 128 + (tid & 127)] = a[r];
            __syncthreads();
            if (tid < 128) { const float bias = p.ada_b[layer * 3072 + cc];
#pragma unroll
                for (int r = 0; r < 8; ++r) mod[((size_t)layer * 48 + rg * 8 + r) * 3072 + cc] = tile[r * 128 + tid] + tile[(8 + r) * 128 + tid] + tile[(16 + r) * 128 + tid] + tile[(24 + r) * 128 + tid] + bias; }
            __syncthreads();
            continue;
        }
        i -= N_MOD;
        if (i < N_W1) { const int kt = i & 15, ntile = i >> 4; transpose_tile(p.pool_w_in, 4096, kt * 64, ntile * 64, 4096, W1t, 1024, ntile * 64, tile); continue; }
        i -= N_W1;
        if (i < N_WG) { const int g = i >> 6, r = i & 63, kt = r & 7, ntile = r >> 3; transpose_tile(p.pool_w_group + (size_t)g * 512 * 512, 512, kt * 64, ntile * 64, 512, Wgt + (size_t)g * 512 * 512, 512, ntile * 64, tile); continue; }
        i -= N_WG;
        if (i < N_W2) { const int kt = i & 31, ntile = i >> 5; transpose_tile(p.pool_w_out, 1024, kt * 64, ntile * 64, 1024, W2t, 2048, ntile * 64, tile); continue; }
        i -= N_W2;
        if (i < N_W3) { const int kt = i & 15, ntile = i >> 4; const int n0 = ntile * 64;
            const int src0 = n0 < 4096 ? n0 : (n0 < 4352 ? 6144 + (n0 - 4096) : 4096 + (n0 - 4352));
            const int valid = (n0 >= 4096 && n0 < 4352) ? 6176 : 1 << 30;
            transpose_tile(p.gdn_w_in, 6176, kt * 64, src0, valid, W3t, 1024, n0, tile); continue; }
        i -= N_W3;
        { const int kt = i & 31, ntile = i >> 5; transpose_tile(p.gdn_w_out, 1024, kt * 64, ntile * 64, 1024, W4t, 2048, ntile * 64, tile); }
    }
}

__device__ void phase_norm_mod(const float* x_lo, const float* x_hi, const float* gain, const float* modl, bf16_t* H) {
    const int lane = threadIdx.x & 63, wid = threadIdx.x >> 6;
    for (int rp = blockIdx.x * 8 + wid; rp < T / 2; rp += gridDim.x * 8) {
        f32x4 v[2][4]; float ss[2];
#pragma unroll
        for (int q = 0; q < 2; ++q) { const int row = rp * 2 + q; const float* xr = row < TP ? x_lo + (size_t)row * 1024 : x_hi + (size_t)(row - TP) * 1024;
#pragma unroll
            for (int j = 0; j < 4; ++j) v[q][j] = *(const f32x4*)(xr + j * 256 + lane * 4); }
#pragma unroll
        for (int q = 0; q < 2; ++q) { float a = 0.f;
#pragma unroll
            for (int j = 0; j < 4; ++j) a += v[q][j][0] * v[q][j][0] + v[q][j][1] * v[q][j][1] + v[q][j][2] * v[q][j][2] + v[q][j][3] * v[q][j][3];
#pragma unroll
            for (int o = 32; o >= 1; o >>= 1) a += __shfl_xor(a, o);
            ss[q] = a; }
#pragma unroll
        for (int q = 0; q < 2; ++q) { const int row = rp * 2 + q; const float r = rsqrtf(ss[q] * (1.0f / 1024.0f) + EPS);
            const float* ms = modl + (size_t)seq_of_row(row) * 3072;
#pragma unroll
            for (int j = 0; j < 4; ++j) { const int c = j * 256 + lane * 4; const f32x4 gn = *(const f32x4*)(gain + c), sh = *(const f32x4*)(ms + c), sc = *(const f32x4*)(ms + 1024 + c);
                const f32x4 o = v[q][j] * r * gn * (sc + 1.0f) + sh; u32x2 w; w.x = cvt_pk_bf16(o[0], o[1]); w.y = cvt_pk_bf16(o[2], o[3]); *(u32x2*)(H + (size_t)row * 1024 + c) = w; } }
    }
}
__device__ void phase_norm_final(const float* X, const float* gain, float* out) {
    const int lane = threadIdx.x & 63, wid = threadIdx.x >> 6;
    for (int rp = blockIdx.x * 8 + wid; rp < T / 2; rp += gridDim.x * 8) {
        f32x4 v[2][4]; float ss[2];
#pragma unroll
        for (int q = 0; q < 2; ++q) { const float* xr = X + (size_t)(rp * 2 + q) * 1024;
#pragma unroll
            for (int j = 0; j < 4; ++j) v[q][j] = *(const f32x4*)(xr + j * 256 + lane * 4); }
#pragma unroll
        for (int q = 0; q < 2; ++q) { float a = 0.f;
#pragma unroll
            for (int j = 0; j < 4; ++j) a += v[q][j][0] * v[q][j][0] + v[q][j][1] * v[q][j][1] + v[q][j][2] * v[q][j][2] + v[q][j][3] * v[q][j][3];
#pragma unroll
            for (int o = 32; o >= 1; o >>= 1) a += __shfl_xor(a, o);
            ss[q] = a; }
#pragma unroll
        for (int q = 0; q < 2; ++q) { const float r = rsqrtf(ss[q] * (1.0f / 1024.0f) + EPS);
#pragma unroll
            for (int j = 0; j < 4; ++j) { const int c = j * 256 + lane * 4; const f32x4 gn = *(const f32x4*)(gain + c); *(f32x4*)(out + (size_t)(rp * 2 + q) * 1024 + c) = v[q][j] * r * gn; } }
    }
}

struct SeqInfo { int sq, lc, seq_t0; bool sample, last; };
__device__ __forceinline__ SeqInfo chunk_info(int chunk) { SeqInfo s; if (chunk < 1024) { s.sq = chunk >> 6; s.lc = chunk & 63; s.seq_t0 = s.sq * 4096; s.sample = false; s.last = (s.lc == 63); } else { const int cs = chunk - 1024; s.sq = 16 + cs; s.lc = 0; s.seq_t0 = TP + cs * 64; s.sample = true; s.last = true; } return s; }
__device__ __forceinline__ void pool_fetch(const bf16_t* U, const float* spool, const SeqInfo& si, int pos, int c, float (&f)[8]) {
    if (pos >= 0) { const u32x4 w = *(const u32x4*)(U + (size_t)(si.seq_t0 + pos) * 2048 + c); unpack8(w, f); }
    else if (si.sample) { const float* sp = spool + ((size_t)(si.sq - 16) * 15 + 15 + pos) * 2048 + c; const f32x4 a = *(const f32x4*)sp, b = *(const f32x4*)(sp + 4);
        f[0] = a[0]; f[1] = a[1]; f[2] = a[2]; f[3] = a[3]; f[4] = b[0]; f[5] = b[1]; f[6] = b[2]; f[7] = b[3]; }
    else {
#pragma unroll
        for (int j = 0; j < 8; ++j) f[j] = 0.f; }
}
template <int W>
__device__ __forceinline__ void pool_fast(const Params& p, const bf16_t* U, bf16_t* D, const SeqInfo& si, int g, int col8, int rs) {
    const int c = g * 512 + col8 * 8; const int p0 = si.lc * 64 + rs * 8;
    u32x4 raw[W + 7];
#pragma unroll
    for (int k = 0; k < W + 7; ++k) { const int pos = p0 - (W - 1) + k; raw[k] = pos >= 0 ? *(const u32x4*)(U + (size_t)(si.seq_t0 + pos) * 2048 + c) : (u32x4){0u, 0u, 0u, 0u}; }
    float s[8], cur[8], old[8];
#pragma unroll
    for (int j = 0; j < 8; ++j) s[j] = 0.f;
#pragma unroll
    for (int k = 0; k < W - 1; ++k) { unpack8(raw[k], cur);
#pragma unroll
        for (int j = 0; j < 8; ++j) s[j] += cur[j]; }
#pragma unroll
    for (int i = 0; i < 8; ++i) { const int pos = p0 + i; unpack8(raw[W - 1 + i], cur);
        if (i > 0) { unpack8(raw[i - 1], old);
#pragma unroll
            for (int j = 0; j < 8; ++j) s[j] -= old[j]; }
#pragma unroll
        for (int j = 0; j < 8; ++j) s[j] += cur[j];
        const float inv = 1.0f / fminf((float)(pos + 1), (float)W);
        float d[8];
#pragma unroll
        for (int j = 0; j < 8; ++j) d[j] = s[j] * inv - cur[j];
        *(u32x4*)(D + (size_t)(si.seq_t0 + pos) * 2048 + c) = pack8(d);
        const int rl = rs * 8 + i;
        if (si.last && rl >= 49) { float* op = p.out + O_POOL_P + ((size_t)si.sq * 15 + (rl - 49)) * 2048 + c;
            *(f32x4*)op = (f32x4){cur[0], cur[1], cur[2], cur[3]}; *(f32x4*)(op + 4) = (f32x4){cur[4], cur[5], cur[6], cur[7]}; }
    }
}
__device__ void phase_pool(const Params& p) {
    const bf16_t* U = (const bf16_t*)(p.ws + WS_R1); bf16_t* D = (bf16_t*)(p.ws + WS_R3);
    const int tid = threadIdx.x, col8 = tid & 63, rs = tid >> 6;
    for (int it = blockIdx.x; it < NCHUNK * 4; it += gridDim.x) {
        const int chunk = it >> 2, g = it & 3, w = 2 << g; const SeqInfo si = chunk_info(chunk);
        if (!si.sample) {
            if (g == 0) pool_fast<2>(p, U, D, si, g, col8, rs); else if (g == 1) pool_fast<4>(p, U, D, si, g, col8, rs); else if (g == 2) pool_fast<8>(p, U, D, si, g, col8, rs); else pool_fast<16>(p, U, D, si, g, col8, rs);
            continue;
        }
        const int c = g * 512 + col8 * 8; const int p0 = si.lc * 64 + rs * 8;
        float s[8], cur[8], old[8];
#pragma unroll
        for (int j = 0; j < 8; ++j) s[j] = 0.f;
        for (int q = p0 - w + 1; q < p0; ++q) { pool_fetch(U, p.state_pool, si, q, c, cur);
#pragma unroll
            for (int j = 0; j < 8; ++j) s[j] += cur[j]; }
#pragma unroll 1
        for (int i = 0; i < 8; ++i) { const int pos = p0 + i;
            pool_fetch(U, p.state_pool, si, pos, c, cur);
            if (i > 0) { pool_fetch(U, p.state_pool, si, pos - w, c, old);
#pragma unroll
                for (int j = 0; j < 8; ++j) s[j] -= old[j]; }
#pragma unroll
            for (int j = 0; j < 8; ++j) s[j] += cur[j];
            const float inv = 1.0f / (float)w;
            float d[8];
#pragma unroll
            for (int j = 0; j < 8; ++j) d[j] = s[j] * inv - cur[j];
            *(u32x4*)(D + (size_t)(si.seq_t0 + pos) * 2048 + c) = pack8(d);
            const int rl = rs * 8 + i;
            if (rl >= 49) { float* op = p.out + O_POOL_S + ((size_t)(si.sq - 16) * 15 + (rl - 49)) * 2048 + c;
                *(f32x4*)op = (f32x4){cur[0], cur[1], cur[2], cur[3]}; *(f32x4*)(op + 4) = (f32x4){cur[4], cur[5], cur[6], cur[7]}; }
        }
    }
}

__device__ void phase_conv(const Params& p) {
    bf16_t* QKV = (bf16_t*)(p.ws + WS_R1); const bf16_t* STASH = (const bf16_t*)(p.ws + WS_STASH); const float* AB = (const float*)(p.ws + WS_AB);
    float* GC = (float*)(p.ws + WS_GC); float* BETA = (float*)(p.ws + WS_BETA);
    const int tid = threadIdx.x, stream = tid >> 7, ct = tid & 127, lane = tid & 63, wid = tid >> 6;
    for (int it = blockIdx.x; it < NCHUNK * 4; it += gridDim.x) {
        const int chunk = it >> 2, qt = it & 3; const SeqInfo si = chunk_info(chunk); const int t0 = chunk * 64;
        const int ch = qt * 1024 + ct * 8; const int r0 = stream * 16;
        float wv[4][8];
#pragma unroll
        for (int t = 0; t < 4; ++t) { const f32x4 a = *(const f32x4*)(p.gdn_conv_w + t * 4096 + ch), b = *(const f32x4*)(p.gdn_conv_w + t * 4096 + ch + 4);
            wv[t][0] = a[0]; wv[t][1] = a[1]; wv[t][2] = a[2]; wv[t][3] = a[3]; wv[t][4] = b[0]; wv[t][5] = b[1]; wv[t][6] = b[2]; wv[t][7] = b[3]; }
        float h0[8], h1[8], h2[8];
        if (stream > 0) { unpack8(*(const u32x4*)(QKV + (size_t)(t0 + r0 - 3) * 4096 + ch), h0); unpack8(*(const u32x4*)(QKV + (size_t)(t0 + r0 - 2) * 4096 + ch), h1); unpack8(*(const u32x4*)(QKV + (size_t)(t0 + r0 - 1) * 4096 + ch), h2); }
        else if (si.lc > 0) { const bf16_t* sp = STASH + (size_t)(chunk - 1) * 3 * 4096 + ch; unpack8(*(const u32x4*)sp, h0); unpack8(*(const u32x4*)(sp + 4096), h1); unpack8(*(const u32x4*)(sp + 8192), h2); }
        else if (si.sample) { const float* sp = p.state_conv + (size_t)(si.sq - 16) * 3 * 4096 + ch;
#pragma unroll
            for (int j = 0; j < 8; ++j) { h0[j] = sp[j]; h1[j] = sp[4096 + j]; h2[j] = sp[8192 + j]; } }
        else {
#pragma unroll
            for (int j = 0; j < 8; ++j) { h0[j] = 0.f; h1[j] = 0.f; h2[j] = 0.f; } }
        u32x4 xr[16];
#pragma unroll
        for (int i = 0; i < 16; ++i) xr[i] = *(const u32x4*)(QKV + (size_t)(t0 + r0 + i) * 4096 + ch);
        __syncthreads();
#pragma unroll
        for (int i = 0; i < 16; ++i) {
            bf16_t* rp = QKV + (size_t)(t0 + r0 + i) * 4096 + ch; float x[8], o[8]; unpack8(xr[i], x);
            float ss = 0.f;
#pragma unroll
            for (int j = 0; j < 8; ++j) { const float cv = wv[0][j] * h0[j] + wv[1][j] * h1[j] + wv[2][j] * h2[j] + wv[3][j] * x[j]; o[j] = silu_f(cv); ss += o[j] * o[j]; h0[j] = h1[j]; h1[j] = h2[j]; h2[j] = x[j]; }
            if (qt < 2) { ss = dpp_sum16(ss);
                const float sc = rsqrtf(ss + EPS) * (qt == 0 ? 0.08838834764831845f : 1.0f);
#pragma unroll
                for (int j = 0; j < 8; ++j) o[j] *= sc; }
            *(u32x4*)rp = pack8(o);
            if (si.last && stream == 3 && i >= 13) { float* op = p.out + (si.sample ? O_CONV_S + ((size_t)(si.sq - 16) * 3 + (i - 13)) * 4096 : O_CONV_P + ((size_t)si.sq * 3 + (i - 13)) * 4096) + ch;
                *(f32x4*)op = (f32x4){x[0], x[1], x[2], x[3]}; *(f32x4*)(op + 4) = (f32x4){x[4], x[5], x[6], x[7]}; }
        }
        if (qt == 0) {
#pragma unroll
            for (int hh = 0; hh < 2; ++hh) { const int h = wid * 2 + hh; const float a = AB[(size_t)(t0 + lane) * 32 + h], b = AB[(size_t)(t0 + lane) * 32 + 16 + h];
                const float xx = a + p.gdn_dt_bias[h]; const float sp = xx > 20.f ? xx : log1pf(expf(xx)); float g = -expf(p.gdn_a_log[h]) * sp;
#pragma unroll
                for (int o = 1; o < 64; o <<= 1) { const float t = __shfl_up(g, o); if (lane >= o) g += t; }
                GC[((size_t)chunk * 16 + h) * 64 + lane] = g; BETA[((size_t)chunk * 16 + h) * 64 + lane] = 1.0f / (1.0f + expf(-b)); }
        }
    }
}

__device__ void phase_j1(const Params& p, unsigned char* lds_g) {
    const bf16_t* QKV = (const bf16_t*)(p.ws + WS_R1); const float* GC = (const float*)(p.ws + WS_GC); const float* BETA = (const float*)(p.ws + WS_BETA);
    bf16_t* AH = (bf16_t*)(p.out + O_Y); bf16_t* AQK = AH + (size_t)NCHUNK * 16 * 4096;
    const int lane = threadIdx.x & 63, wid = threadIdx.x >> 6, c = lane & 15, q4 = lane >> 4;
    float* Lw = (float*)(lds_g + wid * 17408);
    for (int wi = blockIdx.x * 8 + wid; wi < NCHUNK * 16; wi += gridDim.x * 8) {
        const int chunk = wi >> 4, h = wi & 15, hk = h >> 1; const size_t t0 = (size_t)chunk * 64;
        const bf16_t* kb = QKV + t0 * 4096 + 1024 + hk * 128; const bf16_t* qb = QKV + t0 * 4096 + hk * 128;
        const float* gcp = GC + (size_t)wi * 64; const float* btp = BETA + (size_t)wi * 64;
        bf16x8 kf[4][4];
#pragma unroll
        for (int mt = 0; mt < 4; ++mt)
#pragma unroll
            for (int ks = 0; ks < 4; ++ks) kf[mt][ks] = *(const bf16x8*)(kb + (size_t)(16 * mt + c) * 4096 + 32 * ks + 8 * q4);
        float gcc[4];
#pragma unroll
        for (int nt = 0; nt < 4; ++nt) gcc[nt] = gcp[16 * nt + c];
#pragma unroll
        for (int mt = 0; mt < 4; ++mt) {
            bf16x8 qf[4];
#pragma unroll
            for (int ks = 0; ks < 4; ++ks) qf[ks] = *(const bf16x8*)(qb + (size_t)(16 * mt + c) * 4096 + 32 * ks + 8 * q4);
            const f32x4 gcr = *(const f32x4*)(gcp + 16 * mt + 4 * q4), btr = *(const f32x4*)(btp + 16 * mt + 4 * q4);
#pragma unroll
            for (int nt = 0; nt < 4; ++nt) {
                bf16_t* aq = AQK + ((size_t)wi * 64 + 16 * mt + 4 * q4) * 64 + 16 * nt + c;
                if (nt <= mt) {
                    f32x4 kk = (f32x4){0.f, 0.f, 0.f, 0.f}, qk = (f32x4){0.f, 0.f, 0.f, 0.f};
#pragma unroll
                    for (int ks = 0; ks < 4; ++ks) { kk = __builtin_amdgcn_mfma_f32_16x16x32_bf16(kf[mt][ks], kf[nt][ks], kk, 0, 0, 0); qk = __builtin_amdgcn_mfma_f32_16x16x32_bf16(qf[ks], kf[nt][ks], qk, 0, 0, 0); }
#pragma unroll
                    for (int e = 0; e < 4; ++e) { const int i = 16 * mt + 4 * q4 + e, j = 16 * nt + c; const float dec = __expf(fminf(gcr[e] - gcc[nt], 0.f));
                        Lw[i * 68 + j] = (i > j) ? btr[e] * kk[e] * dec : 0.f;
                        const float a = (i >= j) ? qk[e] * dec : 0.f; aq[e * 64] = (bf16_t)(cvt_pk_bf16(a, 0.f) & 0xffffu); }
                } else {
#pragma unroll
                    for (int e = 0; e < 4; ++e) aq[e * 64] = (bf16_t)0;
                }
            }
        }
        __builtin_amdgcn_fence(__ATOMIC_RELEASE, "wavefront"); __builtin_amdgcn_wave_barrier();
        float t[64];
#pragma unroll
        for (int i = 0; i < 64; ++i) {
            float s0 = (lane == i) ? 1.f : 0.f, s1 = 0.f, s2 = 0.f, s3 = 0.f;
#pragma unroll
            for (int j4 = 0; j4 < i; j4 += 4) { const f32x4 l = *(const f32x4*)(Lw + i * 68 + j4);
                s0 -= l[0] * t[j4]; if (j4 + 1 < i) s1 -= l[1] * t[j4 + 1]; if (j4 + 2 < i) s2 -= l[2] * t[j4 + 2]; if (j4 + 3 < i) s3 -= l[3] * t[j4 + 3]; }
            t[i] = (s0 + s1) + (s2 + s3);
        }
        const float bc = btp[lane];
        bf16_t* ah = AH + (size_t)wi * 4096 + lane;
#pragma unroll
        for (int i = 0; i < 64; ++i) ah[i * 64] = (bf16_t)(cvt_pk_bf16(t[i] * bc, 0.f) & 0xffffu);
        __builtin_amdgcn_wave_barrier();
    }
}

__device__ __forceinline__ bf16x8 pack_acc2(const f32x4 a, const f32x4 b) { u32x4 w; w.x = cvt_pk_bf16(a[0], a[1]); w.y = cvt_pk_bf16(a[2], a[3]); w.z = cvt_pk_bf16(b[0], b[1]); w.w = cvt_pk_bf16(b[2], b[3]); return __builtin_bit_cast(bf16x8, w); }
__device__ __forceinline__ bf16x8 ld_perm(const bf16_t* ptr) { const u32x2 a = *(const u32x2*)ptr, b = *(const u32x2*)(ptr + 16); u32x4 w; w.x = a.x; w.y = a.y; w.z = b.x; w.w = b.y; return __builtin_bit_cast(bf16x8, w); }
#define LDS_BARRIER() do { asm volatile("s_waitcnt lgkmcnt(0)" ::: "memory"); __builtin_amdgcn_s_barrier(); asm volatile("" ::: "memory"); } while (0)
__device__ void phase_j2(const Params& p, unsigned char* lds_g, bool dry) {
    bf16_t* QKV = (bf16_t*)(p.ws + WS_R1); const float* GC = (const float*)(p.ws + WS_GC);
    const bf16_t* AH = (const bf16_t*)(p.out + O_Y); const bf16_t* AQK = AH + (size_t)NCHUNK * 16 * 4096;
    const int tid = threadIdx.x, lane = tid & 63, w = tid >> 6, c = lane & 15, q4 = lane >> 4;
    constexpr int KN_OFF = 0, QN_OFF = 17408, KT_OFF = 34816, VT_OFF = 53248, AH_OFF = 71680, AQ_OFF = 80896, OS_OFF = 90112, SSQ_OFF = 107520;
    LAS unsigned char* L = (LAS unsigned char*)lds_g;
    LAS bf16_t* KT = (LAS bf16_t*)(L + KT_OFF); LAS bf16_t* VT = (LAS bf16_t*)(L + VT_OFF); LAS bf16_t* OS = (LAS bf16_t*)(L + OS_OFF);
    LAS float* SSQ = (LAS float*)(L + SSQ_OFF);
    const float nw = p.gdn_norm_w[16 * w + c];
    const int rowl = tid & 63, seg = tid >> 6;
    int par = 0;
    if (tid < 128) ((LAS float*)(L + 111616 + 1024))[tid] = 0.f;
    u32x4 rk0, rk1, rq0, rq1, rv0, rv1, ra, rqk; float ngate, ngl;
    LAS float* GEX = (LAS float*)(L + 111616);
    LAS float* SSQT = (LAS float*)(L + 111616 + 1024);
#define J2_LOAD(chunk_) do { const size_t t0_ = (size_t)(chunk_) * 64; const size_t ci_ = (size_t)(chunk_) * 16 + h; \
        const bf16_t* kb_ = QKV + (t0_ + rowl) * 4096 + 1024 + hk * 128 + seg * 16; const bf16_t* qb_ = QKV + (t0_ + rowl) * 4096 + hk * 128 + seg * 16; const bf16_t* vb_ = QKV + (t0_ + rowl) * 4096 + 2048 + h * 128 + seg * 16; \
        rk0 = *(const u32x4*)kb_; rk1 = *(const u32x4*)(kb_ + 8); rq0 = *(const u32x4*)qb_; rq1 = *(const u32x4*)(qb_ + 8); rv0 = *(const u32x4*)vb_; rv1 = *(const u32x4*)(vb_ + 8); \
        ra = *(const u32x4*)(AH + ci_ * 4096 + tid * 8); rqk = *(const u32x4*)(AQK + ci_ * 4096 + tid * 8); \
        ngate = GC[ci_ * 64 + rowl]; ngl = GC[ci_ * 64 + 63]; } while (0)
#define J2_STORE() do { *(LAS u32x4*)(L + KN_OFF + rowl * 272 + seg * 32) = rk0; *(LAS u32x4*)(L + KN_OFF + rowl * 272 + seg * 32 + 16) = rk1; \
        *(LAS u32x4*)(L + QN_OFF + rowl * 272 + seg * 32) = rq0; *(LAS u32x4*)(L + QN_OFF + rowl * 272 + seg * 32 + 16) = rq1; \
        { const unsigned kw_[8] = {rk0.x, rk0.y, rk0.z, rk0.w, rk1.x, rk1.y, rk1.z, rk1.w}; const unsigned vw_[8] = {rv0.x, rv0.y, rv0.z, rv0.w, rv1.x, rv1.y, rv1.z, rv1.w}; \
          _Pragma("unroll") for (int j_ = 0; j_ < 8; ++j_) { KT[(seg * 16 + 2 * j_) * 72 + rowl] = (bf16_t)(kw_[j_] & 0xffffu); KT[(seg * 16 + 2 * j_ + 1) * 72 + rowl] = (bf16_t)(kw_[j_] >> 16); \
              VT[(seg * 16 + 2 * j_) * 72 + rowl] = (bf16_t)(vw_[j_] & 0xffffu); VT[(seg * 16 + 2 * j_ + 1) * 72 + rowl] = (bf16_t)(vw_[j_] >> 16); } } \
        *(LAS u32x4*)(L + AH_OFF + (tid >> 3) * 144 + (tid & 7) * 16) = ra; *(LAS u32x4*)(L + AQ_OFF + (tid >> 3) * 144 + (tid & 7) * 16) = rqk; if (tid < 64) { GEX[tid] = __expf(ngate); GEX[64 + tid] = __expf(ngl - ngate); if (tid == 63) GEX[128] = __expf(ngl); } } while (0)
#define J2_FRAG(off_) ({ const u32x2 a_ = *(const LAS u32x2*)(L + (off_)); const u32x2 b_ = *(const LAS u32x2*)(L + (off_) + 32); u32x4 w_; w_.x = a_.x; w_.y = a_.y; w_.z = b_.x; w_.w = b_.y; __builtin_bit_cast(bf16x8, w_); })
    for (int item = blockIdx.x; item < 768; item += gridDim.x) {
        int chunk0, nch, h; const float* s0 = nullptr; float* sout;
        if (item < 256) { const int b = item >> 4; h = item & 15; chunk0 = b * 64; nch = 64; sout = p.out + O_REC_P + ((size_t)b * 16 + h) * 16384; }
        else { const int b = (item - 256) >> 4; h = item & 15; chunk0 = 1024 + b; nch = 1; s0 = p.state_rec + ((size_t)b * 16 + h) * 16384; sout = p.out + O_REC_S + ((size_t)b * 16 + h) * 16384; }
        const int hk = h >> 1;
        f32x4 S[8];
        { int loff = (4 * q4) * 128 + 16 * w + c; asm volatile("" : "+v"(loff));
#pragma unroll
        for (int mt = 0; mt < 8; ++mt) {
            if (s0) {
#pragma unroll
                for (int e = 0; e < 4; ++e) S[mt][e] = s0[loff + (16 * mt + e) * 128]; }
            else S[mt] = (f32x4){0.f, 0.f, 0.f, 0.f};
        } }
        J2_LOAD(chunk0);
        LDS_BARRIER();
        J2_STORE();
        LDS_BARRIER();
        for (int n = 0; n < nch; ++n, par ^= 1) {
            const int chunk = chunk0 + n; const size_t t0 = (size_t)chunk * 64; const size_t ci = (size_t)chunk * 16 + h;
            const float egl = GEX[128];
            if (n + 1 < nch) J2_LOAD(chunk + 1);
            LAS float* ssq = SSQT + par * 64;
            bf16x8 Sb[4];
#pragma unroll
            for (int ks = 0; ks < 4; ++ks) Sb[ks] = pack_acc2(S[2 * ks], S[2 * ks + 1]);
#define J2_SB() __builtin_amdgcn_sched_barrier(0)
#define J2_LDKQ(dstk, dstq, mt_) do { _Pragma("unroll") for (int ks_ = 0; ks_ < 4; ++ks_) { const int o_ = (16 * (mt_) + c) * 272 + (32 * ks_ + 4 * q4) * 2; dstk[ks_] = J2_FRAG(KN_OFF + o_); dstq[ks_] = J2_FRAG(QN_OFF + o_); } } while (0)
#define J2_MMKQ(srck, srcq, mt_) do { _Pragma("unroll") for (int ks_ = 0; ks_ < 4; ++ks_) { P[mt_] = __builtin_amdgcn_mfma_f32_16x16x32_bf16(srck[ks_], Sb[ks_], P[mt_], 0, 0, 0); QS[mt_] = __builtin_amdgcn_mfma_f32_16x16x32_bf16(srcq[ks_], Sb[ks_], QS[mt_], 0, 0, 0); } } while (0)
            f32x4 P[4], QS[4];
#pragma unroll
            for (int mt = 0; mt < 4; ++mt) { P[mt] = (f32x4){0.f, 0.f, 0.f, 0.f}; QS[mt] = (f32x4){0.f, 0.f, 0.f, 0.f}; }
            bf16x8 ka[4], qa[4], kb2[4], qb2[4]; u32x2 vv[4];
            J2_LDKQ(ka, qa, 0); J2_LDKQ(kb2, qb2, 1);
            J2_SB(); J2_MMKQ(ka, qa, 0); J2_LDKQ(ka, qa, 2);
            J2_SB(); J2_MMKQ(kb2, qb2, 1); J2_LDKQ(kb2, qb2, 3);
            J2_SB(); J2_MMKQ(ka, qa, 2);
            bf16x8 ahf[4][2], aqf[4][2];
#pragma unroll
            for (int mt = 0; mt < 4; ++mt)
#pragma unroll
                for (int k2 = 0; k2 < 2; ++k2) ahf[mt][k2] = J2_FRAG(AH_OFF + (16 * mt + c) * 144 + (32 * k2 + 4 * q4) * 2);
            f32x4 egc[4];
#pragma unroll
            for (int mt = 0; mt < 4; ++mt) { egc[mt] = *(const LAS f32x4*)(GEX + 16 * mt + 4 * q4);
                vv[mt] = *(const LAS u32x2*)(L + VT_OFF + (16 * w + c) * 144 + (16 * mt + 4 * q4) * 2); }
            J2_SB(); J2_MMKQ(kb2, qb2, 3);
            J2_SB();
            f32x4 edl[4];
#pragma unroll
            for (int mt = 0; mt < 4; ++mt) edl[mt] = *(const LAS f32x4*)(GEX + 64 + 16 * mt + 4 * q4);
            f32x4 R[4];
#pragma unroll
            for (int mt = 0; mt < 4; ++mt) { R[mt][0] = bf_lo(vv[mt].x) - egc[mt][0] * P[mt][0]; R[mt][1] = bf_hi(vv[mt].x) - egc[mt][1] * P[mt][1]; R[mt][2] = bf_lo(vv[mt].y) - egc[mt][2] * P[mt][2]; R[mt][3] = bf_hi(vv[mt].y) - egc[mt][3] * P[mt][3]; }
            bf16x8 Rb[2];
#pragma unroll
            for (int k2 = 0; k2 < 2; ++k2) Rb[k2] = pack_acc2(R[2 * k2], R[2 * k2 + 1]);
            J2_SB();
            f32x4 Vn[4];
#pragma unroll
            for (int mt = 0; mt < 4; ++mt) { Vn[mt] = (f32x4){0.f, 0.f, 0.f, 0.f};
#pragma unroll
                for (int k2 = 0; k2 < 2; ++k2) Vn[mt] = __builtin_amdgcn_mfma_f32_16x16x32_bf16(ahf[mt][k2], Rb[k2], Vn[mt], 0, 0, 0); }
            J2_SB();
#pragma unroll
            for (int mt = 0; mt < 4; ++mt)
#pragma unroll
                for (int k2 = 0; k2 < 2; ++k2) aqf[mt][k2] = J2_FRAG(AQ_OFF + (16 * mt + c) * 144 + (32 * k2 + 4 * q4) * 2);
            bf16x8 ktf[4][2];
#pragma unroll
            for (int mt = 0; mt < 4; ++mt)
#pragma unroll
                for (int k2 = 0; k2 < 2; ++k2) ktf[mt][k2] = J2_FRAG(KT_OFF + (16 * mt + c) * 144 + (32 * k2 + 4 * q4) * 2);
            bf16x8 Vb[2], Vsb[2];
#pragma unroll
            for (int k2 = 0; k2 < 2; ++k2) { Vb[k2] = pack_acc2(Vn[2 * k2], Vn[2 * k2 + 1]); Vsb[k2] = pack_acc2(Vn[2 * k2] * edl[2 * k2], Vn[2 * k2 + 1] * edl[2 * k2 + 1]); }
            J2_SB();
            f32x4 O[4];
#pragma unroll
            for (int mt = 0; mt < 4; ++mt) { O[mt] = QS[mt] * egc[mt];
#pragma unroll
                for (int k2 = 0; k2 < 2; ++k2) O[mt] = __builtin_amdgcn_mfma_f32_16x16x32_bf16(aqf[mt][k2], Vb[k2], O[mt], 0, 0, 0); }
            J2_SB();
#pragma unroll
            for (int mt = 0; mt < 4; ++mt) { S[mt] = S[mt] * egl;
#pragma unroll
                for (int k2 = 0; k2 < 2; ++k2) S[mt] = __builtin_amdgcn_mfma_f32_16x16x32_bf16(ktf[mt][k2], Vsb[k2], S[mt], 0, 0, 0); }
            J2_SB();
#pragma unroll
            for (int mt = 0; mt < 4; ++mt)
#pragma unroll
                for (int k2 = 0; k2 < 2; ++k2) ktf[mt][k2] = J2_FRAG(KT_OFF + (16 * (mt + 4) + c) * 144 + (32 * k2 + 4 * q4) * 2);
#pragma unroll
            for (int mt = 0; mt < 4; ++mt) { f32x4 sq = O[mt] * O[mt]; sq[0] = dpp_sum16(sq[0]); sq[1] = dpp_sum16(sq[1]); sq[2] = dpp_sum16(sq[2]); sq[3] = dpp_sum16(sq[3]);
                if (c == 0) {
#pragma unroll
                    for (int e = 0; e < 4; ++e) __hip_atomic_fetch_add(ssq + 16 * mt + 4 * q4 + e, sq[e], __ATOMIC_RELAXED, __HIP_MEMORY_SCOPE_WORKGROUP); } }
            J2_SB();
#pragma unroll
            for (int mt = 0; mt < 4; ++mt) { S[mt + 4] = S[mt + 4] * egl;
#pragma unroll
                for (int k2 = 0; k2 < 2; ++k2) S[mt + 4] = __builtin_amdgcn_mfma_f32_16x16x32_bf16(ktf[mt][k2], Vsb[k2], S[mt + 4], 0, 0, 0); }
#undef J2_SB
#undef J2_LDKQ
#undef J2_MMKQ
            LDS_BARRIER();
#pragma unroll
            for (int mt = 0; mt < 4; ++mt) { const f32x4 tot = *(const LAS f32x4*)(ssq + 16 * mt + 4 * q4);
#pragma unroll
                for (int e = 0; e < 4; ++e) { const float r = rsqrtf(tot[e] * (1.0f / 128.0f) + EPS); OS[(16 * mt + 4 * q4 + e) * 136 + 16 * w + c] = (bf16_t)(cvt_pk_bf16(O[mt][e] * r * nw, 0.f) & 0xffffu); } }
            LDS_BARRIER();
            { const int row = tid >> 3, s8 = tid & 7; const u32x4 o0 = *(const LAS u32x4*)(L + OS_OFF + row * 272 + s8 * 32), o1 = *(const LAS u32x4*)(L + OS_OFF + row * 272 + s8 * 32 + 16);
              bf16_t* op = QKV + (t0 + row) * 4096 + 2048 + h * 128 + s8 * 16; if (!dry) { *(u32x4*)op = o0; *(u32x4*)(op + 8) = o1; } }
            if (n + 1 < nch) J2_STORE();
            if (tid < 64) SSQT[(par ^ 1) * 64 + tid] = 0.f;
            LDS_BARRIER();
        }
        { int loff = (4 * q4) * 128 + 16 * w + c; asm volatile("" : "+v"(loff));
#pragma unroll
        for (int mt = 0; mt < 8; ++mt)
#pragma unroll
            for (int e = 0; e < 4; ++e) if (!dry) sout[loff + (16 * mt + e) * 128] = S[mt][e]; }
    }
#undef J2_LOAD
#undef J2_STORE
#undef J2_FRAG
}

constexpr int N_PHASES = 14;
#ifndef PH_MASK
#define PH_MASK 0x3fff
#endif
#define PH_ON(n) (((PH_MASK) >> (n)) & 1)
#ifndef REP_MASK
#define REP_MASK 0
#endif
#define REP_ON(n) (((REP_MASK) >> (n)) & 1)
__global__ void __launch_bounds__(NT, 2) mega(Params p, int ph_lo, int ph_hi, int rep_mask) {
    extern __shared__ __attribute__((aligned(16))) unsigned char lds[];
    LAS unsigned char* ldsl = (LAS unsigned char*)lds;
    cg::grid_group grid = cg::this_grid();
    unsigned char* ws = p.ws;
    bf16_t* W1t = (bf16_t*)(ws + WS_W1T); bf16_t* Wgt = (bf16_t*)(ws + WS_WGT); bf16_t* W2t = (bf16_t*)(ws + WS_W2T); bf16_t* W3t = (bf16_t*)(ws + WS_W3T); bf16_t* W4t = (bf16_t*)(ws + WS_W4T);
    float* mod = (float*)(ws + WS_MOD); bf16_t* H = (bf16_t*)(ws + WS_H); bf16_t* R1 = (bf16_t*)(ws + WS_R1); bf16_t* R2 = (bf16_t*)(ws + WS_R2); bf16_t* R3 = (bf16_t*)(ws + WS_R3);
    float* X1 = (float*)(ws + WS_R3);
    const int G = gridDim.x, bid = blockIdx.x;
#define IN(k) (ph_lo <= (k) && (k) < ph_hi)
#define SEAM(k) do { if (IN(k) && IN((k) + 1)) grid.sync(); } while (0)
    if (PH_ON(0) && IN(0)) { phase_prep(p, lds); }
    SEAM(0);
    if (PH_ON(1) && IN(1)) { phase_norm_mod(p.x_prompt, p.x_sample, p.norm_gain, mod, H); }
    SEAM(1);
    if (PH_ON(2) && IN(2)) { { pg8::Gemm g{H, W1t, T, 4096, 1024, 1024, 1024, 0, 0}; pg8::StaticOrder S; S.init(T, 4096, G, bid); pg8::EpiL0In E{R1, R2}; pg8::gemm_phase(ldsl, g, S, E); } }
    SEAM(2);
    if (PH_ON(3) && IN(3)) { phase_pool(p); }
    SEAM(3);
    if (PH_ON(4) && IN(4)) { { pg8::Gemm g{R3, Wgt, T, 2048, 512, 2048, 512, 2, 1024}; pg8::StaticOrder S; S.init(T, 2048, G, bid); pg8::EpiGrp E{R1, R2, p.pool_scale}; pg8::gemm_phase(ldsl, g, S, E); } }
    SEAM(4);
    if (PH_ON(5) && IN(5)) { { pg8::Gemm g{R1, W2t, T, 1024, 2048, 2048, 2048, 0, 0}; pg8::StaticOrder S; S.init(T, 1024, G, bid); pg8::EpiRes E{p.x_prompt, p.x_sample, X1, mod + 2048}; pg8::gemm_phase(ldsl, g, S, E); } }
    SEAM(5);
    if (PH_ON(6) && IN(6)) { phase_norm_mod(X1, X1 + (size_t)TP * 1024, p.norm_gain + 1024, mod + 48 * 3072, H); }
    SEAM(6);
    if (PH_ON(7) && IN(7)) { { pg8::Gemm g{H, W3t, T, 4352, 1024, 1024, 1024, 0, 0}; pg8::StaticOrder S; S.init(T, 4352, G, bid); pg8::EpiL1In E{R1, (bf16_t*)(ws + WS_STASH), (float*)(ws + WS_AB)}; pg8::gemm_phase(ldsl, g, S, E); } }
    SEAM(7);
    if (PH_ON(8) && IN(8)) { phase_conv(p); }
    SEAM(8);
    if (PH_ON(9) && IN(9)) { phase_j1(p, lds); }
    SEAM(9);
    if (PH_ON(10) && IN(10)) { phase_j2(p, lds, false); }
    SEAM(10);
    if (PH_ON(11) && IN(11)) { { pg8::Gemm g{H, W3t + (size_t)4352 * 1024, T, 2048, 1024, 1024, 1024, 0, 0}; pg8::StaticOrder S; S.init(T, 2048, G, bid); pg8::EpiZ E{R1}; pg8::gemm_phase(ldsl, g, S, E); } }
    SEAM(11);
    if (PH_ON(12) && IN(12)) { { pg8::Gemm g{R1 + 2048, W4t, T, 1024, 2048, 4096, 2048, 0, 0}; pg8::StaticOrder S; S.init(T, 1024, G, bid); pg8::EpiRes E{X1, X1 + (size_t)TP * 1024, X1, mod + 48 * 3072 + 2048}; pg8::gemm_phase(ldsl, g, S, E); } }
    SEAM(12);
    if (PH_ON(13) && IN(13)) { phase_norm_final(X1, p.final_gain, p.out + O_Y); }
    SEAM(13);
#undef IN
#undef SEAM
}

#ifndef MK_ONE_LAUNCH
#define MK_ONE_LAUNCH 1
#endif
extern "C" void kernel_launch(void* const* d_in, const int* in_sizes, int n_in, void* d_out, int out_size, void* d_ws, size_t ws_size, hipStream_t stream) {
    static int grid = 0;
    if (grid == 0) {
        if (ws_size < WS_END) { fprintf(stderr, "kernel_launch: workspace too small: %zu < %zu\n", ws_size, (size_t)WS_END); grid = -1; return; }
        int dev = 0, cus = 0, per_cu = 0;
        hipGetDevice(&dev); hipDeviceGetAttribute(&cus, hipDeviceAttributeMultiprocessorCount, dev);
        if (hipFuncSetAttribute((const void*)mega, hipFuncAttributeMaxDynamicSharedMemorySize, LDS_BYTES) != hipSuccess) { fprintf(stderr, "kernel_launch: hipFuncSetAttribute failed\n"); grid = -1; return; }
        if (hipOccupancyMaxActiveBlocksPerMultiprocessor(&per_cu, (const void*)mega, NT, LDS_BYTES) != hipSuccess || per_cu < 1) { fprintf(stderr, "kernel_launch: occupancy query gave %d\n", per_cu); per_cu = 1; }
        (void)hipGetLastError();
        grid = cus * per_cu;
    }
    if (grid < 0) return;
    Params p{};
    p.x_prompt = (const float*)d_in[0]; p.x_sample = (const float*)d_in[1]; p.c_prompt = (const float*)d_in[2]; p.c_sample = (const float*)d_in[3];
    p.state_pool = (const float*)d_in[4]; p.state_conv = (const float*)d_in[5]; p.state_rec = (const float*)d_in[6];
    p.norm_gain = (const float*)d_in[7]; p.ada_w = (const float*)d_in[8]; p.ada_b = (const float*)d_in[9];
    p.pool_w_in = (const float*)d_in[10]; p.pool_w_group = (const float*)d_in[11]; p.pool_scale = (const float*)d_in[12]; p.pool_w_out = (const float*)d_in[13];
    p.gdn_w_in = (const float*)d_in[14]; p.gdn_conv_w = (const float*)d_in[15]; p.gdn_a_log = (const float*)d_in[16]; p.gdn_dt_bias = (const float*)d_in[17]; p.gdn_norm_w = (const float*)d_in[18]; p.gdn_w_out = (const float*)d_in[19];
    p.final_gain = (const float*)d_in[20];
    p.out = (float*)d_out; p.ws = (unsigned char*)d_ws;
#if MK_ONE_LAUNCH
    int lo = 0, hi = N_PHASES, rep = REP_MASK; void* args[] = {&p, &lo, &hi, &rep};
    hipError_t e = hipLaunchCooperativeKernel((const void*)mega, dim3(grid), dim3(NT), args, LDS_BYTES, stream);
    if (e != hipSuccess) fprintf(stderr, "cooperative launch failed: %s (grid %d)\n", hipGetErrorString(e), grid);
#else
    for (int ph = 0; ph < N_PHASES; ++ph) { hipLaunchKernelGGL(mega, dim3(grid), dim3(NT), LDS_BYTES, stream, p, ph, ph + 1, 0); }
#endif
}
```

```cpp
#include <hip/hip_runtime.h>
#include <hip/hip_cooperative_groups.h>
#include <cstdio>
namespace cg = cooperative_groups;

#define LAS __attribute__((address_space(3)))
typedef unsigned short bf16_t;
typedef short bf16x8 __attribute__((ext_vector_type(8)));
typedef short bf16x4 __attribute__((ext_vector_type(4)));
typedef float f32x4 __attribute__((ext_vector_type(4)));
typedef unsigned u32x4 __attribute__((ext_vector_type(4)));
typedef unsigned u32x2 __attribute__((ext_vector_type(2)));

constexpr int DM = 1024, TP = 65536, TS = 2048, T = TP + TS, NSEQ = 48, NCHUNK = T / 64;
constexpr int NT = 512, LDS_BYTES = 147456;
constexpr float EPS = 1e-6f;

constexpr size_t SZ_BIG = (size_t)T * 2048 * 2;
constexpr size_t WS_W1T = 0;
constexpr size_t WS_WGT = WS_W1T + (size_t)4096 * 1024 * 2;
constexpr size_t WS_W2T = WS_WGT + (size_t)2048 * 512 * 2;
constexpr size_t WS_W3T = WS_W2T + (size_t)1024 * 2048 * 2;
constexpr size_t WS_W4T = WS_W3T + (size_t)6400 * 1024 * 2;
constexpr size_t WS_MOD = WS_W4T + (size_t)1024 * 2048 * 2;
constexpr size_t WS_AB = WS_MOD + (size_t)2 * 48 * 3072 * 4;
constexpr size_t WS_GC = WS_AB + (size_t)T * 32 * 4;
constexpr size_t WS_BETA = WS_GC + (size_t)T * 16 * 4;
constexpr size_t WS_STASH = WS_BETA + (size_t)T * 16 * 4;
constexpr size_t WS_H = WS_STASH + (size_t)NCHUNK * 3 * 4096 * 2;
constexpr size_t WS_R1 = WS_H + (size_t)T * 1024 * 2;
constexpr size_t WS_R2 = WS_R1 + SZ_BIG;
constexpr size_t WS_R3 = WS_R2 + SZ_BIG;
constexpr size_t WS_BAR = WS_R3 + SZ_BIG;
constexpr size_t WS_END = WS_BAR + 16384;

constexpr size_t O_Y = 0;
constexpr size_t O_POOL_P = (size_t)T * 1024;
constexpr size_t O_CONV_P = O_POOL_P + (size_t)16 * 15 * 2048;
constexpr size_t O_REC_P = O_CONV_P + (size_t)16 * 3 * 4096;
constexpr size_t O_POOL_S = O_REC_P + (size_t)16 * 16 * 16384;
constexpr size_t O_CONV_S = O_POOL_S + (size_t)32 * 15 * 2048;
constexpr size_t O_REC_S = O_CONV_S + (size_t)32 * 3 * 4096;

struct Params {
    const float* x_prompt; const float* x_sample; const float* c_prompt; const float* c_sample;
    const float* state_pool; const float* state_conv; const float* state_rec;
    const float* norm_gain; const float* ada_w; const float* ada_b;
    const float* pool_w_in; const float* pool_w_group; const float* pool_scale; const float* pool_w_out;
    const float* gdn_w_in; const float* gdn_conv_w; const float* gdn_a_log; const float* gdn_dt_bias; const float* gdn_norm_w; const float* gdn_w_out;
    const float* final_gain;
    float* out; unsigned char* ws;
};

__device__ __forceinline__ unsigned cvt_pk_bf16(float lo, float hi) { unsigned r; asm volatile("v_cvt_pk_bf16_f32 %0, %1, %2" : "=v"(r) : "v"(lo), "v"(hi)); return r; }
__device__ __forceinline__ float bf_lo(unsigned w) { return __uint_as_float(w << 16); }
__device__ __forceinline__ float bf_hi(unsigned w) { return __uint_as_float(w & 0xffff0000u); }
__device__ __forceinline__ float silu_f(float x) { return x * __builtin_amdgcn_rcpf(1.0f + __expf(-x)); }
__device__ __forceinline__ void unpack8(const u32x4 w, float (&f)[8]) { f[0] = bf_lo(w.x); f[1] = bf_hi(w.x); f[2] = bf_lo(w.y); f[3] = bf_hi(w.y); f[4] = bf_lo(w.z); f[5] = bf_hi(w.z); f[6] = bf_lo(w.w); f[7] = bf_hi(w.w); }
__device__ __forceinline__ u32x4 pack8(const float (&f)[8]) { u32x4 w; w.x = cvt_pk_bf16(f[0], f[1]); w.y = cvt_pk_bf16(f[2], f[3]); w.z = cvt_pk_bf16(f[4], f[5]); w.w = cvt_pk_bf16(f[6], f[7]); return w; }
__device__ __forceinline__ int seq_of_row(int row) { return row < TP ? (row >> 12) : 16 + ((row - TP) >> 6); }

__device__ __forceinline__ float dpp_sum16(float v) {
    v += __int_as_float(__builtin_amdgcn_update_dpp(0, __float_as_int(v), 0xB1, 0xF, 0xF, true));
    v += __int_as_float(__builtin_amdgcn_update_dpp(0, __float_as_int(v), 0x4E, 0xF, 0xF, true));
    v += __int_as_float(__builtin_amdgcn_update_dpp(0, __float_as_int(v), 0x141, 0xF, 0xF, true));
    v += __int_as_float(__builtin_amdgcn_update_dpp(0, __float_as_int(v), 0x140, 0xF, 0xF, true));
    return v;
}
namespace pg8 {
constexpr int BM = 256, BK = 64, HALF = 128, HTB = HALF * BK * 2, STAGE_BYTES = 8 * HTB, NXCD = 8, WGM = 4;
__device__ __forceinline__ int lds_byte(int r, int c) { const int st = (r >> 4) * 2 + (c >> 5), rr = r & 15, cc = c & 31, ob = rr * 64 + cc * 2; return st * 1024 + (ob ^ (((ob >> 9) & 1) << 5)); }
__device__ __forceinline__ void stage_rc(int b, int& R, int& C) { const int st = b / 1024, sb = b % 1024, swz = sb ^ (((sb >> 9) & 1) << 5); R = (st >> 1) * 16 + swz / 64; C = (st & 1) * 32 + (swz % 64) / 2; }
__device__ __forceinline__ int perm32(int rho) { const int n = rho >> 4, i = rho & 15; return 8 * (i >> 2) + 4 * n + (i & 3); }
struct Unit { int pm, pn; };
struct Gemm { const bf16_t* A; const bf16_t* Bt; int M, N, K, lda, ldb, a_grp_div; long a_gstride; int pm_mask = 0xffff; };
struct StaticOrder {
    int nM, nN, nwg, G, c;
    __device__ void init(int M, int N, int G_, int c_) { nM = M / BM; nN = N / BM; nwg = nM * nN; G = G_; c = c_; }
    __device__ bool next(int i, Unit& u) const {
        const long L = (long)i * G + c; if (L >= nwg) return false;
        int wgid = (int)L; { const int q = nwg / NXCD, r = nwg % NXCD, xcd = wgid % NXCD, off = wgid / NXCD; wgid = (xcd < r ? xcd * (q + 1) : r * (q + 1) + (xcd - r) * q) + off; }
        const int nig = WGM * nN, gid = wgid / nig, fm = gid * WGM, gsz = (nM - fm) < WGM ? (nM - fm) : WGM;
        u.pm = fm + ((wgid % nig) % gsz); u.pn = (wgid % nig) / gsz; return true;
    }
};

template <class Epi>
__device__ __forceinline__ void gemm_phase(LAS unsigned char* lds, const Gemm g, const StaticOrder& S, const Epi& E) {
    const int tid = threadIdx.x, wid = __builtin_amdgcn_readfirstlane(tid >> 6), lane = tid & 63, wr = wid >> 2, wc = wid & 3, fr = lane & 15, fq = lane >> 4;
    const int K = g.K, nt = K / BK;
    unsigned voffA[2], voffB[2];
#pragma unroll
    for (int i = 0; i < 2; ++i) { int R, C; stage_rc(tid * 16 + i * 8192, R, C); const int Rb = Epi::PERM ? ((R & ~31) + perm32(R & 31)) : R;
        voffA[i] = (unsigned)(R * g.lda + C) * 2u; voffB[i] = (unsigned)(Rb * g.ldb + C) * 2u; }
    const size_t kstep = (size_t)(BK * 2);
    const size_t hsA = (size_t)HALF * g.lda * 2, hsB = (size_t)HALF * g.ldb * 2;
    const size_t tsA = 2 * hsA, tsB = 2 * hsB;
    const unsigned ldsw = (unsigned)wid * 1024u;
    const int aoff = lds_byte(wr * 64 + fr, fq * 8), boff = lds_byte(wc * 32 + fr, fq * 8);
#define PG8_SA(b, h) (((b) * 2 + (h)) * HTB)
#define PG8_SB(b, h) ((4 + (b) * 2 + (h)) * HTB)
#define PG8_STAGE(bufoff, gbase, voff) do { _Pragma("unroll") for (int _i = 0; _i < 2; ++_i) \
        __builtin_amdgcn_global_load_lds((const unsigned*)((const char*)(gbase) + (voff)[_i]), (LAS unsigned*)(lds + (bufoff) + ldsw + _i * 8192), 16, 0, 0); } while (0)
#define PG8_LDA(dst, b, h) do { _Pragma("unroll") for (int m = 0; m < 4; ++m) _Pragma("unroll") for (int k = 0; k < 2; ++k) dst[m][k] = *(const LAS bf16x8*)(lds + PG8_SA(b, h) + aoff + m * 2048 + k * 1024); } while (0)
#define PG8_LDB(dst, b, h) do { _Pragma("unroll") for (int n = 0; n < 2; ++n) _Pragma("unroll") for (int k = 0; k < 2; ++k) dst[n][k] = *(const LAS bf16x8*)(lds + PG8_SB(b, h) + boff + n * 2048 + k * 1024); } while (0)
#define PG8_MMA(ai, bj, At, Bt) do { __builtin_amdgcn_s_setprio(1); _Pragma("unroll") for (int m = 0; m < 4; ++m) _Pragma("unroll") for (int n = 0; n < 2; ++n) _Pragma("unroll") for (int k = 0; k < 2; ++k) \
        acc[ai][bj][m][n] = __builtin_amdgcn_mfma_f32_16x16x32_bf16(Bt[n][k], At[m][k], acc[ai][bj][m][n], 0, 0, 0); __builtin_amdgcn_s_setprio(0); } while (0)
#define PG8_WAIT_V(n) asm volatile("s_waitcnt vmcnt(" #n ")" ::: "memory")
#define PG8_WAIT_L(n) asm volatile("s_waitcnt lgkmcnt(" #n ")" ::: "memory")
#define PG8_BAR __builtin_amdgcn_s_barrier()
#define PG8_SCHED __builtin_amdgcn_sched_barrier(0)
#define PG8_APTR(u) ((const char*)g.A + (size_t)((u).pm & g.pm_mask) * tsA + (g.a_grp_div ? (size_t)((u).pn / g.a_grp_div) * (size_t)g.a_gstride : (size_t)0))
#define PG8_BPTR(u) ((const char*)g.Bt + (size_t)(u).pn * tsB)
    Unit cur, nxt; int ui = 0;
    if (!S.next(0, cur)) return;
    f32x4 acc[2][2][4][2];
#pragma unroll
    for (int a = 0; a < 2; ++a)
#pragma unroll
        for (int b = 0; b < 2; ++b)
#pragma unroll
            for (int m = 0; m < 4; ++m)
#pragma unroll
                for (int n = 0; n < 2; ++n) acc[a][b][m][n] = (f32x4){0.f, 0.f, 0.f, 0.f};
    bf16x8 At[4][2], B0[2][2], B1[2][2];
    const char* cA = PG8_APTR(cur); const char* cB = PG8_BPTR(cur);
    PG8_STAGE(PG8_SB(0, 0), cB, voffB); PG8_STAGE(PG8_SA(0, 0), cA, voffA); PG8_STAGE(PG8_SB(0, 1), cB + hsB, voffB); PG8_STAGE(PG8_SA(0, 1), cA + hsA, voffA);
    if (wr == 1) PG8_BAR;
    PG8_WAIT_V(4); PG8_BAR;
    PG8_STAGE(PG8_SB(1, 0), cB + kstep, voffB); PG8_STAGE(PG8_SA(1, 0), cA + kstep, voffA); PG8_STAGE(PG8_SB(1, 1), cB + hsB + kstep, voffB);
    PG8_WAIT_V(6); PG8_BAR;
    for (;;) {
        const bool has_next = S.next(ui + 1, nxt);
        const char* nA = has_next ? PG8_APTR(nxt) : cA; const char* nB = has_next ? PG8_BPTR(nxt) : cB;
        for (int t = 0; t < nt; t += 2) {
            const bool last = (t == nt - 2);
            const char* a1 = cA + (size_t)(t + 1) * kstep;
            const char* a2 = last ? nA : cA + (size_t)(t + 2) * kstep; const char* b2 = last ? nB : cB + (size_t)(t + 2) * kstep;
            const char* a3 = a2 + kstep; const char* b3 = b2 + kstep;
            PG8_LDB(B0, 0, 0); PG8_SCHED; PG8_LDA(At, 0, 0); PG8_STAGE(PG8_SA(1, 1), a1 + hsA, voffA);
            PG8_WAIT_L(8); PG8_BAR; PG8_WAIT_L(0); PG8_MMA(0, 0, At, B0); PG8_BAR; PG8_SCHED;
            PG8_LDB(B1, 0, 1); PG8_STAGE(PG8_SB(0, 0), b2, voffB);
            PG8_BAR; PG8_WAIT_L(0); PG8_MMA(0, 1, At, B1); PG8_BAR;
            PG8_LDA(At, 0, 1); PG8_STAGE(PG8_SA(0, 0), a2, voffA);
            PG8_BAR; PG8_WAIT_L(0); PG8_MMA(1, 0, At, B0); PG8_BAR; PG8_SCHED;
            PG8_STAGE(PG8_SB(0, 1), b2 + hsB, voffB);
            PG8_WAIT_V(6); PG8_BAR; PG8_MMA(1, 1, At, B1); PG8_BAR;
            PG8_LDB(B0, 1, 0); PG8_SCHED; PG8_LDA(At, 1, 0); PG8_STAGE(PG8_SA(0, 1), a2 + hsA, voffA);
            PG8_WAIT_L(8); PG8_BAR; PG8_WAIT_L(0); PG8_MMA(0, 0, At, B0); PG8_BAR; PG8_SCHED;
            PG8_LDB(B1, 1, 1); PG8_STAGE(PG8_SB(1, 0), b3, voffB);
            PG8_BAR; PG8_WAIT_L(0); PG8_MMA(0, 1, At, B1); PG8_BAR;
            PG8_LDA(At, 1, 1); PG8_STAGE(PG8_SA(1, 0), a3, voffA);
            PG8_BAR; PG8_WAIT_L(0); PG8_MMA(1, 0, At, B0); PG8_BAR; PG8_SCHED;
            PG8_STAGE(PG8_SB(1, 1), b3 + hsB, voffB);
            PG8_WAIT_V(6); PG8_BAR; PG8_MMA(1, 1, At, B1); PG8_BAR;
        }
        E(acc, cur, wr, wc, fr, fq);
        if (!has_next) break;
#pragma unroll
        for (int a = 0; a < 2; ++a)
#pragma unroll
            for (int b = 0; b < 2; ++b)
#pragma unroll
                for (int m = 0; m < 4; ++m)
#pragma unroll
                    for (int n = 0; n < 2; ++n) acc[a][b][m][n] = (f32x4){0.f, 0.f, 0.f, 0.f};
        cur = nxt; cA = nA; cB = nB; ++ui;
    }
    PG8_WAIT_V(0);
    if (wr == 0) PG8_BAR;
    PG8_BAR;
#undef PG8_SA
#undef PG8_SB
#undef PG8_STAGE
#undef PG8_LDA
#undef PG8_LDB
#undef PG8_MMA
#undef PG8_WAIT_V
#undef PG8_WAIT_L
#undef PG8_BAR
#undef PG8_SCHED
#undef PG8_APTR
#undef PG8_BPTR
}

struct EpiL0In {
    static constexpr bool PERM = true;
    bf16_t* U; bf16_t* SZ;
    __device__ __forceinline__ void operator()(const f32x4 (&acc)[2][2][4][2], const Unit& u, int wr, int wc, int fr, int fq) const {
        const int row0 = u.pm * BM + wr * 64 + fr; const bool isz = u.pn >= 8;
        bf16_t* base = isz ? SZ : U; const int col0 = (isz ? u.pn - 8 : u.pn) * BM + wc * 32 + 8 * fq;
#pragma unroll
        for (int ai = 0; ai < 2; ++ai)
#pragma unroll
            for (int m = 0; m < 4; ++m) { bf16_t* rowp = base + (size_t)(row0 + ai * HALF + m * 16) * 2048 + col0;
#pragma unroll
                for (int bj = 0; bj < 2; ++bj) { f32x4 v0 = acc[ai][bj][m][0], v1 = acc[ai][bj][m][1];
                    if (isz) {
#pragma unroll
                        for (int j = 0; j < 4; ++j) { v0[j] = silu_f(v0[j]); v1[j] = silu_f(v1[j]); } }
                    u32x4 w; w.x = cvt_pk_bf16(v0[0], v0[1]); w.y = cvt_pk_bf16(v0[2], v0[3]); w.z = cvt_pk_bf16(v1[0], v1[1]); w.w = cvt_pk_bf16(v1[2], v1[3]);
                    *(u32x4*)(rowp + bj * HALF) = w; } }
    }
};
struct EpiGrp {
    static constexpr bool PERM = true;
    bf16_t* YY; const bf16_t* SZ; const float* scale;
    __device__ __forceinline__ void operator()(const f32x4 (&acc)[2][2][4][2], const Unit& u, int wr, int wc, int fr, int fq) const {
        const int row0 = u.pm * BM + wr * 64 + fr; const int col0 = u.pn * BM + wc * 32 + 8 * fq;
        f32x4 sc[2][2];
#pragma unroll
        for (int bj = 0; bj < 2; ++bj) { sc[bj][0] = *(const f32x4*)(scale + col0 + bj * HALF); sc[bj][1] = *(const f32x4*)(scale + col0 + bj * HALF + 4); }
#pragma unroll
        for (int ai = 0; ai < 2; ++ai)
#pragma unroll
            for (int m = 0; m < 4; ++m) { const size_t off = (size_t)(row0 + ai * HALF + m * 16) * 2048 + col0;
#pragma unroll
                for (int bj = 0; bj < 2; ++bj) { const u32x4 z = *(const u32x4*)(SZ + off + bj * HALF); float zf[8]; unpack8(z, zf);
                    const f32x4 v0 = acc[ai][bj][m][0] * sc[bj][0], v1 = acc[ai][bj][m][1] * sc[bj][1];
                    u32x4 w; w.x = cvt_pk_bf16(v0[0] * zf[0], v0[1] * zf[1]); w.y = cvt_pk_bf16(v0[2] * zf[2], v0[3] * zf[3]); w.z = cvt_pk_bf16(v1[0] * zf[4], v1[1] * zf[5]); w.w = cvt_pk_bf16(v1[2] * zf[6], v1[3] * zf[7]);
                    *(u32x4*)(YY + off + bj * HALF) = w; } }
    }
};
struct EpiRes {
    static constexpr bool PERM = false;
    const float* base_lo; const float* base_hi; float* OUT; const float* gate;
    __device__ __forceinline__ void operator()(const f32x4 (&acc)[2][2][4][2], const Unit& u, int wr, int wc, int fr, int fq) const {
        const int row0 = u.pm * BM + wr * 64 + fr, col0 = u.pn * BM + wc * 32 + 4 * fq;
#pragma unroll
        for (int ai = 0; ai < 2; ++ai)
#pragma unroll
            for (int m = 0; m < 4; ++m) { const int row = row0 + ai * HALF + m * 16; const float* gp = gate + (size_t)seq_of_row(row) * 3072 + col0;
                const float* bp = (row < TP ? base_lo + (size_t)row * 1024 : base_hi + (size_t)(row - TP) * 1024) + col0; float* op = OUT + (size_t)row * 1024 + col0;
#pragma unroll
                for (int bj = 0; bj < 2; ++bj)
#pragma unroll
                    for (int n = 0; n < 2; ++n) { const f32x4 gv = *(const f32x4*)(gp + bj * HALF + n * 16); const f32x4 bs = *(const f32x4*)(bp + bj * HALF + n * 16);
                        *(f32x4*)(op + bj * HALF + n * 16) = bs + gv * acc[ai][bj][m][n]; } }
    }
};
struct EpiL1In {
    static constexpr bool PERM = true;
    bf16_t* QKV; bf16_t* STASH; float* AB;
    __device__ __forceinline__ void operator()(const f32x4 (&acc)[2][2][4][2], const Unit& u, int wr, int wc, int fr, int fq) const {
        const int row0 = u.pm * BM + wr * 64 + fr;
        if (u.pn < 16) {
            const int col0 = u.pn * BM + wc * 32 + 8 * fq;
#pragma unroll
            for (int ai = 0; ai < 2; ++ai)
#pragma unroll
                for (int m = 0; m < 4; ++m) { const int row = row0 + ai * HALF + m * 16; bf16_t* rowp = QKV + (size_t)row * 4096 + col0; const int rl = row & 63;
#pragma unroll
                    for (int bj = 0; bj < 2; ++bj) { const f32x4 v0 = acc[ai][bj][m][0], v1 = acc[ai][bj][m][1];
                        u32x4 w; w.x = cvt_pk_bf16(v0[0], v0[1]); w.y = cvt_pk_bf16(v0[2], v0[3]); w.z = cvt_pk_bf16(v1[0], v1[1]); w.w = cvt_pk_bf16(v1[2], v1[3]);
                        *(u32x4*)(rowp + bj * HALF) = w;
                        if (rl >= 61) *(u32x4*)(STASH + ((size_t)(row >> 6) * 3 + (rl - 61)) * 4096 + col0 + bj * HALF) = w; } }
        } else if (wc == 0) {
#pragma unroll
            for (int ai = 0; ai < 2; ++ai)
#pragma unroll
                for (int m = 0; m < 4; ++m) { const int row = row0 + ai * HALF + m * 16; float* rowp = AB + (size_t)row * 32 + 8 * fq;
                    *(f32x4*)(rowp) = acc[ai][0][m][0]; *(f32x4*)(rowp + 4) = acc[ai][0][m][1]; }
        }
    }
};
struct EpiZ {
    static constexpr bool PERM = true;
    bf16_t* QKV;
    __device__ __forceinline__ void operator()(const f32x4 (&acc)[2][2][4][2], const Unit& u, int wr, int wc, int fr, int fq) const {
        const int row0 = u.pm * BM + wr * 64 + fr; const int col0 = 2048 + u.pn * BM + wc * 32 + 8 * fq;
#pragma unroll
        for (int ai = 0; ai < 2; ++ai)
#pragma unroll
            for (int m = 0; m < 4; ++m) { bf16_t* rowp = QKV + (size_t)(row0 + ai * HALF + m * 16) * 4096 + col0;
#pragma unroll
                for (int bj = 0; bj < 2; ++bj) { const u32x4 o = *(const u32x4*)(rowp + bj * HALF); float of[8]; unpack8(o, of);
                    const f32x4 v0 = acc[ai][bj][m][0], v1 = acc[ai][bj][m][1];
                    u32x4 w; w.x = cvt_pk_bf16(of[0] * silu_f(v0[0]), of[1] * silu_f(v0[1])); w.y = cvt_pk_bf16(of[2] * silu_f(v0[2]), of[3] * silu_f(v0[3]));
                    w.z = cvt_pk_bf16(of[4] * silu_f(v1[0]), of[5] * silu_f(v1[1])); w.w = cvt_pk_bf16(of[6] * silu_f(v1[2]), of[7] * silu_f(v1[3]));
                    *(u32x4*)(rowp + bj * HALF) = w; } }
    }
};
struct EpiNull {
    static constexpr bool PERM = true;
    float* sink;
    __device__ __forceinline__ void operator()(const f32x4 (&acc)[2][2][4][2], const Unit& u, int wr, int wc, int fr, int fq) const {
        float t = 0.f;
#pragma unroll
        for (int ai = 0; ai < 2; ++ai)
#pragma unroll
            for (int bj = 0; bj < 2; ++bj)
#pragma unroll
                for (int m = 0; m < 4; ++m)
#pragma unroll
                    for (int n = 0; n < 2; ++n) t += acc[ai][bj][m][n][0] + acc[ai][bj][m][n][1] + acc[ai][bj][m][n][2] + acc[ai][bj][m][n][3];
        if (t == 12345.678f) sink[0] = t;
    }
};
}

__device__ void transpose_tile(const float* src, int ld_src, int k0, int ncol0, int ncols_valid, bf16_t* dst, int ld_dst, int dst_row0, float* tile) {
    const int tid = threadIdx.x;
    { const int r = tid >> 4, c4 = (tid & 15) * 4;
#pragma unroll
        for (int i = 0; i < 2; ++i) { const int row = r + 32 * i; f32x4 v = (f32x4){0.f, 0.f, 0.f, 0.f};
            if (ncol0 + c4 < ncols_valid) v = *(const f32x4*)(src + (size_t)(k0 + row) * ld_src + ncol0 + c4);
            tile[row * 65 + c4 + 0] = v[0]; tile[row * 65 + c4 + 1] = v[1]; tile[row * 65 + c4 + 2] = v[2]; tile[row * 65 + c4 + 3] = v[3]; } }
    __syncthreads();
    { const int n = tid >> 3, k8 = (tid & 7) * 8; float f[8];
#pragma unroll
        for (int j = 0; j < 8; ++j) f[j] = tile[(k8 + j) * 65 + n];
        *(u32x4*)(dst + (size_t)(dst_row0 + n) * ld_dst + k0 + k8) = pack8(f); }
    __syncthreads();
}
__device__ void phase_prep(const Params& p, unsigned char* lds_g) {
    float* tile = (float*)lds_g;
    bf16_t* W1t = (bf16_t*)(p.ws + WS_W1T); bf16_t* Wgt = (bf16_t*)(p.ws + WS_WGT); bf16_t* W2t = (bf16_t*)(p.ws + WS_W2T); bf16_t* W3t = (bf16_t*)(p.ws + WS_W3T); bf16_t* W4t = (bf16_t*)(p.ws + WS_W4T);
    float* mod = (float*)(p.ws + WS_MOD);
    const int tid = threadIdx.x;
    constexpr int N_MOD = 288, N_W1 = 1024, N_WG = 256, N_W2 = 512, N_W3 = 1600, N_W4 = 512, N_ALL = N_MOD + N_W1 + N_WG + N_W2 + N_W3 + N_W4;
    for (int it = blockIdx.x; it < N_ALL; it += gridDim.x) {
        int i = it;
        if (i < N_MOD) {
            const int colchunk = i % 48, rg = i / 48; const int col = colchunk * 128 + (tid & 127), ksl = tid >> 7, layer = col / 3072, cc = col % 3072;
            for (int idx = tid; idx < 8192; idx += NT) { const int k = idx >> 3, r = idx & 7, row = rg * 8 + r;
                const float cv = row < 16 ? p.c_prompt[row * 1024 + k] : p.c_sample[(row - 16) * 1024 + k]; tile[idx] = silu_f(cv); }
            __syncthreads();
            float a[8];
#pragma unroll
            for (int r = 0; r < 8; ++r) a[r] = 0.f;
            const float* wp = p.ada_w + (size_t)layer * 1024 * 3072 + (size_t)(ksl * 256) * 3072 + cc; const float* tp = tile + ksl * 256 * 8;
#pragma unroll 16
            for (int k = 0; k < 256; ++k) { const float w = wp[(size_t)k * 3072]; const f32x4 s0 = *(const f32x4*)(tp + k * 8), s1 = *(const f32x4*)(tp + k * 8 + 4);
                a[0] += w * s0[0]; a[1] += w * s0[1]; a[2] += w * s0[2]; a[3] += w * s0[3]; a[4] += w * s1[0]; a[5] += w * s1[1]; a[6] += w * s1[2]; a[7] += w * s1[3]; }
            __syncthreads();
#pragma unroll
            for (int r = 0; r < 8; ++r) tile[(ksl * 8 + r) * 128 + (tid & 127)] = a[r];
            __syncthreads();
            if (tid < 128) { const float bias = p.ada_b[layer * 3072 + cc];
#pragma unroll
                for (int r = 0; r < 8; ++r) mod[((size_t)layer * 48 + rg * 8 + r) * 3072 + cc] = tile[r * 128 + tid] + tile[(8 + r) * 128 + tid] + tile[(16 + r) * 128 + tid] + tile[(24 + r) * 128 + tid] + bias; }
            __syncthreads();
            continue;
        }
        i -= N_MOD;
        if (i < N_W1) { const int kt = i & 15, ntile = i >> 4; transpose_tile(p.pool_w_in, 4096, kt * 64, ntile * 64, 4096, W1t, 1024, ntile * 64, tile); continue; }
        i -= N_W1;
        if (i < N_WG) { const int g = i >> 6, r = i & 63, kt = r & 7, ntile = r >> 3; transpose_tile(p.pool_w_group + (size_t)g * 512 * 512, 512, kt * 64, ntile * 64, 512, Wgt + (size_t)g * 512 * 512, 512, ntile * 64, tile); continue; }
        i -= N_WG;
        if (i < N_W2) { const int kt = i & 31, ntile = i >> 5; transpose_tile(p.pool_w_out, 1024, kt * 64, ntile * 64, 1024, W2t, 2048, ntile * 64, tile); continue; }
        i -= N_W2;
        if (i < N_W3) { const int kt = i & 15, ntile = i >> 4; const int n0 = ntile * 64;
            const int src0 = n0 < 4096 ? n0 : (n0 < 4352 ? 6144 + (n0 - 4096) : 4096 + (n0 - 4352));
            const int valid = (n0 >= 4096 && n0 < 4352) ? 6176 : 1 << 30;
            transpose_tile(p.gdn_w_in, 6176, kt * 64, src0, valid, W3t, 1024, n0, tile); continue; }
        i -= N_W3;
        { const int kt = i & 31, ntile = i >> 5; transpose_tile(p.gdn_w_out, 1024, kt * 64, ntile * 64, 1024, W4t, 2048, ntile * 64, tile); }
    }
}

constexpr int NR = 4;
__device__ void phase_norm_mod(const float* x_lo, const float* x_hi, const float* gain, const float* modl, bf16_t* H) {
    const int lane = threadIdx.x & 63, wid = threadIdx.x >> 6;
    for (int rp = blockIdx.x * 8 + wid; rp < T / NR; rp += gridDim.x * 8) {
        f32x4 v[NR][4]; float ss[NR];
#pragma unroll
        for (int q = 0; q < NR; ++q) { const int row = rp * NR + q; const float* xr = row < TP ? x_lo + (size_t)row * 1024 : x_hi + (size_t)(row - TP) * 1024;
#pragma unroll
            for (int j = 0; j < 4; ++j) v[q][j] = *(const f32x4*)(xr + j * 256 + lane * 4); }
#pragma unroll
        for (int q = 0; q < NR; ++q) { float a = 0.f;
#pragma unroll
            for (int j = 0; j < 4; ++j) a += v[q][j][0] * v[q][j][0] + v[q][j][1] * v[q][j][1] + v[q][j][2] * v[q][j][2] + v[q][j][3] * v[q][j][3];
#pragma unroll
            for (int o = 32; o >= 1; o >>= 1) a += __shfl_xor(a, o);
            ss[q] = a; }
#pragma unroll
        for (int q = 0; q < NR; ++q) { const int row = rp * NR + q; const float r = rsqrtf(ss[q] * (1.0f / 1024.0f) + EPS);
            const float* ms = modl + (size_t)seq_of_row(row) * 3072;
#pragma unroll
            for (int j = 0; j < 4; ++j) { const int c = j * 256 + lane * 4; const f32x4 gn = *(const f32x4*)(gain + c), sh = *(const f32x4*)(ms + c), sc = *(const f32x4*)(ms + 1024 + c);
                const f32x4 o = v[q][j] * r * gn * (sc + 1.0f) + sh; u32x2 w; w.x = cvt_pk_bf16(o[0], o[1]); w.y = cvt_pk_bf16(o[2], o[3]); *(u32x2*)(H + (size_t)row * 1024 + c) = w; } }
    }
}
__device__ void phase_norm_final(const float* X, const float* gain, float* out) {
    const int lane = threadIdx.x & 63, wid = threadIdx.x >> 6;
    for (int rp = blockIdx.x * 8 + wid; rp < T / NR; rp += gridDim.x * 8) {
        f32x4 v[NR][4]; float ss[NR];
#pragma unroll
        for (int q = 0; q < NR; ++q) { const float* xr = X + (size_t)(rp * NR + q) * 1024;
#pragma unroll
            for (int j = 0; j < 4; ++j) v[q][j] = *(const f32x4*)(xr + j * 256 + lane * 4); }
#pragma unroll
        for (int q = 0; q < NR; ++q) { float a = 0.f;
#pragma unroll
            for (int j = 0; j < 4; ++j) a += v[q][j][0] * v[q][j][0] + v[q][j][1] * v[q][j][1] + v[q][j][2] * v[q][j][2] + v[q][j][3] * v[q][j][3];
#pragma unroll
            for (int o = 32; o >= 1; o >>= 1) a += __shfl_xor(a, o);
            ss[q] = a; }
#pragma unroll
        for (int q = 0; q < NR; ++q) { const float r = rsqrtf(ss[q] * (1.0f / 1024.0f) + EPS);
#pragma unroll
            for (int j = 0; j < 4; ++j) { const int c = j * 256 + lane * 4; const f32x4 gn = *(const f32x4*)(gain + c); __builtin_nontemporal_store(v[q][j] * r * gn, (f32x4*)(out + (size_t)(rp * NR + q) * 1024 + c)); } }
    }
}

struct SeqInfo { int sq, lc, seq_t0; bool sample, last; };
__device__ __forceinline__ SeqInfo chunk_info(int chunk) { SeqInfo s; if (chunk < 1024) { s.sq = chunk >> 6; s.lc = chunk & 63; s.seq_t0 = s.sq * 4096; s.sample = false; s.last = (s.lc == 63); } else { const int cs = chunk - 1024; s.sq = 16 + cs; s.lc = 0; s.seq_t0 = TP + cs * 64; s.sample = true; s.last = true; } return s; }
__device__ __forceinline__ void pool_fetch(const bf16_t* U, const float* spool, const SeqInfo& si, int pos, int c, float (&f)[8]) {
    if (pos >= 0) { const u32x4 w = *(const u32x4*)(U + (size_t)(si.seq_t0 + pos) * 2048 + c); unpack8(w, f); }
    else if (si.sample) { const float* sp = spool + ((size_t)(si.sq - 16) * 15 + 15 + pos) * 2048 + c; const f32x4 a = *(const f32x4*)sp, b = *(const f32x4*)(sp + 4);
        f[0] = a[0]; f[1] = a[1]; f[2] = a[2]; f[3] = a[3]; f[4] = b[0]; f[5] = b[1]; f[6] = b[2]; f[7] = b[3]; }
    else {
#pragma unroll
        for (int j = 0; j < 8; ++j) f[j] = 0.f; }
}
template <int W>
__device__ __forceinline__ void pool_fast(const Params& p, const bf16_t* U, bf16_t* D, const SeqInfo& si, int g, int col8, int rs) {
    const int c = g * 512 + col8 * 8; const int p0 = si.lc * 64 + rs * 8;
    u32x4 raw[W + 7];
#pragma unroll
    for (int k = 0; k < W + 7; ++k) { const int pos = p0 - (W - 1) + k; raw[k] = pos >= 0 ? *(const u32x4*)(U + (size_t)(si.seq_t0 + pos) * 2048 + c) : (u32x4){0u, 0u, 0u, 0u}; }
    float s[8], cur[8], old[8];
#pragma unroll
    for (int j = 0; j < 8; ++j) s[j] = 0.f;
#pragma unroll
    for (int k = 0; k < W - 1; ++k) { unpack8(raw[k], cur);
#pragma unroll
        for (int j = 0; j < 8; ++j) s[j] += cur[j]; }
#pragma unroll
    for (int i = 0; i < 8; ++i) { const int pos = p0 + i; unpack8(raw[W - 1 + i], cur);
        if (i > 0) { unpack8(raw[i - 1], old);
#pragma unroll
            for (int j = 0; j < 8; ++j) s[j] -= old[j]; }
#pragma unroll
        for (int j = 0; j < 8; ++j) s[j] += cur[j];
        const float inv = 1.0f / fminf((float)(pos + 1), (float)W);
        float d[8];
#pragma unroll
        for (int j = 0; j < 8; ++j) d[j] = s[j] * inv - cur[j];
        *(u32x4*)(D + (size_t)(si.seq_t0 + pos) * 2048 + c) = pack8(d);
        const int rl = rs * 8 + i;
        if (si.last && rl >= 49) { float* op = p.out + O_POOL_P + ((size_t)si.sq * 15 + (rl - 49)) * 2048 + c;
            *(f32x4*)op = (f32x4){cur[0], cur[1], cur[2], cur[3]}; *(f32x4*)(op + 4) = (f32x4){cur[4], cur[5], cur[6], cur[7]}; }
    }
}
__device__ void phase_pool(const Params& p) {
    const bf16_t* U = (const bf16_t*)(p.ws + WS_R1); bf16_t* D = (bf16_t*)(p.ws + WS_R3);
    const int tid = threadIdx.x, col8 = tid & 63, rs = tid >> 6;
    for (int it = blockIdx.x; it < NCHUNK * 4; it += gridDim.x) {
        const int chunk = it >> 2, g = it & 3, w = 2 << g; const SeqInfo si = chunk_info(chunk);
        if (!si.sample) {
            if (g == 0) pool_fast<2>(p, U, D, si, g, col8, rs); else if (g == 1) pool_fast<4>(p, U, D, si, g, col8, rs); else if (g == 2) pool_fast<8>(p, U, D, si, g, col8, rs); else pool_fast<16>(p, U, D, si, g, col8, rs);
            continue;
        }
        const int c = g * 512 + col8 * 8; const int p0 = si.lc * 64 + rs * 8;
        float s[8], cur[8], old[8];
#pragma unroll
        for (int j = 0; j < 8; ++j) s[j] = 0.f;
        for (int q = p0 - w + 1; q < p0; ++q) { pool_fetch(U, p.state_pool, si, q, c, cur);
#pragma unroll
            for (int j = 0; j < 8; ++j) s[j] += cur[j]; }
#pragma unroll 1
        for (int i = 0; i < 8; ++i) { const int pos = p0 + i;
            pool_fetch(U, p.state_pool, si, pos, c, cur);
            if (i > 0) { pool_fetch(U, p.state_pool, si, pos - w, c, old);
#pragma unroll
                for (int j = 0; j < 8; ++j) s[j] -= old[j]; }
#pragma unroll
            for (int j = 0; j < 8; ++j) s[j] += cur[j];
            const float inv = 1.0f / (float)w;
            float d[8];
#pragma unroll
            for (int j = 0; j < 8; ++j) d[j] = s[j] * inv - cur[j];
            *(u32x4*)(D + (size_t)(si.seq_t0 + pos) * 2048 + c) = pack8(d);
            const int rl = rs * 8 + i;
            if (rl >= 49) { float* op = p.out + O_POOL_S + ((size_t)(si.sq - 16) * 15 + (rl - 49)) * 2048 + c;
                *(f32x4*)op = (f32x4){cur[0], cur[1], cur[2], cur[3]}; *(f32x4*)(op + 4) = (f32x4){cur[4], cur[5], cur[6], cur[7]}; }
        }
    }
}

__device__ void phase_conv(const Params& p) {
    bf16_t* QKV = (bf16_t*)(p.ws + WS_R1); const bf16_t* STASH = (const bf16_t*)(p.ws + WS_STASH); const float* AB = (const float*)(p.ws + WS_AB);
    float* GC = (float*)(p.ws + WS_GC); float* BETA = (float*)(p.ws + WS_BETA);
    const int tid = threadIdx.x, stream = tid >> 7, ct = tid & 127, lane = tid & 63, wid = tid >> 6;
    for (int it = blockIdx.x; it < NCHUNK * 4; it += gridDim.x) {
        const int chunk = it >> 2, qt = it & 3; const SeqInfo si = chunk_info(chunk); const int t0 = chunk * 64;
        const int ch = qt * 1024 + ct * 8; const int r0 = stream * 16;
        float wv[4][8];
#pragma unroll
        for (int t = 0; t < 4; ++t) { const f32x4 a = *(const f32x4*)(p.gdn_conv_w + t * 4096 + ch), b = *(const f32x4*)(p.gdn_conv_w + t * 4096 + ch + 4);
            wv[t][0] = a[0]; wv[t][1] = a[1]; wv[t][2] = a[2]; wv[t][3] = a[3]; wv[t][4] = b[0]; wv[t][5] = b[1]; wv[t][6] = b[2]; wv[t][7] = b[3]; }
        float h0[8], h1[8], h2[8];
        if (stream > 0) { unpack8(*(const u32x4*)(QKV + (size_t)(t0 + r0 - 3) * 4096 + ch), h0); unpack8(*(const u32x4*)(QKV + (size_t)(t0 + r0 - 2) * 4096 + ch), h1); unpack8(*(const u32x4*)(QKV + (size_t)(t0 + r0 - 1) * 4096 + ch), h2); }
        else if (si.lc > 0) { const bf16_t* sp = STASH + (size_t)(chunk - 1) * 3 * 4096 + ch; unpack8(*(const u32x4*)sp, h0); unpack8(*(const u32x4*)(sp + 4096), h1); unpack8(*(const u32x4*)(sp + 8192), h2); }
        else if (si.sample) { const float* sp = p.state_conv + (size_t)(si.sq - 16) * 3 * 4096 + ch;
#pragma unroll
            for (int j = 0; j < 8; ++j) { h0[j] = sp[j]; h1[j] = sp[4096 + j]; h2[j] = sp[8192 + j]; } }
        else {
#pragma unroll
            for (int j = 0; j < 8; ++j) { h0[j] = 0.f; h1[j] = 0.f; h2[j] = 0.f; } }
        u32x4 xr[16];
#pragma unroll
        for (int i = 0; i < 16; ++i) xr[i] = *(const u32x4*)(QKV + (size_t)(t0 + r0 + i) * 4096 + ch);
        __syncthreads();
#pragma unroll
        for (int i = 0; i < 16; ++i) {
            bf16_t* rp = QKV + (size_t)(t0 + r0 + i) * 4096 + ch; float x[8], o[8]; unpack8(xr[i], x);
            float ss = 0.f;
#pragma unroll
            for (int j = 0; j < 8; ++j) { const float cv = wv[0][j] * h0[j] + wv[1][j] * h1[j] + wv[2][j] * h2[j] + wv[3][j] * x[j]; o[j] = silu_f(cv); ss += o[j] * o[j]; h0[j] = h1[j]; h1[j] = h2[j]; h2[j] = x[j]; }
            if (qt < 2) { ss = dpp_sum16(ss);
                const float sc = rsqrtf(ss + EPS) * (qt == 0 ? 0.08838834764831845f : 1.0f);
#pragma unroll
                for (int j = 0; j < 8; ++j) o[j] *= sc; }
            *(u32x4*)rp = pack8(o);
            if (si.last && stream == 3 && i >= 13) { float* op = p.out + (si.sample ? O_CONV_S + ((size_t)(si.sq - 16) * 3 + (i - 13)) * 4096 : O_CONV_P + ((size_t)si.sq * 3 + (i - 13)) * 4096) + ch;
                *(f32x4*)op = (f32x4){x[0], x[1], x[2], x[3]}; *(f32x4*)(op + 4) = (f32x4){x[4], x[5], x[6], x[7]}; }
        }
        if (qt == 0) {
#pragma unroll
            for (int hh = 0; hh < 2; ++hh) { const int h = wid * 2 + hh; const float a = AB[(size_t)(t0 + lane) * 32 + h], b = AB[(size_t)(t0 + lane) * 32 + 16 + h];
                const float xx = a + p.gdn_dt_bias[h]; const float sp = xx > 20.f ? xx : log1pf(expf(xx)); float g = -expf(p.gdn_a_log[h]) * sp;
#pragma unroll
                for (int o = 1; o < 64; o <<= 1) { const float t = __shfl_up(g, o); if (lane >= o) g += t; }
                GC[((size_t)chunk * 16 + h) * 64 + lane] = g; BETA[((size_t)chunk * 16 + h) * 64 + lane] = 1.0f / (1.0f + expf(-b)); }
        }
    }
}

__device__ void phase_j1(const Params& p, unsigned char* lds_g) {
    const bf16_t* QKV = (const bf16_t*)(p.ws + WS_R1); const float* GC = (const float*)(p.ws + WS_GC); const float* BETA = (const float*)(p.ws + WS_BETA);
    bf16_t* AH = (bf16_t*)(p.out + O_Y); bf16_t* AQK = AH + (size_t)NCHUNK * 16 * 4096;
    const int lane = threadIdx.x & 63, wid = threadIdx.x >> 6, c = lane & 15, q4 = lane >> 4;
    float* Lw = (float*)(lds_g + wid * 17408);
    for (int wi = blockIdx.x * 8 + wid; wi < NCHUNK * 16; wi += gridDim.x * 8) {
        const int chunk = wi >> 4, h = wi & 15, hk = h >> 1; const size_t t0 = (size_t)chunk * 64;
        const bf16_t* kb = QKV + t0 * 4096 + 1024 + hk * 128; const bf16_t* qb = QKV + t0 * 4096 + hk * 128;
        const float* gcp = GC + (size_t)wi * 64; const float* btp = BETA + (size_t)wi * 64;
        bf16x8 kf[4][4];
#pragma unroll
        for (int mt = 0; mt < 4; ++mt)
#pragma unroll
            for (int ks = 0; ks < 4; ++ks) kf[mt][ks] = *(const bf16x8*)(kb + (size_t)(16 * mt + c) * 4096 + 32 * ks + 8 * q4);
        float gcc[4];
#pragma unroll
        for (int nt = 0; nt < 4; ++nt) gcc[nt] = gcp[16 * nt + c];
#pragma unroll
        for (int mt = 0; mt < 4; ++mt) {
            bf16x8 qf[4];
#pragma unroll
            for (int ks = 0; ks < 4; ++ks) qf[ks] = *(const bf16x8*)(qb + (size_t)(16 * mt + c) * 4096 + 32 * ks + 8 * q4);
            const f32x4 gcr = *(const f32x4*)(gcp + 16 * mt + 4 * q4), btr = *(const f32x4*)(btp + 16 * mt + 4 * q4);
#pragma unroll
            for (int nt = 0; nt < 4; ++nt) {
                bf16_t* aq = AQK + ((size_t)wi * 64 + 16 * mt + 4 * q4) * 64 + 16 * nt + c;
                if (nt <= mt) {
                    f32x4 kk = (f32x4){0.f, 0.f, 0.f, 0.f}, qk = (f32x4){0.f, 0.f, 0.f, 0.f};
#pragma unroll
                    for (int ks = 0; ks < 4; ++ks) { kk = __builtin_amdgcn_mfma_f32_16x16x32_bf16(kf[mt][ks], kf[nt][ks], kk, 0, 0, 0); qk = __builtin_amdgcn_mfma_f32_16x16x32_bf16(qf[ks], kf[nt][ks], qk, 0, 0, 0); }
#pragma unroll
                    for (int e = 0; e < 4; ++e) { const int i = 16 * mt + 4 * q4 + e, j = 16 * nt + c; const float dec = __expf(fminf(gcr[e] - gcc[nt], 0.f));
                        Lw[i * 68 + j] = (i > j) ? btr[e] * kk[e] * dec : 0.f;
                        const float a = (i >= j) ? qk[e] * dec : 0.f; aq[e * 64] = (bf16_t)(cvt_pk_bf16(a, 0.f) & 0xffffu); }
                } else {
#pragma unroll
                    for (int e = 0; e < 4; ++e) aq[e * 64] = (bf16_t)0;
                }
            }
        }
        __builtin_amdgcn_fence(__ATOMIC_RELEASE, "wavefront"); __builtin_amdgcn_wave_barrier();
        float t[64];
#pragma unroll
        for (int i = 0; i < 64; ++i) {
            float s0 = (lane == i) ? 1.f : 0.f, s1 = 0.f, s2 = 0.f, s3 = 0.f;
#pragma unroll
            for (int j4 = 0; j4 < i; j4 += 4) { const f32x4 l = *(const f32x4*)(Lw + i * 68 + j4);
                s0 -= l[0] * t[j4]; if (j4 + 1 < i) s1 -= l[1] * t[j4 + 1]; if (j4 + 2 < i) s2 -= l[2] * t[j4 + 2]; if (j4 + 3 < i) s3 -= l[3] * t[j4 + 3]; }
            t[i] = (s0 + s1) + (s2 + s3);
        }
        const float bc = btp[lane];
        bf16_t* ah = AH + (size_t)wi * 4096 + lane;
#pragma unroll
        for (int i = 0; i < 64; ++i) ah[i * 64] = (bf16_t)(cvt_pk_bf16(t[i] * bc, 0.f) & 0xffffu);
        __builtin_amdgcn_wave_barrier();
    }
}

__device__ __forceinline__ bf16x8 pack_acc2(const f32x4 a, const f32x4 b) { u32x4 w; w.x = cvt_pk_bf16(a[0], a[1]); w.y = cvt_pk_bf16(a[2], a[3]); w.z = cvt_pk_bf16(b[0], b[1]); w.w = cvt_pk_bf16(b[2], b[3]); return __builtin_bit_cast(bf16x8, w); }
__device__ __forceinline__ bf16x8 ld_perm(const bf16_t* ptr) { const u32x2 a = *(const u32x2*)ptr, b = *(const u32x2*)(ptr + 16); u32x4 w; w.x = a.x; w.y = a.y; w.z = b.x; w.w = b.y; return __builtin_bit_cast(bf16x8, w); }
#define LDS_BARRIER() do { asm volatile("s_waitcnt lgkmcnt(0)" ::: "memory"); __builtin_amdgcn_s_barrier(); asm volatile("" ::: "memory"); } while (0)
__device__ void phase_j2(const Params& p, unsigned char* lds_g, bool dry) {
    bf16_t* QKV = (bf16_t*)(p.ws + WS_R1); const float* GC = (const float*)(p.ws + WS_GC);
    const bf16_t* AH = (const bf16_t*)(p.out + O_Y); const bf16_t* AQK = AH + (size_t)NCHUNK * 16 * 4096;
    const int tid = threadIdx.x, lane = tid & 63, w = tid >> 6, c = lane & 15, q4 = lane >> 4;
    constexpr int KN_OFF = 0, QN_OFF = 17408, KT_OFF = 34816, VT_OFF = 53248, AH_OFF = 71680, AQ_OFF = 80896, OS_OFF = 90112, SSQ_OFF = 107520;
    LAS unsigned char* L = (LAS unsigned char*)lds_g;
    LAS bf16_t* KT = (LAS bf16_t*)(L + KT_OFF); LAS bf16_t* VT = (LAS bf16_t*)(L + VT_OFF); LAS bf16_t* OS = (LAS bf16_t*)(L + OS_OFF);
    LAS float* SSQ = (LAS float*)(L + SSQ_OFF);
    const float nw = p.gdn_norm_w[16 * w + c];
    const int rowl = tid & 63, seg = tid >> 6;
    int par = 0;
    if (tid < 128) ((LAS float*)(L + 111616 + 1024))[tid] = 0.f;
    u32x4 rk0, rk1, rq0, rq1, rv0, rv1, ra, rqk; float ngate, ngl;
    LAS float* GEX = (LAS float*)(L + 111616);
    LAS float* SSQT = (LAS float*)(L + 111616 + 1024);
#define J2_LOAD(chunk_) do { const size_t t0_ = (size_t)(chunk_) * 64; const size_t ci_ = (size_t)(chunk_) * 16 + h; \
        const bf16_t* kb_ = QKV + (t0_ + rowl) * 4096 + 1024 + hk * 128 + seg * 16; const bf16_t* qb_ = QKV + (t0_ + rowl) * 4096 + hk * 128 + seg * 16; const bf16_t* vb_ = QKV + (t0_ + rowl) * 4096 + 2048 + h * 128 + seg * 16; \
        rk0 = *(const u32x4*)kb_; rk1 = *(const u32x4*)(kb_ + 8); rq0 = *(const u32x4*)qb_; rq1 = *(const u32x4*)(qb_ + 8); rv0 = *(const u32x4*)vb_; rv1 = *(const u32x4*)(vb_ + 8); \
        ra = *(const u32x4*)(AH + ci_ * 4096 + tid * 8); rqk = *(const u32x4*)(AQK + ci_ * 4096 + tid * 8); \
        ngate = GC[ci_ * 64 + rowl]; ngl = GC[ci_ * 64 + 63]; } while (0)
#define J2_STORE() do { *(LAS u32x4*)(L + KN_OFF + rowl * 272 + seg * 32) = rk0; *(LAS u32x4*)(L + KN_OFF + rowl * 272 + seg * 32 + 16) = rk1; \
        *(LAS u32x4*)(L + QN_OFF + rowl * 272 + seg * 32) = rq0; *(LAS u32x4*)(L + QN_OFF + rowl * 272 + seg * 32 + 16) = rq1; \
        { const unsigned kw_[8] = {rk0.x, rk0.y, rk0.z, rk0.w, rk1.x, rk1.y, rk1.z, rk1.w}; const unsigned vw_[8] = {rv0.x, rv0.y, rv0.z, rv0.w, rv1.x, rv1.y, rv1.z, rv1.w}; \
          _Pragma("unroll") for (int j_ = 0; j_ < 8; ++j_) { KT[(seg * 16 + 2 * j_) * 72 + rowl] = (bf16_t)(kw_[j_] & 0xffffu); KT[(seg * 16 + 2 * j_ + 1) * 72 + rowl] = (bf16_t)(kw_[j_] >> 16); \
              VT[(seg * 16 + 2 * j_) * 72 + rowl] = (bf16_t)(vw_[j_] & 0xffffu); VT[(seg * 16 + 2 * j_ + 1) * 72 + rowl] = (bf16_t)(vw_[j_] >> 16); } } \
        *(LAS u32x4*)(L + AH_OFF + (tid >> 3) * 144 + (tid & 7) * 16) = ra; *(LAS u32x4*)(L + AQ_OFF + (tid >> 3) * 144 + (tid & 7) * 16) = rqk; if (tid < 64) { GEX[tid] = __expf(ngate); GEX[64 + tid] = __expf(ngl - ngate); if (tid == 63) GEX[128] = __expf(ngl); } } while (0)
#define J2_FRAG(off_) ({ const u32x2 a_ = *(const LAS u32x2*)(L + (off_)); const u32x2 b_ = *(const LAS u32x2*)(L + (off_) + 32); u32x4 w_; w_.x = a_.x; w_.y = a_.y; w_.z = b_.x; w_.w = b_.y; __builtin_bit_cast(bf16x8, w_); })
    for (int item = blockIdx.x; item < 768; item += gridDim.x) {
        int chunk0, nch, h; const float* s0 = nullptr; float* sout;
        if (item < 256) { const int b = item >> 4; h = item & 15; chunk0 = b * 64; nch = 64; sout = p.out + O_REC_P + ((size_t)b * 16 + h) * 16384; }
        else { const int b = (item - 256) >> 4; h = item & 15; chunk0 = 1024 + b; nch = 1; s0 = p.state_rec + ((size_t)b * 16 + h) * 16384; sout = p.out + O_REC_S + ((size_t)b * 16 + h) * 16384; }
        const int hk = h >> 1;
        f32x4 S[8];
        { int loff = (4 * q4) * 128 + 16 * w + c; asm volatile("" : "+v"(loff));
#pragma unroll
        for (int mt = 0; mt < 8; ++mt) {
            if (s0) {
#pragma unroll
                for (int e = 0; e < 4; ++e) S[mt][e] = s0[loff + (16 * mt + e) * 128]; }
            else S[mt] = (f32x4){0.f, 0.f, 0.f, 0.f};
        } }
        J2_LOAD(chunk0);
        LDS_BARRIER();
        J2_STORE();
        LDS_BARRIER();
        for (int n = 0; n < nch; ++n, par ^= 1) {
            const int chunk = chunk0 + n; const size_t t0 = (size_t)chunk * 64; const size_t ci = (size_t)chunk * 16 + h;
            const float egl = GEX[128];
            if (n + 1 < nch) J2_LOAD(chunk + 1);
            LAS float* ssq = SSQT + par * 64;
            bf16x8 Sb[4];
#pragma unroll
            for (int ks = 0; ks < 4; ++ks) Sb[ks] = pack_acc2(S[2 * ks], S[2 * ks + 1]);
#define J2_SB() __builtin_amdgcn_sched_barrier(0)
#define J2_LDKQ(dstk, dstq, mt_) do { _Pragma("unroll") for (int ks_ = 0; ks_ < 4; ++ks_) { const int o_ = (16 * (mt_) + c) * 272 + (32 * ks_ + 4 * q4) * 2; dstk[ks_] = J2_FRAG(KN_OFF + o_); dstq[ks_] = J2_FRAG(QN_OFF + o_); } } while (0)
#define J2_MMKQ(srck, srcq, mt_) do { _Pragma("unroll") for (int ks_ = 0; ks_ < 4; ++ks_) { P[mt_] = __builtin_amdgcn_mfma_f32_16x16x32_bf16(srck[ks_], Sb[ks_], P[mt_], 0, 0, 0); QS[mt_] = __builtin_amdgcn_mfma_f32_16x16x32_bf16(srcq[ks_], Sb[ks_], QS[mt_], 0, 0, 0); } } while (0)
            f32x4 P[4], QS[4];
#pragma unroll
            for (int mt = 0; mt < 4; ++mt) { P[mt] = (f32x4){0.f, 0.f, 0.f, 0.f}; QS[mt] = (f32x4){0.f, 0.f, 0.f, 0.f}; }
            bf16x8 ka[4], qa[4], kb2[4], qb2[4]; u32x2 vv[4];
            J2_LDKQ(ka, qa, 0); J2_LDKQ(kb2, qb2, 1);
            J2_SB(); J2_MMKQ(ka, qa, 0); J2_LDKQ(ka, qa, 2);
            J2_SB(); J2_MMKQ(kb2, qb2, 1); J2_LDKQ(kb2, qb2, 3);
            J2_SB(); J2_MMKQ(ka, qa, 2);
            bf16x8 ahf[4][2], aqf[4][2];
#pragma unroll
            for (int mt = 0; mt < 4; ++mt)
#pragma unroll
                for (int k2 = 0; k2 < 2; ++k2) ahf[mt][k2] = J2_FRAG(AH_OFF + (16 * mt + c) * 144 + (32 * k2 + 4 * q4) * 2);
            f32x4 egc[4];
#pragma unroll
            for (int mt = 0; mt < 4; ++mt) { egc[mt] = *(const LAS f32x4*)(GEX + 16 * mt + 4 * q4);
                vv[mt] = *(const LAS u32x2*)(L + VT_OFF + (16 * w + c) * 144 + (16 * mt + 4 * q4) * 2); }
            J2_SB(); J2_MMKQ(kb2, qb2, 3);
            J2_SB();
            f32x4 edl[4];
#pragma unroll
            for (int mt = 0; mt < 4; ++mt) edl[mt] = *(const LAS f32x4*)(GEX + 64 + 16 * mt + 4 * q4);
            f32x4 R[4];
#pragma unroll
            for (int mt = 0; mt < 4; ++mt) { R[mt][0] = bf_lo(vv[mt].x) - egc[mt][0] * P[mt][0]; R[mt][1] = bf_hi(vv[mt].x) - egc[mt][1] * P[mt][1]; R[mt][2] = bf_lo(vv[mt].y) - egc[mt][2] * P[mt][2]; R[mt][3] = bf_hi(vv[mt].y) - egc[mt][3] * P[mt][3]; }
            bf16x8 Rb[2];
#pragma unroll
            for (int k2 = 0; k2 < 2; ++k2) Rb[k2] = pack_acc2(R[2 * k2], R[2 * k2 + 1]);
            J2_SB();
            f32x4 Vn[4];
#pragma unroll
            for (int mt = 0; mt < 4; ++mt) { Vn[mt] = (f32x4){0.f, 0.f, 0.f, 0.f};
#pragma unroll
                for (int k2 = 0; k2 < 2; ++k2) Vn[mt] = __builtin_amdgcn_mfma_f32_16x16x32_bf16(ahf[mt][k2], Rb[k2], Vn[mt], 0, 0, 0); }
            J2_SB();
#pragma unroll
            for (int mt = 0; mt < 4; ++mt)
#pragma unroll
                for (int k2 = 0; k2 < 2; ++k2) aqf[mt][k2] = J2_FRAG(AQ_OFF + (16 * mt + c) * 144 + (32 * k2 + 4 * q4) * 2);
            bf16x8 ktf[4][2];
#pragma unroll
            for (int mt = 0; mt < 4; ++mt)
#pragma unroll
                for (int k2 = 0; k2 < 2; ++k2) ktf[mt][k2] = J2_FRAG(KT_OFF + (16 * mt + c) * 144 + (32 * k2 + 4 * q4) * 2);
            bf16x8 Vb[2], Vsb[2];
#pragma unroll
            for (int k2 = 0; k2 < 2; ++k2) { Vb[k2] = pack_acc2(Vn[2 * k2], Vn[2 * k2 + 1]); Vsb[k2] = pack_acc2(Vn[2 * k2] * edl[2 * k2], Vn[2 * k2 + 1] * edl[2 * k2 + 1]); }
            J2_SB();
            f32x4 O[4];
#pragma unroll
            for (int mt = 0; mt < 4; ++mt) { O[mt] = QS[mt] * egc[mt];
#pragma unroll
                for (int k2 = 0; k2 < 2; ++k2) O[mt] = __builtin_amdgcn_mfma_f32_16x16x32_bf16(aqf[mt][k2], Vb[k2], O[mt], 0, 0, 0); }
            J2_SB();
#pragma unroll
            for (int mt = 0; mt < 4; ++mt) { S[mt] = S[mt] * egl;
#pragma unroll
                for (int k2 = 0; k2 < 2; ++k2) S[mt] = __builtin_amdgcn_mfma_f32_16x16x32_bf16(ktf[mt][k2], Vsb[k2], S[mt], 0, 0, 0); }
            J2_SB();
#pragma unroll
            for (int mt = 0; mt < 4; ++mt)
#pragma unroll
                for (int k2 = 0; k2 < 2; ++k2) ktf[mt][k2] = J2_FRAG(KT_OFF + (16 * (mt + 4) + c) * 144 + (32 * k2 + 4 * q4) * 2);
#pragma unroll
            for (int mt = 0; mt < 4; ++mt) { f32x4 sq = O[mt] * O[mt]; sq[0] = dpp_sum16(sq[0]); sq[1] = dpp_sum16(sq[1]); sq[2] = dpp_sum16(sq[2]); sq[3] = dpp_sum16(sq[3]);
                if (c == 0) {
#pragma unroll
                    for (int e = 0; e < 4; ++e) __hip_atomic_fetch_add(ssq + 16 * mt + 4 * q4 + e, sq[e], __ATOMIC_RELAXED, __HIP_MEMORY_SCOPE_WORKGROUP); } }
            J2_SB();
#pragma unroll
            for (int mt = 0; mt < 4; ++mt) { S[mt + 4] = S[mt + 4] * egl;
#pragma unroll
                for (int k2 = 0; k2 < 2; ++k2) S[mt + 4] = __builtin_amdgcn_mfma_f32_16x16x32_bf16(ktf[mt][k2], Vsb[k2], S[mt + 4], 0, 0, 0); }
#undef J2_SB
#undef J2_LDKQ
#undef J2_MMKQ
            LDS_BARRIER();
#pragma unroll
            for (int mt = 0; mt < 4; ++mt) { const f32x4 tot = *(const LAS f32x4*)(ssq + 16 * mt + 4 * q4);
#pragma unroll
                for (int e = 0; e < 4; ++e) { const float r = rsqrtf(tot[e] * (1.0f / 128.0f) + EPS); OS[(16 * mt + 4 * q4 + e) * 136 + 16 * w + c] = (bf16_t)(cvt_pk_bf16(O[mt][e] * r * nw, 0.f) & 0xffffu); } }
            LDS_BARRIER();
            { const int row = tid >> 3, s8 = tid & 7; const u32x4 o0 = *(const LAS u32x4*)(L + OS_OFF + row * 272 + s8 * 32), o1 = *(const LAS u32x4*)(L + OS_OFF + row * 272 + s8 * 32 + 16);
              bf16_t* op = QKV + (t0 + row) * 4096 + 2048 + h * 128 + s8 * 16; if (!dry) { *(u32x4*)op = o0; *(u32x4*)(op + 8) = o1; } }
            if (n + 1 < nch) J2_STORE();
            if (tid < 64) SSQT[(par ^ 1) * 64 + tid] = 0.f;
            LDS_BARRIER();
        }
        { int loff = (4 * q4) * 128 + 16 * w + c; asm volatile("" : "+v"(loff));
#pragma unroll
        for (int mt = 0; mt < 8; ++mt)
#pragma unroll
            for (int e = 0; e < 4; ++e) if (!dry) sout[loff + (16 * mt + e) * 128] = S[mt][e]; }
    }
#undef J2_LOAD
#undef J2_STORE
#undef J2_FRAG
}


#define XB_TMO      128
#define XB_XCNT(j)  (256  + 64 * (j))
#define XB_XSUB(j)  (1280 + 64 * (j))
#define XB_XGEN(j)  (2304 + 64 * (j))
#define XB_TOP      3328
#define XB_TOPGEN   3392
#define XCD_BAR_WORDS 3456
#define XB_SPIN_CAP (1u << 18)
__device__ __forceinline__ unsigned xb_ld(unsigned* p)              { return __hip_atomic_load(p, __ATOMIC_RELAXED, __HIP_MEMORY_SCOPE_AGENT); }
__device__ __forceinline__ unsigned xb_add(unsigned* p, unsigned v) { return __hip_atomic_fetch_add(p, v, __ATOMIC_RELAXED, __HIP_MEMORY_SCOPE_AGENT); }
__device__ __forceinline__ unsigned xb_xcc_id() { return (unsigned)__builtin_amdgcn_s_getreg((3 << 11) | 20) & 0xFu; }
#define XB_SPIN(cond, bar) do { unsigned _sp = 0; while (cond) { __builtin_amdgcn_s_sleep(1); \
    if ((++_sp & 255u) == 0u) { if (xb_ld(&(bar)[XB_TMO])) break; if (_sp > XB_SPIN_CAP) { atomicAdd(&(bar)[XB_TMO], 1u); break; } } } } while (0)
struct XcdBarrier { unsigned* bar; unsigned x; volatile LAS unsigned* st; };
__device__ __forceinline__ XcdBarrier xcd_barrier_post(unsigned* bar, volatile LAS unsigned* st) {
    XcdBarrier b; b.bar = bar; b.x = xb_xcc_id(); b.st = st;
    if (threadIdx.x == 0) (void)xb_add(&bar[XB_XCNT(b.x)], 1u);
    return b;
}
__device__ __forceinline__ void xcd_barrier_complete(unsigned* bar, unsigned x, unsigned& nloc, unsigned& nx) {
    const unsigned G = gridDim.x * gridDim.y * gridDim.z;
    unsigned sum, cnt, mine, sp = 0u;
    for (;;) {
        sum = 0u; cnt = 0u; mine = 0u;
#pragma unroll
        for (unsigned j = 0; j < 16; ++j) { const unsigned c = xb_ld(&bar[XB_XCNT(j)]); sum += c; cnt += (c > 0u) ? 1u : 0u; mine = (j == x) ? c : mine; }
        if (sum == G) break;
        __builtin_amdgcn_s_sleep(1);
        if ((++sp & 255u) == 0u) { if (xb_ld(&bar[XB_TMO])) break; if (sp > XB_SPIN_CAP) { atomicAdd(&bar[XB_TMO], 1u); break; } }
    }
    nloc = mine > 0u ? mine : 1u; nx = cnt > 0u ? cnt : 1u;
}
__device__ __forceinline__ void xcd_barrier(const XcdBarrier& b) {
    asm volatile("s_waitcnt vmcnt(0)" ::: "memory");
    __syncthreads();
    if (threadIdx.x == 0) {
        unsigned* bar = b.bar;
        __builtin_amdgcn_s_waitcnt(0);
        unsigned nloc = b.st[0], nx = b.st[1];
        if (nloc == 0u) { xcd_barrier_complete(bar, b.x, nloc, nx); b.st[0] = nloc; b.st[1] = nx; }
        const unsigned old = xb_add(&bar[XB_XSUB(b.x)], 1u);
        const unsigned gen = old / nloc;
        if (old + 1u == (gen + 1u) * nloc) {
            __builtin_amdgcn_fence(__ATOMIC_RELEASE, "agent");
            asm volatile("s_waitcnt vmcnt(0)" ::: "memory");
            const unsigned og = xb_add(&bar[XB_TOP], 1u);
            const unsigned tg = og / nx;
            if (og + 1u == (tg + 1u) * nx) xb_add(&bar[XB_TOPGEN], 1u);
            else XB_SPIN(xb_ld(&bar[XB_TOPGEN]) == tg, bar);
            __builtin_amdgcn_fence(__ATOMIC_ACQUIRE, "agent");
            xb_add(&bar[XB_XGEN(b.x)], 1u);
            asm volatile("s_waitcnt vmcnt(0)" ::: "memory");
        } else {
            XB_SPIN(xb_ld(&bar[XB_XGEN(b.x)]) == gen, bar);
            __builtin_amdgcn_fence(__ATOMIC_ACQUIRE, "agent");
            asm volatile("s_waitcnt vmcnt(0)" ::: "memory");
        }
    }
    __syncthreads();
}

constexpr int N_PHASES = 14;
#ifndef PH_MASK
#define PH_MASK 0x3fff
#endif
#define PH_ON(n) (((PH_MASK) >> (n)) & 1)
#ifndef REP_MASK
#define REP_MASK 0
#endif
#define REP_ON(n) (((REP_MASK) >> (n)) & 1)
__global__ void __launch_bounds__(NT, 2) mega(Params p, int ph_lo, int ph_hi, int rep_mask) {
    extern __shared__ __attribute__((aligned(16))) unsigned char lds[];
    LAS unsigned char* ldsl = (LAS unsigned char*)lds;
    cg::grid_group grid = cg::this_grid();
    unsigned char* ws = p.ws;
    bf16_t* W1t = (bf16_t*)(ws + WS_W1T); bf16_t* Wgt = (bf16_t*)(ws + WS_WGT); bf16_t* W2t = (bf16_t*)(ws + WS_W2T); bf16_t* W3t = (bf16_t*)(ws + WS_W3T); bf16_t* W4t = (bf16_t*)(ws + WS_W4T);
    float* mod = (float*)(ws + WS_MOD); bf16_t* H = (bf16_t*)(ws + WS_H); bf16_t* R1 = (bf16_t*)(ws + WS_R1); bf16_t* R2 = (bf16_t*)(ws + WS_R2); bf16_t* R3 = (bf16_t*)(ws + WS_R3);
    float* X1 = (float*)(ws + WS_R3);
    const int G = gridDim.x, bid = blockIdx.x;
    volatile LAS unsigned* xst = (volatile LAS unsigned*)(ldsl + LDS_BYTES - 16);
    if (threadIdx.x == 0) { xst[0] = 0u; xst[1] = 0u; }
    __syncthreads();
    const XcdBarrier xb = xcd_barrier_post((unsigned*)(ws + WS_BAR), xst);
#define IN(k) (ph_lo <= (k) && (k) < ph_hi)
#define SEAM(k) do { if (IN(k) && IN((k) + 1)) { if (ph_lo < 0) grid.sync(); else xcd_barrier(xb); } } while (0)
    if (PH_ON(0) && IN(0)) { phase_prep(p, lds); }
    SEAM(0);
    if (PH_ON(1) && IN(1)) { phase_norm_mod(p.x_prompt, p.x_sample, p.norm_gain, mod, H); }
    SEAM(1);
    if (PH_ON(2) && IN(2)) { { pg8::Gemm g{H, W1t, T, 4096, 1024, 1024, 1024, 0, 0}; pg8::StaticOrder S; S.init(T, 4096, G, bid); pg8::EpiL0In E{R1, R2}; pg8::gemm_phase(ldsl, g, S, E); } }
    SEAM(2);
    if (PH_ON(3) && IN(3)) { phase_pool(p); }
    SEAM(3);
    if (PH_ON(4) && IN(4)) { { pg8::Gemm g{R3, Wgt, T, 2048, 512, 2048, 512, 2, 1024}; pg8::StaticOrder S; S.init(T, 2048, G, bid); pg8::EpiGrp E{R1, R2, p.pool_scale}; pg8::gemm_phase(ldsl, g, S, E); } }
    SEAM(4);
    if (PH_ON(5) && IN(5)) { { pg8::Gemm g{R1, W2t, T, 1024, 2048, 2048, 2048, 0, 0}; pg8::StaticOrder S; S.init(T, 1024, G, bid); pg8::EpiRes E{p.x_prompt, p.x_sample, X1, mod + 2048}; pg8::gemm_phase(ldsl, g, S, E); } }
    SEAM(5);
    if (PH_ON(6) && IN(6)) { phase_norm_mod(X1, X1 + (size_t)TP * 1024, p.norm_gain + 1024, mod + 48 * 3072, H); }
    SEAM(6);
    if (PH_ON(7) && IN(7)) { { pg8::Gemm g{H, W3t, T, 4352, 1024, 1024, 1024, 0, 0}; pg8::StaticOrder S; S.init(T, 4352, G, bid); pg8::EpiL1In E{R1, (bf16_t*)(ws + WS_STASH), (float*)(ws + WS_AB)}; pg8::gemm_phase(ldsl, g, S, E); } }
    SEAM(7);
    if (PH_ON(8) && IN(8)) { phase_conv(p); }
    SEAM(8);
    if (PH_ON(9) && IN(9)) { phase_j1(p, lds); }
    SEAM(9);
    if (PH_ON(10) && IN(10)) { phase_j2(p, lds, false); }
    SEAM(10);
    if (PH_ON(11) && IN(11)) { { pg8::Gemm g{H, W3t + (size_t)4352 * 1024, T, 2048, 1024, 1024, 1024, 0, 0}; pg8::StaticOrder S; S.init(T, 2048, G, bid); pg8::EpiZ E{R1}; pg8::gemm_phase(ldsl, g, S, E); } }
    SEAM(11);
    if (PH_ON(12) && IN(12)) { { pg8::Gemm g{R1 + 2048, W4t, T, 1024, 2048, 4096, 2048, 0, 0}; pg8::StaticOrder S; S.init(T, 1024, G, bid); pg8::EpiRes E{X1, X1 + (size_t)TP * 1024, X1, mod + 48 * 3072 + 2048}; pg8::gemm_phase(ldsl, g, S, E); } }
    SEAM(12);
    if (PH_ON(13) && IN(13)) { phase_norm_final(X1, p.final_gain, p.out + O_Y); }
    SEAM(13);
#undef IN
#undef SEAM
}

#ifndef MK_ONE_LAUNCH
#define MK_ONE_LAUNCH 1
#endif
extern "C" void kernel_launch(void* const* d_in, const int* in_sizes, int n_in, void* d_out, int out_size, void* d_ws, size_t ws_size, hipStream_t stream) {
    static int grid = 0;
    if (grid == 0) {
        if (ws_size < WS_END) { fprintf(stderr, "kernel_launch: workspace too small: %zu < %zu\n", ws_size, (size_t)WS_END); grid = -1; return; }
        int dev = 0, cus = 0, per_cu = 0;
        hipGetDevice(&dev); hipDeviceGetAttribute(&cus, hipDeviceAttributeMultiprocessorCount, dev);
        if (hipFuncSetAttribute((const void*)mega, hipFuncAttributeMaxDynamicSharedMemorySize, LDS_BYTES) != hipSuccess) { fprintf(stderr, "kernel_launch: hipFuncSetAttribute failed\n"); grid = -1; return; }
        if (hipOccupancyMaxActiveBlocksPerMultiprocessor(&per_cu, (const void*)mega, NT, LDS_BYTES) != hipSuccess || per_cu < 1) { fprintf(stderr, "kernel_launch: occupancy query gave %d\n", per_cu); per_cu = 1; }
        (void)hipGetLastError();
        grid = cus * per_cu;
    }
    if (grid < 0) return;
    Params p{};
    p.x_prompt = (const float*)d_in[0]; p.x_sample = (const float*)d_in[1]; p.c_prompt = (const float*)d_in[2]; p.c_sample = (const float*)d_in[3];
    p.state_pool = (const float*)d_in[4]; p.state_conv = (const float*)d_in[5]; p.state_rec = (const float*)d_in[6];
    p.norm_gain = (const float*)d_in[7]; p.ada_w = (const float*)d_in[8]; p.ada_b = (const float*)d_in[9];
    p.pool_w_in = (const float*)d_in[10]; p.pool_w_group = (const float*)d_in[11]; p.pool_scale = (const float*)d_in[12]; p.pool_w_out = (const float*)d_in[13];
    p.gdn_w_in = (const float*)d_in[14]; p.gdn_conv_w = (const float*)d_in[15]; p.gdn_a_log = (const float*)d_in[16]; p.gdn_dt_bias = (const float*)d_in[17]; p.gdn_norm_w = (const float*)d_in[18]; p.gdn_w_out = (const float*)d_in[19];
    p.final_gain = (const float*)d_in[20];
    p.out = (float*)d_out; p.ws = (unsigned char*)d_ws;
    if (hipMemsetAsync((unsigned char*)d_ws + WS_BAR, 0, 16384, stream) != hipSuccess) { fprintf(stderr, "kernel_launch: memset of barrier words failed\n"); return; }
#if MK_ONE_LAUNCH
    int lo = 0, hi = N_PHASES, rep = REP_MASK; void* args[] = {&p, &lo, &hi, &rep};
    hipError_t e = hipLaunchCooperativeKernel((const void*)mega, dim3(grid), dim3(NT), args, LDS_BYTES, stream);
    if (e != hipSuccess) fprintf(stderr, "cooperative launch failed: %s (grid %d)\n", hipGetErrorString(e), grid);
#else
    for (int ph = 0; ph < N_PHASES; ++ph) { hipLaunchKernelGGL(mega, dim3(grid), dim3(NT), LDS_BYTES, stream, p, ph, ph + 1, 0); }
#endif
}
```

```cpp
#include <hip/hip_runtime.h>
#include <hip/hip_cooperative_groups.h>
#include <cstdio>
namespace cg = cooperative_groups;

#define LAS __attribute__((address_space(3)))
typedef unsigned short bf16_t;
typedef short bf16x8 __attribute__((ext_vector_type(8)));
typedef short bf16x4 __attribute__((ext_vector_type(4)));
typedef float f32x4 __attribute__((ext_vector_type(4)));
typedef unsigned u32x4 __attribute__((ext_vector_type(4)));
typedef unsigned u32x2 __attribute__((ext_vector_type(2)));

constexpr int DM = 1024, TP = 65536, TS = 2048, T = TP + TS, NSEQ = 48, NCHUNK = T / 64;
constexpr int NT = 512, LDS_BYTES = 147456;
constexpr float EPS = 1e-6f;

constexpr size_t SZ_BIG = (size_t)T * 2048 * 2;
constexpr size_t WS_W1T = 0;
constexpr size_t WS_WGT = WS_W1T + (size_t)4096 * 1024 * 2;
constexpr size_t WS_W2T = WS_WGT + (size_t)2048 * 512 * 2;
constexpr size_t WS_W3T = WS_W2T + (size_t)1024 * 2048 * 2;
constexpr size_t WS_W4T = WS_W3T + (size_t)6400 * 1024 * 2;
constexpr size_t WS_MOD = WS_W4T + (size_t)1024 * 2048 * 2;
constexpr size_t WS_AB = WS_MOD + (size_t)2 * 48 * 3072 * 4;
constexpr size_t WS_GC = WS_AB + (size_t)T * 32 * 4;
constexpr size_t WS_BETA = WS_GC + (size_t)T * 16 * 4;
constexpr size_t WS_STASH = WS_BETA + (size_t)T * 16 * 4;
constexpr size_t WS_H = WS_STASH + (size_t)NCHUNK * 3 * 4096 * 2;
constexpr size_t WS_R1 = WS_H + (size_t)T * 1024 * 2;
constexpr size_t WS_R2 = WS_R1 + SZ_BIG;
constexpr size_t WS_R3 = WS_R2 + SZ_BIG;
constexpr size_t WS_BAR = WS_R3 + SZ_BIG;
constexpr size_t WS_END = WS_BAR + 16384;

constexpr size_t O_Y = 0;
constexpr size_t O_POOL_P = (size_t)T * 1024;
constexpr size_t O_CONV_P = O_POOL_P + (size_t)16 * 15 * 2048;
constexpr size_t O_REC_P = O_CONV_P + (size_t)16 * 3 * 4096;
constexpr size_t O_POOL_S = O_REC_P + (size_t)16 * 16 * 16384;
constexpr size_t O_CONV_S = O_POOL_S + (size_t)32 * 15 * 2048;
constexpr size_t O_REC_S = O_CONV_S + (size_t)32 * 3 * 4096;

struct Params {
    const float* x_prompt; const float* x_sample; const float* c_prompt; const float* c_sample;
    const float* state_pool; const float* state_conv; const float* state_rec;
    const float* norm_gain; const float* ada_w; const float* ada_b;
    const float* pool_w_in; const float* pool_w_group; const float* pool_scale; const float* pool_w_out;
    const float* gdn_w_in; const float* gdn_conv_w; const float* gdn_a_log; const float* gdn_dt_bias; const float* gdn_norm_w; const float* gdn_w_out;
    const float* final_gain;
    float* out; unsigned char* ws;
};

__device__ __forceinline__ unsigned cvt_pk_bf16(float lo, float hi) { unsigned r; asm volatile("v_cvt_pk_bf16_f32 %0, %1, %2" : "=v"(r) : "v"(lo), "v"(hi)); return r; }
__device__ __forceinline__ float bf_lo(unsigned w) { return __uint_as_float(w << 16); }
__device__ __forceinline__ float bf_hi(unsigned w) { return __uint_as_float(w & 0xffff0000u); }
__device__ __forceinline__ float silu_f(float x) { return x * __builtin_amdgcn_rcpf(1.0f + __expf(-x)); }
__device__ __forceinline__ void unpack8(const u32x4 w, float (&f)[8]) { f[0] = bf_lo(w.x); f[1] = bf_hi(w.x); f[2] = bf_lo(w.y); f[3] = bf_hi(w.y); f[4] = bf_lo(w.z); f[5] = bf_hi(w.z); f[6] = bf_lo(w.w); f[7] = bf_hi(w.w); }
__device__ __forceinline__ u32x4 pack8(const float (&f)[8]) { u32x4 w; w.x = cvt_pk_bf16(f[0], f[1]); w.y = cvt_pk_bf16(f[2], f[3]); w.z = cvt_pk_bf16(f[4], f[5]); w.w = cvt_pk_bf16(f[6], f[7]); return w; }
__device__ __forceinline__ int seq_of_row(int row) { return row < TP ? (row >> 12) : 16 + ((row - TP) >> 6); }

__device__ __forceinline__ float dpp_sum16(float v) {
    v += __int_as_float(__builtin_amdgcn_update_dpp(0, __float_as_int(v), 0xB1, 0xF, 0xF, true));
    v += __int_as_float(__builtin_amdgcn_update_dpp(0, __float_as_int(v), 0x4E, 0xF, 0xF, true));
    v += __int_as_float(__builtin_amdgcn_update_dpp(0, __float_as_int(v), 0x141, 0xF, 0xF, true));
    v += __int_as_float(__builtin_amdgcn_update_dpp(0, __float_as_int(v), 0x140, 0xF, 0xF, true));
    return v;
}
namespace pg8 {
constexpr int BM = 256, BK = 64, HALF = 128, HTB = HALF * BK * 2, STAGE_BYTES = 8 * HTB, NXCD = 8, WGM = 4;
__device__ __forceinline__ int lds_byte(int r, int c) { const int st = (r >> 4) * 2 + (c >> 5), rr = r & 15, cc = c & 31, ob = rr * 64 + cc * 2; return st * 1024 + (ob ^ (((ob >> 9) & 1) << 5)); }
__device__ __forceinline__ void stage_rc(int b, int& R, int& C) { const int st = b / 1024, sb = b % 1024, swz = sb ^ (((sb >> 9) & 1) << 5); R = (st >> 1) * 16 + swz / 64; C = (st & 1) * 32 + (swz % 64) / 2; }
__device__ __forceinline__ int perm32(int rho) { const int n = rho >> 4, i = rho & 15; return 8 * (i >> 2) + 4 * n + (i & 3); }
struct Unit { int pm, pn; };
struct Gemm { const bf16_t* A; const bf16_t* Bt; int M, N, K, lda, ldb, a_grp_div; long a_gstride; int pm_mask = 0xffff; };
struct StaticOrder {
    int nM, nN, nwg, G, c;
    __device__ void init(int M, int N, int G_, int c_) { nM = M / BM; nN = N / BM; nwg = nM * nN; G = G_; c = c_; }
    __device__ bool next(int i, Unit& u) const {
        const long L = (long)i * G + c; if (L >= nwg) return false;
        int wgid = (int)L; { const int q = nwg / NXCD, r = nwg % NXCD, xcd = wgid % NXCD, off = wgid / NXCD; wgid = (xcd < r ? xcd * (q + 1) : r * (q + 1) + (xcd - r) * q) + off; }
        const int nig = WGM * nN, gid = wgid / nig, fm = gid * WGM, gsz = (nM - fm) < WGM ? (nM - fm) : WGM;
        u.pm = fm + ((wgid % nig) % gsz); u.pn = (wgid % nig) / gsz; return true;
    }
};

template <class Epi>
__device__ __forceinline__ void gemm_phase(LAS unsigned char* lds, const Gemm g, const StaticOrder& S, const Epi& E) {
    const int tid = threadIdx.x, wid = __builtin_amdgcn_readfirstlane(tid >> 6), lane = tid & 63, wr = wid >> 2, wc = wid & 3, fr = lane & 15, fq = lane >> 4;
    const int K = g.K, nt = K / BK;
    unsigned voffA[2], voffB[2];
#pragma unroll
    for (int i = 0; i < 2; ++i) { int R, C; stage_rc(tid * 16 + i * 8192, R, C); const int Rb = Epi::PERM ? ((R & ~31) + perm32(R & 31)) : R;
        voffA[i] = (unsigned)(R * g.lda + C) * 2u; voffB[i] = (unsigned)(Rb * g.ldb + C) * 2u; }
    const size_t kstep = (size_t)(BK * 2);
    const size_t hsA = (size_t)HALF * g.lda * 2, hsB = (size_t)HALF * g.ldb * 2;
    const size_t tsA = 2 * hsA, tsB = 2 * hsB;
    const unsigned ldsw = (unsigned)wid * 1024u;
    const int aoff = lds_byte(wr * 64 + fr, fq * 8), boff = lds_byte(wc * 32 + fr, fq * 8);
#define PG8_SA(b, h) (((b) * 2 + (h)) * HTB)
#define PG8_SB(b, h) ((4 + (b) * 2 + (h)) * HTB)
#define PG8_STAGE(bufoff, gbase, voff) do { _Pragma("unroll") for (int _i = 0; _i < 2; ++_i) \
        __builtin_amdgcn_global_load_lds((const unsigned*)((const char*)(gbase) + (voff)[_i]), (LAS unsigned*)(lds + (bufoff) + ldsw + _i * 8192), 16, 0, 0); } while (0)
#define PG8_LDA(dst, b, h) do { _Pragma("unroll") for (int m = 0; m < 4; ++m) _Pragma("unroll") for (int k = 0; k < 2; ++k) dst[m][k] = *(const LAS bf16x8*)(lds + PG8_SA(b, h) + aoff + m * 2048 + k * 1024); } while (0)
#define PG8_LDB(dst, b, h) do { _Pragma("unroll") for (int n = 0; n < 2; ++n) _Pragma("unroll") for (int k = 0; k < 2; ++k) dst[n][k] = *(const LAS bf16x8*)(lds + PG8_SB(b, h) + boff + n * 2048 + k * 1024); } while (0)
#define PG8_MMA(ai, bj, At, Bt) do { __builtin_amdgcn_s_setprio(1); _Pragma("unroll") for (int m = 0; m < 4; ++m) _Pragma("unroll") for (int n = 0; n < 2; ++n) _Pragma("unroll") for (int k = 0; k < 2; ++k) \
        acc[ai][bj][m][n] = __builtin_amdgcn_mfma_f32_16x16x32_bf16(Bt[n][k], At[m][k], acc[ai][bj][m][n], 0, 0, 0); __builtin_amdgcn_s_setprio(0); } while (0)
#define PG8_WAIT_V(n) asm volatile("s_waitcnt vmcnt(" #n ")" ::: "memory")
#define PG8_WAIT_L(n) asm volatile("s_waitcnt lgkmcnt(" #n ")" ::: "memory")
#define PG8_BAR __builtin_amdgcn_s_barrier()
#define PG8_SCHED __builtin_amdgcn_sched_barrier(0)
#define PG8_APTR(u) ((const char*)g.A + (size_t)((u).pm & g.pm_mask) * tsA + (g.a_grp_div ? (size_t)((u).pn / g.a_grp_div) * (size_t)g.a_gstride : (size_t)0))
#define PG8_BPTR(u) ((const char*)g.Bt + (size_t)(u).pn * tsB)
    Unit cur, nxt; int ui = 0;
    if (!S.next(0, cur)) return;
    f32x4 acc[2][2][4][2];
#pragma unroll
    for (int a = 0; a < 2; ++a)
#pragma unroll
        for (int b = 0; b < 2; ++b)
#pragma unroll
            for (int m = 0; m < 4; ++m)
#pragma unroll
                for (int n = 0; n < 2; ++n) acc[a][b][m][n] = (f32x4){0.f, 0.f, 0.f, 0.f};
    bf16x8 At[4][2], B0[2][2], B1[2][2];
    const char* cA = PG8_APTR(cur); const char* cB = PG8_BPTR(cur);
    PG8_STAGE(PG8_SB(0, 0), cB, voffB); PG8_STAGE(PG8_SA(0, 0), cA, voffA); PG8_STAGE(PG8_SB(0, 1), cB + hsB, voffB); PG8_STAGE(PG8_SA(0, 1), cA + hsA, voffA);
    if (wr == 1) PG8_BAR;
    PG8_WAIT_V(4); PG8_BAR;
    PG8_STAGE(PG8_SB(1, 0), cB + kstep, voffB); PG8_STAGE(PG8_SA(1, 0), cA + kstep, voffA); PG8_STAGE(PG8_SB(1, 1), cB + hsB + kstep, voffB);
    PG8_WAIT_V(6); PG8_BAR;
    for (;;) {
        const bool has_next = S.next(ui + 1, nxt);
        const char* nA = has_next ? PG8_APTR(nxt) : cA; const char* nB = has_next ? PG8_BPTR(nxt) : cB;
        for (int t = 0; t < nt; t += 2) {
            const bool last = (t == nt - 2);
            const char* a1 = cA + (size_t)(t + 1) * kstep;
            const char* a2 = last ? nA : cA + (size_t)(t + 2) * kstep; const char* b2 = last ? nB : cB + (size_t)(t + 2) * kstep;
            const char* a3 = a2 + kstep; const char* b3 = b2 + kstep;
            PG8_LDB(B0, 0, 0); PG8_SCHED; PG8_LDA(At, 0, 0); PG8_STAGE(PG8_SA(1, 1), a1 + hsA, voffA);
            PG8_WAIT_L(8); PG8_BAR; PG8_WAIT_L(0); PG8_MMA(0, 0, At, B0); PG8_BAR; PG8_SCHED;
            PG8_LDB(B1, 0, 1); PG8_STAGE(PG8_SB(0, 0), b2, voffB);
            PG8_BAR; PG8_WAIT_L(0); PG8_MMA(0, 1, At, B1); PG8_BAR;
            PG8_LDA(At, 0, 1); PG8_STAGE(PG8_SA(0, 0), a2, voffA);
            PG8_BAR; PG8_WAIT_L(0); PG8_MMA(1, 0, At, B0); PG8_BAR; PG8_SCHED;
            PG8_STAGE(PG8_SB(0, 1), b2 + hsB, voffB);
            PG8_WAIT_V(6); PG8_BAR; PG8_MMA(1, 1, At, B1); PG8_BAR;
            PG8_LDB(B0, 1, 0); PG8_SCHED; PG8_LDA(At, 1, 0); PG8_STAGE(PG8_SA(0, 1), a2 + hsA, voffA);
            PG8_WAIT_L(8); PG8_BAR; PG8_WAIT_L(0); PG8_MMA(0, 0, At, B0); PG8_BAR; PG8_SCHED;
            PG8_LDB(B1, 1, 1); PG8_STAGE(PG8_SB(1, 0), b3, voffB);
            PG8_BAR; PG8_WAIT_L(0); PG8_MMA(0, 1, At, B1); PG8_BAR;
            PG8_LDA(At, 1, 1); PG8_STAGE(PG8_SA(1, 0), a3, voffA);
            PG8_BAR; PG8_WAIT_L(0); PG8_MMA(1, 0, At, B0); PG8_BAR; PG8_SCHED;
            PG8_STAGE(PG8_SB(1, 1), b3 + hsB, voffB);
            PG8_WAIT_V(6); PG8_BAR; PG8_MMA(1, 1, At, B1); PG8_BAR;
        }
        E(acc, cur, wr, wc, fr, fq);
        if (!has_next) break;
#pragma unroll
        for (int a = 0; a < 2; ++a)
#pragma unroll
            for (int b = 0; b < 2; ++b)
#pragma unroll
                for (int m = 0; m < 4; ++m)
#pragma unroll
                    for (int n = 0; n < 2; ++n) acc[a][b][m][n] = (f32x4){0.f, 0.f, 0.f, 0.f};
        cur = nxt; cA = nA; cB = nB; ++ui;
    }
    PG8_WAIT_V(0);
    if (wr == 0) PG8_BAR;
    PG8_BAR;
#undef PG8_SA
#undef PG8_SB
#undef PG8_STAGE
#undef PG8_LDA
#undef PG8_LDB
#undef PG8_MMA
#undef PG8_WAIT_V
#undef PG8_WAIT_L
#undef PG8_BAR
#undef PG8_SCHED
#undef PG8_APTR
#undef PG8_BPTR
}

struct EpiL0In {
    static constexpr bool PERM = true;
    bf16_t* U; bf16_t* SZ;
    __device__ __forceinline__ void operator()(const f32x4 (&acc)[2][2][4][2], const Unit& u, int wr, int wc, int fr, int fq) const {
        const int row0 = u.pm * BM + wr * 64 + fr; const bool isz = u.pn >= 8;
        bf16_t* base = isz ? SZ : U; const int col0 = (isz ? u.pn - 8 : u.pn) * BM + wc * 32 + 8 * fq;
#pragma unroll
        for (int ai = 0; ai < 2; ++ai)
#pragma unroll
            for (int m = 0; m < 4; ++m) { bf16_t* rowp = base + (size_t)(row0 + ai * HALF + m * 16) * 2048 + col0;
#pragma unroll
                for (int bj = 0; bj < 2; ++bj) { f32x4 v0 = acc[ai][bj][m][0], v1 = acc[ai][bj][m][1];
                    if (isz) {
#pragma unroll
                        for (int j = 0; j < 4; ++j) { v0[j] = silu_f(v0[j]); v1[j] = silu_f(v1[j]); } }
                    u32x4 w; w.x = cvt_pk_bf16(v0[0], v0[1]); w.y = cvt_pk_bf16(v0[2], v0[3]); w.z = cvt_pk_bf16(v1[0], v1[1]); w.w = cvt_pk_bf16(v1[2], v1[3]);
                    *(u32x4*)(rowp + bj * HALF) = w; } }
    }
};
struct EpiGrp {
    static constexpr bool PERM = true;
    bf16_t* YY; const bf16_t* SZ; const float* scale;
    __device__ __forceinline__ void operator()(const f32x4 (&acc)[2][2][4][2], const Unit& u, int wr, int wc, int fr, int fq) const {
        const int row0 = u.pm * BM + wr * 64 + fr; const int col0 = u.pn * BM + wc * 32 + 8 * fq;
        f32x4 sc[2][2];
#pragma unroll
        for (int bj = 0; bj < 2; ++bj) { sc[bj][0] = *(const f32x4*)(scale + col0 + bj * HALF); sc[bj][1] = *(const f32x4*)(scale + col0 + bj * HALF + 4); }
#pragma unroll
        for (int ai = 0; ai < 2; ++ai)
#pragma unroll
            for (int m = 0; m < 4; ++m) { const size_t off = (size_t)(row0 + ai * HALF + m * 16) * 2048 + col0;
#pragma unroll
                for (int bj = 0; bj < 2; ++bj) { const u32x4 z = *(const u32x4*)(SZ + off + bj * HALF); float zf[8]; unpack8(z, zf);
                    const f32x4 v0 = acc[ai][bj][m][0] * sc[bj][0], v1 = acc[ai][bj][m][1] * sc[bj][1];
                    u32x4 w; w.x = cvt_pk_bf16(v0[0] * zf[0], v0[1] * zf[1]); w.y = cvt_pk_bf16(v0[2] * zf[2], v0[3] * zf[3]); w.z = cvt_pk_bf16(v1[0] * zf[4], v1[1] * zf[5]); w.w = cvt_pk_bf16(v1[2] * zf[6], v1[3] * zf[7]);
                    *(u32x4*)(YY + off + bj * HALF) = w; } }
    }
};
template <bool BASE_BF16> struct EpiRes {
    static constexpr bool PERM = true;
    const float* base_lo; const float* base_hi; const bf16_t* base_b; bf16_t* OUT; const float* gate;
    __device__ __forceinline__ void operator()(const f32x4 (&acc)[2][2][4][2], const Unit& u, int wr, int wc, int fr, int fq) const {
        const int row0 = u.pm * BM + wr * 64 + fr, col0 = u.pn * BM + wc * 32 + 8 * fq;
#pragma unroll
        for (int ai = 0; ai < 2; ++ai) {
            const float* gp = gate + (size_t)seq_of_row(u.pm * BM + ai * HALF + wr * 64) * 3072 + col0;
            f32x4 gv[2][2];
#pragma unroll
            for (int bj = 0; bj < 2; ++bj) { gv[bj][0] = *(const f32x4*)(gp + bj * HALF); gv[bj][1] = *(const f32x4*)(gp + bj * HALF + 4); }
#pragma unroll
            for (int m = 0; m < 4; ++m) { const int row = row0 + ai * HALF + m * 16; bf16_t* op = OUT + (size_t)row * 1024 + col0;
#pragma unroll
                for (int bj = 0; bj < 2; ++bj) { float bs[8];
                    if (BASE_BF16) unpack8(*(const u32x4*)(base_b + (size_t)row * 1024 + col0 + bj * HALF), bs);
                    else { const float* bp = (row < TP ? base_lo + (size_t)row * 1024 : base_hi + (size_t)(row - TP) * 1024) + col0 + bj * HALF; const f32x4 b0 = *(const f32x4*)bp, b1 = *(const f32x4*)(bp + 4);
                        bs[0] = b0[0]; bs[1] = b0[1]; bs[2] = b0[2]; bs[3] = b0[3]; bs[4] = b1[0]; bs[5] = b1[1]; bs[6] = b1[2]; bs[7] = b1[3]; }
                    const f32x4 v0 = acc[ai][bj][m][0] * gv[bj][0], v1 = acc[ai][bj][m][1] * gv[bj][1];
                    u32x4 w; w.x = cvt_pk_bf16(bs[0] + v0[0], bs[1] + v0[1]); w.y = cvt_pk_bf16(bs[2] + v0[2], bs[3] + v0[3]); w.z = cvt_pk_bf16(bs[4] + v1[0], bs[5] + v1[1]); w.w = cvt_pk_bf16(bs[6] + v1[2], bs[7] + v1[3]);
                    *(u32x4*)(op + bj * HALF) = w; } } }
    }
};
struct EpiL1In {
    static constexpr bool PERM = true;
    bf16_t* QKV; bf16_t* STASH; float* AB;
    __device__ __forceinline__ void operator()(const f32x4 (&acc)[2][2][4][2], const Unit& u, int wr, int wc, int fr, int fq) const {
        const int row0 = u.pm * BM + wr * 64 + fr;
        if (u.pn < 16) {
            const int col0 = u.pn * BM + wc * 32 + 8 * fq;
#pragma unroll
            for (int ai = 0; ai < 2; ++ai)
#pragma unroll
                for (int m = 0; m < 4; ++m) { const int row = row0 + ai * HALF + m * 16; bf16_t* rowp = QKV + (size_t)row * 4096 + col0; const int rl = row & 63;
#pragma unroll
                    for (int bj = 0; bj < 2; ++bj) { const f32x4 v0 = acc[ai][bj][m][0], v1 = acc[ai][bj][m][1];
                        u32x4 w; w.x = cvt_pk_bf16(v0[0], v0[1]); w.y = cvt_pk_bf16(v0[2], v0[3]); w.z = cvt_pk_bf16(v1[0], v1[1]); w.w = cvt_pk_bf16(v1[2], v1[3]);
                        *(u32x4*)(rowp + bj * HALF) = w;
                        if (rl >= 61) *(u32x4*)(STASH + ((size_t)(row >> 6) * 3 + (rl - 61)) * 4096 + col0 + bj * HALF) = w; } }
        } else if (wc == 0) {
#pragma unroll
            for (int ai = 0; ai < 2; ++ai)
#pragma unroll
                for (int m = 0; m < 4; ++m) { const int row = row0 + ai * HALF + m * 16; float* rowp = AB + (size_t)row * 32 + 8 * fq;
                    *(f32x4*)(rowp) = acc[ai][0][m][0]; *(f32x4*)(rowp + 4) = acc[ai][0][m][1]; }
        }
    }
};
struct EpiZ {
    static constexpr bool PERM = true;
    bf16_t* QKV;
    __device__ __forceinline__ void operator()(const f32x4 (&acc)[2][2][4][2], const Unit& u, int wr, int wc, int fr, int fq) const {
        const int row0 = u.pm * BM + wr * 64 + fr; const int col0 = 2048 + u.pn * BM + wc * 32 + 8 * fq;
#pragma unroll
        for (int ai = 0; ai < 2; ++ai)
#pragma unroll
            for (int m = 0; m < 4; ++m) { bf16_t* rowp = QKV + (size_t)(row0 + ai * HALF + m * 16) * 4096 + col0;
#pragma unroll
                for (int bj = 0; bj < 2; ++bj) { const u32x4 o = *(const u32x4*)(rowp + bj * HALF); float of[8]; unpack8(o, of);
                    const f32x4 v0 = acc[ai][bj][m][0], v1 = acc[ai][bj][m][1];
                    u32x4 w; w.x = cvt_pk_bf16(of[0] * silu_f(v0[0]), of[1] * silu_f(v0[1])); w.y = cvt_pk_bf16(of[2] * silu_f(v0[2]), of[3] * silu_f(v0[3]));
                    w.z = cvt_pk_bf16(of[4] * silu_f(v1[0]), of[5] * silu_f(v1[1])); w.w = cvt_pk_bf16(of[6] * silu_f(v1[2]), of[7] * silu_f(v1[3]));
                    *(u32x4*)(rowp + bj * HALF) = w; } }
    }
};
struct EpiNull {
    static constexpr bool PERM = true;
    float* sink;
    __device__ __forceinline__ void operator()(const f32x4 (&acc)[2][2][4][2], const Unit& u, int wr, int wc, int fr, int fq) const {
        float t = 0.f;
#pragma unroll
        for (int ai = 0; ai < 2; ++ai)
#pragma unroll
            for (int bj = 0; bj < 2; ++bj)
#pragma unroll
                for (int m = 0; m < 4; ++m)
#pragma unroll
                    for (int n = 0; n < 2; ++n) t += acc[ai][bj][m][n][0] + acc[ai][bj][m][n][1] + acc[ai][bj][m][n][2] + acc[ai][bj][m][n][3];
        if (t == 12345.678f) sink[0] = t;
    }
};
}

__device__ void transpose_tile(const float* src, int ld_src, int k0, int ncol0, int ncols_valid, bf16_t* dst, int ld_dst, int dst_row0, float* tile) {
    const int tid = threadIdx.x;
    { const int r = tid >> 4, c4 = (tid & 15) * 4;
#pragma unroll
        for (int i = 0; i < 2; ++i) { const int row = r + 32 * i; f32x4 v = (f32x4){0.f, 0.f, 0.f, 0.f};
            if (ncol0 + c4 < ncols_valid) v = *(const f32x4*)(src + (size_t)(k0 + row) * ld_src + ncol0 + c4);
            tile[row * 65 + c4 + 0] = v[0]; tile[row * 65 + c4 + 1] = v[1]; tile[row * 65 + c4 + 2] = v[2]; tile[row * 65 + c4 + 3] = v[3]; } }
    __syncthreads();
    { const int n = tid >> 3, k8 = (tid & 7) * 8; float f[8];
#pragma unroll
        for (int j = 0; j < 8; ++j) f[j] = tile[(k8 + j) * 65 + n];
        *(u32x4*)(dst + (size_t)(dst_row0 + n) * ld_dst + k0 + k8) = pack8(f); }
    __syncthreads();
}
__device__ void phase_prep(const Params& p, unsigned char* lds_g) {
    float* tile = (float*)lds_g;
    bf16_t* W1t = (bf16_t*)(p.ws + WS_W1T); bf16_t* Wgt = (bf16_t*)(p.ws + WS_WGT); bf16_t* W2t = (bf16_t*)(p.ws + WS_W2T); bf16_t* W3t = (bf16_t*)(p.ws + WS_W3T); bf16_t* W4t = (bf16_t*)(p.ws + WS_W4T);
    float* mod = (float*)(p.ws + WS_MOD);
    const int tid = threadIdx.x;
    constexpr int N_MOD = 288, N_W1 = 1024, N_WG = 256, N_W2 = 512, N_W3 = 1600, N_W4 = 512, N_ALL = N_MOD + N_W1 + N_WG + N_W2 + N_W3 + N_W4;
    for (int it = blockIdx.x; it < N_ALL; it += gridDim.x) {
        int i = it;
        if (i < N_MOD) {
            const int colchunk = i % 48, rg = i / 48; const int col = colchunk * 128 + (tid & 127), ksl = tid >> 7, layer = col / 3072, cc = col % 3072;
            for (int idx = tid; idx < 8192; idx += NT) { const int k = idx >> 3, r = idx & 7, row = rg * 8 + r;
                const float cv = row < 16 ? p.c_prompt[row * 1024 + k] : p.c_sample[(row - 16) * 1024 + k]; tile[idx] = silu_f(cv); }
            __syncthreads();
            float a[8];
#pragma unroll
            for (int r = 0; r < 8; ++r) a[r] = 0.f;
            const float* wp = p.ada_w + (size_t)layer * 1024 * 3072 + (size_t)(ksl * 256) * 3072 + cc; const float* tp = tile + ksl * 256 * 8;
#pragma unroll 16
            for (int k = 0; k < 256; ++k) { const float w = wp[(size_t)k * 3072]; const f32x4 s0 = *(const f32x4*)(tp + k * 8), s1 = *(const f32x4*)(tp + k * 8 + 4);
                a[0] += w * s0[0]; a[1] += w * s0[1]; a[2] += w * s0[2]; a[3] += w * s0[3]; a[4] += w * s1[0]; a[5] += w * s1[1]; a[6] += w * s1[2]; a[7] += w * s1[3]; }
            __syncthreads();
#pragma unroll
            for (int r = 0; r < 8; ++r) tile[(ksl * 8 + r) * 128 + (tid & 127)] = a[r];
            __syncthreads();
            if (tid < 128) { const float bias = p.ada_b[layer * 3072 + cc];
#pragma unroll
                for (int r = 0; r < 8; ++r) mod[((size_t)layer * 48 + rg * 8 + r) * 3072 + cc] = tile[r * 128 + tid] + tile[(8 + r) * 128 + tid] + tile[(16 + r) * 128 + tid] + tile[(24 + r) * 128 + tid] + bias; }
            __syncthreads();
            continue;
        }
        i -= N_MOD;
        if (i < N_W1) { const int kt = i & 15, ntile = i >> 4; transpose_tile(p.pool_w_in, 4096, kt * 64, ntile * 64, 4096, W1t, 1024, ntile * 64, tile); continue; }
        i -= N_W1;
        if (i < N_WG) { const int g = i >> 6, r = i & 63, kt = r & 7, ntile = r >> 3; transpose_tile(p.pool_w_group + (size_t)g * 512 * 512, 512, kt * 64, ntile * 64, 512, Wgt + (size_t)g * 512 * 512, 512, ntile * 64, tile); continue; }
        i -= N_WG;
        if (i < N_W2) { const int kt = i & 31, ntile = i >> 5; transpose_tile(p.pool_w_out, 1024, kt * 64, ntile * 64, 1024, W2t, 2048, ntile * 64, tile); continue; }
        i -= N_W2;
        if (i < N_W3) { const int kt = i & 15, ntile = i >> 4; const int n0 = ntile * 64;
            const int src0 = n0 < 4096 ? n0 : (n0 < 4352 ? 6144 + (n0 - 4096) : 4096 + (n0 - 4352));
            const int valid = (n0 >= 4096 && n0 < 4352) ? 6176 : 1 << 30;
            transpose_tile(p.gdn_w_in, 6176, kt * 64, src0, valid, W3t, 1024, n0, tile); continue; }
        i -= N_W3;
        { const int kt = i & 31, ntile = i >> 5; transpose_tile(p.gdn_w_out, 1024, kt * 64, ntile * 64, 1024, W4t, 2048, ntile * 64, tile); }
    }
}

constexpr int NR = 4;
__device__ void phase_norm_mod(const float* x_lo, const float* x_hi, const float* gain, const float* modl, bf16_t* H) {
    const int lane = threadIdx.x & 63, wid = threadIdx.x >> 6;
    for (int rp = blockIdx.x * 8 + wid; rp < T / NR; rp += gridDim.x * 8) {
        f32x4 v[NR][4]; float ss[NR];
#pragma unroll
        for (int q = 0; q < NR; ++q) { const int row = rp * NR + q; const float* xr = row < TP ? x_lo + (size_t)row * 1024 : x_hi + (size_t)(row - TP) * 1024;
#pragma unroll
            for (int j = 0; j < 4; ++j) v[q][j] = *(const f32x4*)(xr + j * 256 + lane * 4); }
#pragma unroll
        for (int q = 0; q < NR; ++q) { float a = 0.f;
#pragma unroll
            for (int j = 0; j < 4; ++j) a += v[q][j][0] * v[q][j][0] + v[q][j][1] * v[q][j][1] + v[q][j][2] * v[q][j][2] + v[q][j][3] * v[q][j][3];
#pragma unroll
            for (int o = 32; o >= 1; o >>= 1) a += __shfl_xor(a, o);
            ss[q] = a; }
#pragma unroll
        for (int q = 0; q < NR; ++q) { const int row = rp * NR + q; const float r = rsqrtf(ss[q] * (1.0f / 1024.0f) + EPS);
            const float* ms = modl + (size_t)seq_of_row(row) * 3072;
#pragma unroll
            for (int j = 0; j < 4; ++j) { const int c = j * 256 + lane * 4; const f32x4 gn = *(const f32x4*)(gain + c), sh = *(const f32x4*)(ms + c), sc = *(const f32x4*)(ms + 1024 + c);
                const f32x4 o = v[q][j] * r * gn * (sc + 1.0f) + sh; u32x2 w; w.x = cvt_pk_bf16(o[0], o[1]); w.y = cvt_pk_bf16(o[2], o[3]); *(u32x2*)(H + (size_t)row * 1024 + c) = w; } }
    }
}
template <int MODE>
__device__ void phase_norm_b(const bf16_t* X, const float* gain, const float* modl, bf16_t* H, float* out) {
    constexpr int NRB = 8;
    const int lane = threadIdx.x & 63, wid = threadIdx.x >> 6;
    for (int rp = blockIdx.x * 8 + wid; rp < T / NRB; rp += gridDim.x * 8) {
        u32x4 raw[NRB][2]; float ss[NRB];
#pragma unroll
        for (int q = 0; q < NRB; ++q) { const bf16_t* xr = X + (size_t)(rp * NRB + q) * 1024;
#pragma unroll
            for (int j = 0; j < 2; ++j) raw[q][j] = *(const u32x4*)(xr + j * 512 + lane * 8); }
#pragma unroll
        for (int q = 0; q < NRB; ++q) { float a = 0.f;
#pragma unroll
            for (int j = 0; j < 2; ++j) { float f[8]; unpack8(raw[q][j], f);
#pragma unroll
                for (int e = 0; e < 8; ++e) a += f[e] * f[e]; }
#pragma unroll
            for (int o = 32; o >= 1; o >>= 1) a += __shfl_xor(a, o);
            ss[q] = a; }
#pragma unroll
        for (int q = 0; q < NRB; ++q) { const int row = rp * NRB + q; const float r = rsqrtf(ss[q] * (1.0f / 1024.0f) + EPS);
#pragma unroll
            for (int j = 0; j < 2; ++j) { const int c = j * 512 + lane * 8; float f[8], o[8]; unpack8(raw[q][j], f);
                const f32x4 g0 = *(const f32x4*)(gain + c), g1 = *(const f32x4*)(gain + c + 4);
                if (MODE == 0) { const float* ms = modl + (size_t)seq_of_row(row) * 3072; const f32x4 sh0 = *(const f32x4*)(ms + c), sh1 = *(const f32x4*)(ms + c + 4), sc0 = *(const f32x4*)(ms + 1024 + c), sc1 = *(const f32x4*)(ms + 1024 + c + 4);
#pragma unroll
                    for (int e = 0; e < 4; ++e) { o[e] = f[e] * r * g0[e] * (sc0[e] + 1.0f) + sh0[e]; o[4 + e] = f[4 + e] * r * g1[e] * (sc1[e] + 1.0f) + sh1[e]; }
                    *(u32x4*)(H + (size_t)row * 1024 + c) = pack8(o); }
                else { __builtin_nontemporal_store((f32x4){f[0] * r * g0[0], f[1] * r * g0[1], f[2] * r * g0[2], f[3] * r * g0[3]}, (f32x4*)(out + (size_t)row * 1024 + c));
                    __builtin_nontemporal_store((f32x4){f[4] * r * g1[0], f[5] * r * g1[1], f[6] * r * g1[2], f[7] * r * g1[3]}, (f32x4*)(out + (size_t)row * 1024 + c + 4)); } }
        }
    }
}

struct SeqInfo { int sq, lc, seq_t0; bool sample, last; };
__device__ __forceinline__ SeqInfo chunk_info(int chunk) { SeqInfo s; if (chunk < 1024) { s.sq = chunk >> 6; s.lc = chunk & 63; s.seq_t0 = s.sq * 4096; s.sample = false; s.last = (s.lc == 63); } else { const int cs = chunk - 1024; s.sq = 16 + cs; s.lc = 0; s.seq_t0 = TP + cs * 64; s.sample = true; s.last = true; } return s; }
__device__ __forceinline__ void pool_fetch(const bf16_t* U, const float* spool, const SeqInfo& si, int pos, int c, float (&f)[8]) {
    if (pos >= 0) { const u32x4 w = *(const u32x4*)(U + (size_t)(si.seq_t0 + pos) * 2048 + c); unpack8(w, f); }
    else if (si.sample) { const float* sp = spool + ((size_t)(si.sq - 16) * 15 + 15 + pos) * 2048 + c; const f32x4 a = *(const f32x4*)sp, b = *(const f32x4*)(sp + 4);
        f[0] = a[0]; f[1] = a[1]; f[2] = a[2]; f[3] = a[3]; f[4] = b[0]; f[5] = b[1]; f[6] = b[2]; f[7] = b[3]; }
    else {
#pragma unroll
        for (int j = 0; j < 8; ++j) f[j] = 0.f; }
}
template <int W>
__device__ __forceinline__ void pool_fast(const Params& p, const bf16_t* U, bf16_t* D, const SeqInfo& si, int g, int col8, int rs) {
    const int c = g * 512 + col8 * 8; const int p0 = si.lc * 64 + rs * 8;
    u32x4 raw[W + 7];
#pragma unroll
    for (int k = 0; k < W + 7; ++k) { const int pos = p0 - (W - 1) + k; raw[k] = pos >= 0 ? *(const u32x4*)(U + (size_t)(si.seq_t0 + pos) * 2048 + c) : (u32x4){0u, 0u, 0u, 0u}; }
    float s[8], cur[8], old[8];
#pragma unroll
    for (int j = 0; j < 8; ++j) s[j] = 0.f;
#pragma unroll
    for (int k = 0; k < W - 1; ++k) { unpack8(raw[k], cur);
#pragma unroll
        for (int j = 0; j < 8; ++j) s[j] += cur[j]; }
#pragma unroll
    for (int i = 0; i < 8; ++i) { const int pos = p0 + i; unpack8(raw[W - 1 + i], cur);
        if (i > 0) { unpack8(raw[i - 1], old);
#pragma unroll
            for (int j = 0; j < 8; ++j) s[j] -= old[j]; }
#pragma unroll
        for (int j = 0; j < 8; ++j) s[j] += cur[j];
        const float inv = 1.0f / fminf((float)(pos + 1), (float)W);
        float d[8];
#pragma unroll
        for (int j = 0; j < 8; ++j) d[j] = s[j] * inv - cur[j];
        *(u32x4*)(D + (size_t)(si.seq_t0 + pos) * 2048 + c) = pack8(d);
        const int rl = rs * 8 + i;
        if (si.last && rl >= 49) { float* op = p.out + O_POOL_P + ((size_t)si.sq * 15 + (rl - 49)) * 2048 + c;
            *(f32x4*)op = (f32x4){cur[0], cur[1], cur[2], cur[3]}; *(f32x4*)(op + 4) = (f32x4){cur[4], cur[5], cur[6], cur[7]}; }
    }
}
__device__ void phase_pool(const Params& p) {
    const bf16_t* U = (const bf16_t*)(p.ws + WS_R1); bf16_t* D = (bf16_t*)(p.ws + WS_R3);
    const int tid = threadIdx.x, col8 = tid & 63, rs = tid >> 6;
    for (int it = blockIdx.x; it < NCHUNK * 4; it += gridDim.x) {
        const int chunk = it >> 2, g = it & 3, w = 2 << g; const SeqInfo si = chunk_info(chunk);
        if (!si.sample) {
            if (g == 0) pool_fast<2>(p, U, D, si, g, col8, rs); else if (g == 1) pool_fast<4>(p, U, D, si, g, col8, rs); else if (g == 2) pool_fast<8>(p, U, D, si, g, col8, rs); else pool_fast<16>(p, U, D, si, g, col8, rs);
            continue;
        }
        const int c = g * 512 + col8 * 8; const int p0 = si.lc * 64 + rs * 8;
        float s[8], cur[8], old[8];
#pragma unroll
        for (int j = 0; j < 8; ++j) s[j] = 0.f;
        for (int q = p0 - w + 1; q < p0; ++q) { pool_fetch(U, p.state_pool, si, q, c, cur);
#pragma unroll
            for (int j = 0; j < 8; ++j) s[j] += cur[j]; }
#pragma unroll 1
        for (int i = 0; i < 8; ++i) { const int pos = p0 + i;
            pool_fetch(U, p.state_pool, si, pos, c, cur);
            if (i > 0) { pool_fetch(U, p.state_pool, si, pos - w, c, old);
#pragma unroll
                for (int j = 0; j < 8; ++j) s[j] -= old[j]; }
#pragma unroll
            for (int j = 0; j < 8; ++j) s[j] += cur[j];
            const float inv = 1.0f / (float)w;
            float d[8];
#pragma unroll
            for (int j = 0; j < 8; ++j) d[j] = s[j] * inv - cur[j];
            *(u32x4*)(D + (size_t)(si.seq_t0 + pos) * 2048 + c) = pack8(d);
            const int rl = rs * 8 + i;
            if (rl >= 49) { float* op = p.out + O_POOL_S + ((size_t)(si.sq - 16) * 15 + (rl - 49)) * 2048 + c;
                *(f32x4*)op = (f32x4){cur[0], cur[1], cur[2], cur[3]}; *(f32x4*)(op + 4) = (f32x4){cur[4], cur[5], cur[6], cur[7]}; }
        }
    }
}

__device__ void phase_conv(const Params& p) {
    bf16_t* QKV = (bf16_t*)(p.ws + WS_R1); const bf16_t* STASH = (const bf16_t*)(p.ws + WS_STASH); const float* AB = (const float*)(p.ws + WS_AB);
    float* GC = (float*)(p.ws + WS_GC); float* BETA = (float*)(p.ws + WS_BETA);
    const int tid = threadIdx.x, stream = tid >> 7, ct = tid & 127, lane = tid & 63, wid = tid >> 6;
    for (int it = blockIdx.x; it < NCHUNK * 4; it += gridDim.x) {
        const int chunk = it >> 2, qt = it & 3; const SeqInfo si = chunk_info(chunk); const int t0 = chunk * 64;
        const int ch = qt * 1024 + ct * 8; const int r0 = stream * 16;
        float wv[4][8];
#pragma unroll
        for (int t = 0; t < 4; ++t) { const f32x4 a = *(const f32x4*)(p.gdn_conv_w + t * 4096 + ch), b = *(const f32x4*)(p.gdn_conv_w + t * 4096 + ch + 4);
            wv[t][0] = a[0]; wv[t][1] = a[1]; wv[t][2] = a[2]; wv[t][3] = a[3]; wv[t][4] = b[0]; wv[t][5] = b[1]; wv[t][6] = b[2]; wv[t][7] = b[3]; }
        float h0[8], h1[8], h2[8];
        if (stream > 0) { unpack8(*(const u32x4*)(QKV + (size_t)(t0 + r0 - 3) * 4096 + ch), h0); unpack8(*(const u32x4*)(QKV + (size_t)(t0 + r0 - 2) * 4096 + ch), h1); unpack8(*(const u32x4*)(QKV + (size_t)(t0 + r0 - 1) * 4096 + ch), h2); }
        else if (si.lc > 0) { const bf16_t* sp = STASH + (size_t)(chunk - 1) * 3 * 4096 + ch; unpack8(*(const u32x4*)sp, h0); unpack8(*(const u32x4*)(sp + 4096), h1); unpack8(*(const u32x4*)(sp + 8192), h2); }
        else if (si.sample) { const float* sp = p.state_conv + (size_t)(si.sq - 16) * 3 * 4096 + ch;
#pragma unroll
            for (int j = 0; j < 8; ++j) { h0[j] = sp[j]; h1[j] = sp[4096 + j]; h2[j] = sp[8192 + j]; } }
        else {
#pragma unroll
            for (int j = 0; j < 8; ++j) { h0[j] = 0.f; h1[j] = 0.f; h2[j] = 0.f; } }
        u32x4 xr[16];
#pragma unroll
        for (int i = 0; i < 16; ++i) xr[i] = *(const u32x4*)(QKV + (size_t)(t0 + r0 + i) * 4096 + ch);
        __syncthreads();
#pragma unroll
        for (int i = 0; i < 16; ++i) {
            bf16_t* rp = QKV + (size_t)(t0 + r0 + i) * 4096 + ch; float x[8], o[8]; unpack8(xr[i], x);
            float ss = 0.f;
#pragma unroll
            for (int j = 0; j < 8; ++j) { const float cv = wv[0][j] * h0[j] + wv[1][j] * h1[j] + wv[2][j] * h2[j] + wv[3][j] * x[j]; o[j] = silu_f(cv); ss += o[j] * o[j]; h0[j] = h1[j]; h1[j] = h2[j]; h2[j] = x[j]; }
            if (qt < 2) { ss = dpp_sum16(ss);
                const float sc = rsqrtf(ss + EPS) * (qt == 0 ? 0.08838834764831845f : 1.0f);
#pragma unroll
                for (int j = 0; j < 8; ++j) o[j] *= sc; }
            *(u32x4*)rp = pack8(o);
            if (si.last && stream == 3 && i >= 13) { float* op = p.out + (si.sample ? O_CONV_S + ((size_t)(si.sq - 16) * 3 + (i - 13)) * 4096 : O_CONV_P + ((size_t)si.sq * 3 + (i - 13)) * 4096) + ch;
                *(f32x4*)op = (f32x4){x[0], x[1], x[2], x[3]}; *(f32x4*)(op + 4) = (f32x4){x[4], x[5], x[6], x[7]}; }
        }
        if (qt == 0) {
#pragma unroll
            for (int hh = 0; hh < 2; ++hh) { const int h = wid * 2 + hh; const float a = AB[(size_t)(t0 + lane) * 32 + h], b = AB[(size_t)(t0 + lane) * 32 + 16 + h];
                const float xx = a + p.gdn_dt_bias[h]; const float sp = xx > 20.f ? xx : log1pf(expf(xx)); float g = -expf(p.gdn_a_log[h]) * sp;
#pragma unroll
                for (int o = 1; o < 64; o <<= 1) { const float t = __shfl_up(g, o); if (lane >= o) g += t; }
                GC[((size_t)chunk * 16 + h) * 64 + lane] = g; BETA[((size_t)chunk * 16 + h) * 64 + lane] = 1.0f / (1.0f + expf(-b)); }
        }
    }
}

__device__ void phase_j1(const Params& p, unsigned char* lds_g) {
    const bf16_t* QKV = (const bf16_t*)(p.ws + WS_R1); const float* GC = (const float*)(p.ws + WS_GC); const float* BETA = (const float*)(p.ws + WS_BETA);
    bf16_t* AH = (bf16_t*)(p.out + O_Y); bf16_t* AQK = AH + (size_t)NCHUNK * 16 * 4096;
    const int lane = threadIdx.x & 63, wid = threadIdx.x >> 6, c = lane & 15, q4 = lane >> 4;
    float* Lw = (float*)(lds_g + wid * 17408);
    for (int wi = blockIdx.x * 8 + wid; wi < NCHUNK * 16; wi += gridDim.x * 8) {
        const int chunk = wi >> 4, h = wi & 15, hk = h >> 1; const size_t t0 = (size_t)chunk * 64;
        const bf16_t* kb = QKV + t0 * 4096 + 1024 + hk * 128; const bf16_t* qb = QKV + t0 * 4096 + hk * 128;
        const float* gcp = GC + (size_t)wi * 64; const float* btp = BETA + (size_t)wi * 64;
        bf16x8 kf[4][4];
#pragma unroll
        for (int mt = 0; mt < 4; ++mt)
#pragma unroll
            for (int ks = 0; ks < 4; ++ks) kf[mt][ks] = *(const bf16x8*)(kb + (size_t)(16 * mt + c) * 4096 + 32 * ks + 8 * q4);
        float gcc[4];
#pragma unroll
        for (int nt = 0; nt < 4; ++nt) gcc[nt] = gcp[16 * nt + c];
#pragma unroll
        for (int mt = 0; mt < 4; ++mt) {
            bf16x8 qf[4];
#pragma unroll
            for (int ks = 0; ks < 4; ++ks) qf[ks] = *(const bf16x8*)(qb + (size_t)(16 * mt + c) * 4096 + 32 * ks + 8 * q4);
            const f32x4 gcr = *(const f32x4*)(gcp + 16 * mt + 4 * q4), btr = *(const f32x4*)(btp + 16 * mt + 4 * q4);
#pragma unroll
            for (int nt = 0; nt < 4; ++nt) {
                bf16_t* aq = AQK + ((size_t)wi * 64 + 16 * mt + 4 * q4) * 64 + 16 * nt + c;
                if (nt <= mt) {
                    f32x4 kk = (f32x4){0.f, 0.f, 0.f, 0.f}, qk = (f32x4){0.f, 0.f, 0.f, 0.f};
#pragma unroll
                    for (int ks = 0; ks < 4; ++ks) { kk = __builtin_amdgcn_mfma_f32_16x16x32_bf16(kf[mt][ks], kf[nt][ks], kk, 0, 0, 0); qk = __builtin_amdgcn_mfma_f32_16x16x32_bf16(qf[ks], kf[nt][ks], qk, 0, 0, 0); }
#pragma unroll
                    for (int e = 0; e < 4; ++e) { const int i = 16 * mt + 4 * q4 + e, j = 16 * nt + c; const float dec = __expf(fminf(gcr[e] - gcc[nt], 0.f));
                        Lw[i * 68 + j] = (i > j) ? btr[e] * kk[e] * dec : 0.f;
                        const float a = (i >= j) ? qk[e] * dec : 0.f; aq[e * 64] = (bf16_t)(cvt_pk_bf16(a, 0.f) & 0xffffu); }
                } else {
#pragma unroll
                    for (int e = 0; e < 4; ++e) aq[e * 64] = (bf16_t)0;
                }
            }
        }
        __builtin_amdgcn_fence(__ATOMIC_RELEASE, "wavefront"); __builtin_amdgcn_wave_barrier();
        float t[64];
#pragma unroll
        for (int i = 0; i < 64; ++i) {
            float s0 = (lane == i) ? 1.f : 0.f, s1 = 0.f, s2 = 0.f, s3 = 0.f;
#pragma unroll
            for (int j4 = 0; j4 < i; j4 += 4) { const f32x4 l = *(const f32x4*)(Lw + i * 68 + j4);
                s0 -= l[0] * t[j4]; if (j4 + 1 < i) s1 -= l[1] * t[j4 + 1]; if (j4 + 2 < i) s2 -= l[2] * t[j4 + 2]; if (j4 + 3 < i) s3 -= l[3] * t[j4 + 3]; }
            t[i] = (s0 + s1) + (s2 + s3);
        }
        const float bc = btp[lane];
        bf16_t* ah = AH + (size_t)wi * 4096 + lane;
#pragma unroll
        for (int i = 0; i < 64; ++i) ah[i * 64] = (bf16_t)(cvt_pk_bf16(t[i] * bc, 0.f) & 0xffffu);
        __builtin_amdgcn_wave_barrier();
    }
}

__device__ __forceinline__ bf16x8 pack_acc2(const f32x4 a, const f32x4 b) { u32x4 w; w.x = cvt_pk_bf16(a[0], a[1]); w.y = cvt_pk_bf16(a[2], a[3]); w.z = cvt_pk_bf16(b[0], b[1]); w.w = cvt_pk_bf16(b[2], b[3]); return __builtin_bit_cast(bf16x8, w); }
__device__ __forceinline__ bf16x8 ld_perm(const bf16_t* ptr) { const u32x2 a = *(const u32x2*)ptr, b = *(const u32x2*)(ptr + 16); u32x4 w; w.x = a.x; w.y = a.y; w.z = b.x; w.w = b.y; return __builtin_bit_cast(bf16x8, w); }
#define LDS_BARRIER() do { asm volatile("s_waitcnt lgkmcnt(0)" ::: "memory"); __builtin_amdgcn_s_barrier(); asm volatile("" ::: "memory"); } while (0)
__device__ void phase_j2(const Params& p, unsigned char* lds_g, bool dry) {
    bf16_t* QKV = (bf16_t*)(p.ws + WS_R1); const float* GC = (const float*)(p.ws + WS_GC);
    const bf16_t* AH = (const bf16_t*)(p.out + O_Y); const bf16_t* AQK = AH + (size_t)NCHUNK * 16 * 4096;
    const int tid = threadIdx.x, lane = tid & 63, w = tid >> 6, c = lane & 15, q4 = lane >> 4;
    constexpr int KN_OFF = 0, QN_OFF = 17408, KT_OFF = 34816, VT_OFF = 53248, AH_OFF = 71680, AQ_OFF = 80896, OS_OFF = 90112, SSQ_OFF = 107520;
    LAS unsigned char* L = (LAS unsigned char*)lds_g;
    LAS bf16_t* KT = (LAS bf16_t*)(L + KT_OFF); LAS bf16_t* VT = (LAS bf16_t*)(L + VT_OFF); LAS bf16_t* OS = (LAS bf16_t*)(L + OS_OFF);
    LAS float* SSQ = (LAS float*)(L + SSQ_OFF);
    const float nw = p.gdn_norm_w[16 * w + c];
    const int rowl = tid & 63, seg = tid >> 6;
    int par = 0;
    if (tid < 128) ((LAS float*)(L + 111616 + 1024))[tid] = 0.f;
    u32x4 rk0, rk1, rq0, rq1, rv0, rv1, ra, rqk; float ngate, ngl;
    LAS float* GEX = (LAS float*)(L + 111616);
    LAS float* SSQT = (LAS float*)(L + 111616 + 1024);
#define J2_LOAD(chunk_) do { const size_t t0_ = (size_t)(chunk_) * 64; const size_t ci_ = (size_t)(chunk_) * 16 + h; \
        const bf16_t* kb_ = QKV + (t0_ + rowl) * 4096 + 1024 + hk * 128 + seg * 16; const bf16_t* qb_ = QKV + (t0_ + rowl) * 4096 + hk * 128 + seg * 16; const bf16_t* vb_ = QKV + (t0_ + rowl) * 4096 + 2048 + h * 128 + seg * 16; \
        rk0 = *(const u32x4*)kb_; rk1 = *(const u32x4*)(kb_ + 8); rq0 = *(const u32x4*)qb_; rq1 = *(const u32x4*)(qb_ + 8); rv0 = *(const u32x4*)vb_; rv1 = *(const u32x4*)(vb_ + 8); \
        ra = *(const u32x4*)(AH + ci_ * 4096 + tid * 8); rqk = *(const u32x4*)(AQK + ci_ * 4096 + tid * 8); \
        ngate = GC[ci_ * 64 + rowl]; ngl = GC[ci_ * 64 + 63]; } while (0)
#define J2_STORE() do { *(LAS u32x4*)(L + KN_OFF + rowl * 272 + seg * 32) = rk0; *(LAS u32x4*)(L + KN_OFF + rowl * 272 + seg * 32 + 16) = rk1; \
        *(LAS u32x4*)(L + QN_OFF + rowl * 272 + seg * 32) = rq0; *(LAS u32x4*)(L + QN_OFF + rowl * 272 + seg * 32 + 16) = rq1; \
        { const unsigned kw_[8] = {rk0.x, rk0.y, rk0.z, rk0.w, rk1.x, rk1.y, rk1.z, rk1.w}; const unsigned vw_[8] = {rv0.x, rv0.y, rv0.z, rv0.w, rv1.x, rv1.y, rv1.z, rv1.w}; \
          _Pragma("unroll") for (int j_ = 0; j_ < 8; ++j_) { KT[(seg * 16 + 2 * j_) * 72 + rowl] = (bf16_t)(kw_[j_] & 0xffffu); KT[(seg * 16 + 2 * j_ + 1) * 72 + rowl] = (bf16_t)(kw_[j_] >> 16); \
              VT[(seg * 16 + 2 * j_) * 72 + rowl] = (bf16_t)(vw_[j_] & 0xffffu); VT[(seg * 16 + 2 * j_ + 1) * 72 + rowl] = (bf16_t)(vw_[j_] >> 16); } } \
        *(LAS u32x4*)(L + AH_OFF + (tid >> 3) * 144 + (tid & 7) * 16) = ra; *(LAS u32x4*)(L + AQ_OFF + (tid >> 3) * 144 + (tid & 7) * 16) = rqk; if (tid < 64) { GEX[tid] = __expf(ngate); GEX[64 + tid] = __expf(ngl - ngate); if (tid == 63) GEX[128] = __expf(ngl); } } while (0)
#define J2_FRAG(off_) ({ const u32x2 a_ = *(const LAS u32x2*)(L + (off_)); const u32x2 b_ = *(const LAS u32x2*)(L + (off_) + 32); u32x4 w_; w_.x = a_.x; w_.y = a_.y; w_.z = b_.x; w_.w = b_.y; __builtin_bit_cast(bf16x8, w_); })
    for (int item = blockIdx.x; item < 768; item += gridDim.x) {
        int chunk0, nch, h; const float* s0 = nullptr; float* sout;
        if (item < 256) { const int b = item >> 4; h = item & 15; chunk0 = b * 64; nch = 64; sout = p.out + O_REC_P + ((size_t)b * 16 + h) * 16384; }
        else { const int b = (item - 256) >> 4; h = item & 15; chunk0 = 1024 + b; nch = 1; s0 = p.state_rec + ((size_t)b * 16 + h) * 16384; sout = p.out + O_REC_S + ((size_t)b * 16 + h) * 16384; }
        const int hk = h >> 1;
        f32x4 S[8];
        { int loff = (4 * q4) * 128 + 16 * w + c; asm volatile("" : "+v"(loff));
#pragma unroll
        for (int mt = 0; mt < 8; ++mt) {
            if (s0) {
#pragma unroll
                for (int e = 0; e < 4; ++e) S[mt][e] = s0[loff + (16 * mt + e) * 128]; }
            else S[mt] = (f32x4){0.f, 0.f, 0.f, 0.f};
        } }
        J2_LOAD(chunk0);
        LDS_BARRIER();
        J2_STORE();
        LDS_BARRIER();
        for (int n = 0; n < nch; ++n, par ^= 1) {
            const int chunk = chunk0 + n; const size_t t0 = (size_t)chunk * 64; const size_t ci = (size_t)chunk * 16 + h;
            const float egl = GEX[128];
            if (n + 1 < nch) J2_LOAD(chunk + 1);
            LAS float* ssq = SSQT + par * 64;
            bf16x8 Sb[4];
#pragma unroll
            for (int ks = 0; ks < 4; ++ks) Sb[ks] = pack_acc2(S[2 * ks], S[2 * ks + 1]);
#define J2_SB() __builtin_amdgcn_sched_barrier(0)
#define J2_LDKQ(dstk, dstq, mt_) do { _Pragma("unroll") for (int ks_ = 0; ks_ < 4; ++ks_) { const int o_ = (16 * (mt_) + c) * 272 + (32 * ks_ + 4 * q4) * 2; dstk[ks_] = J2_FRAG(KN_OFF + o_); dstq[ks_] = J2_FRAG(QN_OFF + o_); } } while (0)
#define J2_MMKQ(srck, srcq, mt_) do { _Pragma("unroll") for (int ks_ = 0; ks_ < 4; ++ks_) { P[mt_] = __builtin_amdgcn_mfma_f32_16x16x32_bf16(srck[ks_], Sb[ks_], P[mt_], 0, 0, 0); QS[mt_] = __builtin_amdgcn_mfma_f32_16x16x32_bf16(srcq[ks_], Sb[ks_], QS[mt_], 0, 0, 0); } } while (0)
            f32x4 P[4], QS[4];
#pragma unroll
            for (int mt = 0; mt < 4; ++mt) { P[mt] = (f32x4){0.f, 0.f, 0.f, 0.f}; QS[mt] = (f32x4){0.f, 0.f, 0.f, 0.f}; }
            bf16x8 ka[4], qa[4], kb2[4], qb2[4]; u32x2 vv[4];
            J2_LDKQ(ka, qa, 0); J2_LDKQ(kb2, qb2, 1);
            J2_SB(); J2_MMKQ(ka, qa, 0); J2_LDKQ(ka, qa, 2);
            J2_SB(); J2_MMKQ(kb2, qb2, 1); J2_LDKQ(kb2, qb2, 3);
            J2_SB(); J2_MMKQ(ka, qa, 2);
            bf16x8 ahf[4][2], aqf[4][2];
#pragma unroll
            for (int mt = 0; mt < 4; ++mt)
#pragma unroll
                for (int k2 = 0; k2 < 2; ++k2) ahf[mt][k2] = J2_FRAG(AH_OFF + (16 * mt + c) * 144 + (32 * k2 + 4 * q4) * 2);
            f32x4 egc[4];
#pragma unroll
            for (int mt = 0; mt < 4; ++mt) { egc[mt] = *(const LAS f32x4*)(GEX + 16 * mt + 4 * q4);
                vv[mt] = *(const LAS u32x2*)(L + VT_OFF + (16 * w + c) * 144 + (16 * mt + 4 * q4) * 2); }
            J2_SB(); J2_MMKQ(kb2, qb2, 3);
            J2_SB();
            f32x4 edl[4];
#pragma unroll
            for (int mt = 0; mt < 4; ++mt) edl[mt] = *(const LAS f32x4*)(GEX + 64 + 16 * mt + 4 * q4);
            f32x4 R[4];
#pragma unroll
            for (int mt = 0; mt < 4; ++mt) { R[mt][0] = bf_lo(vv[mt].x) - egc[mt][0] * P[mt][0]; R[mt][1] = bf_hi(vv[mt].x) - egc[mt][1] * P[mt][1]; R[mt][2] = bf_lo(vv[mt].y) - egc[mt][2] * P[mt][2]; R[mt][3] = bf_hi(vv[mt].y) - egc[mt][3] * P[mt][3]; }
            bf16x8 Rb[2];
#pragma unroll
            for (int k2 = 0; k2 < 2; ++k2) Rb[k2] = pack_acc2(R[2 * k2], R[2 * k2 + 1]);
            J2_SB();
            f32x4 Vn[4];
#pragma unroll
            for (int mt = 0; mt < 4; ++mt) { Vn[mt] = (f32x4){0.f, 0.f, 0.f, 0.f};
#pragma unroll
                for (int k2 = 0; k2 < 2; ++k2) Vn[mt] = __builtin_amdgcn_mfma_f32_16x16x32_bf16(ahf[mt][k2], Rb[k2], Vn[mt], 0, 0, 0); }
            J2_SB();
#pragma unroll
            for (int mt = 0; mt < 4; ++mt)
#pragma unroll
                for (int k2 = 0; k2 < 2; ++k2) aqf[mt][k2] = J2_FRAG(AQ_OFF + (16 * mt + c) * 144 + (32 * k2 + 4 * q4) * 2);
            bf16x8 ktf[4][2];
#pragma unroll
            for (int mt = 0; mt < 4; ++mt)
#pragma unroll
                for (int k2 = 0; k2 < 2; ++k2) ktf[mt][k2] = J2_FRAG(KT_OFF + (16 * mt + c) * 144 + (32 * k2 + 4 * q4) * 2);
            bf16x8 Vb[2], Vsb[2];
#pragma unroll
            for (int k2 = 0; k2 < 2; ++k2) { Vb[k2] = pack_acc2(Vn[2 * k2], Vn[2 * k2 + 1]); Vsb[k2] = pack_acc2(Vn[2 * k2] * edl[2 * k2], Vn[2 * k2 + 1] * edl[2 * k2 + 1]); }
            J2_SB();
            f32x4 O[4];
#pragma unroll
            for (int mt = 0; mt < 4; ++mt) { O[mt] = QS[mt] * egc[mt];
#pragma unroll
                for (int k2 = 0; k2 < 2; ++k2) O[mt] = __builtin_amdgcn_mfma_f32_16x16x32_bf16(aqf[mt][k2], Vb[k2], O[mt], 0, 0, 0); }
            J2_SB();
#pragma unroll
            for (int mt = 0; mt < 4; ++mt) { S[mt] = S[mt] * egl;
#pragma unroll
                for (int k2 = 0; k2 < 2; ++k2) S[mt] = __builtin_amdgcn_mfma_f32_16x16x32_bf16(ktf[mt][k2], Vsb[k2], S[mt], 0, 0, 0); }
            J2_SB();
#pragma unroll
            for (int mt = 0; mt < 4; ++mt)
#pragma unroll
                for (int k2 = 0; k2 < 2; ++k2) ktf[mt][k2] = J2_FRAG(KT_OFF + (16 * (mt + 4) + c) * 144 + (32 * k2 + 4 * q4) * 2);
#pragma unroll
            for (int mt = 0; mt < 4; ++mt) { f32x4 sq = O[mt] * O[mt]; sq[0] = dpp_sum16(sq[0]); sq[1] = dpp_sum16(sq[1]); sq[2] = dpp_sum16(sq[2]); sq[3] = dpp_sum16(sq[3]);
                if (c == 0) {
#pragma unroll
                    for (int e = 0; e < 4; ++e) __hip_atomic_fetch_add(ssq + 16 * mt + 4 * q4 + e, sq[e], __ATOMIC_RELAXED, __HIP_MEMORY_SCOPE_WORKGROUP); } }
            J2_SB();
#pragma unroll
            for (int mt = 0; mt < 4; ++mt) { S[mt + 4] = S[mt + 4] * egl;
#pragma unroll
                for (int k2 = 0; k2 < 2; ++k2) S[mt + 4] = __builtin_amdgcn_mfma_f32_16x16x32_bf16(ktf[mt][k2], Vsb[k2], S[mt + 4], 0, 0, 0); }
#undef J2_SB
#undef J2_LDKQ
#undef J2_MMKQ
            LDS_BARRIER();
#pragma unroll
            for (int mt = 0; mt < 4; ++mt) { const f32x4 tot = *(const LAS f32x4*)(ssq + 16 * mt + 4 * q4);
#pragma unroll
                for (int e = 0; e < 4; ++e) { const float r = rsqrtf(tot[e] * (1.0f / 128.0f) + EPS); OS[(16 * mt + 4 * q4 + e) * 136 + 16 * w + c] = (bf16_t)(cvt_pk_bf16(O[mt][e] * r * nw, 0.f) & 0xffffu); } }
            LDS_BARRIER();
            { const int row = tid >> 3, s8 = tid & 7; const u32x4 o0 = *(const LAS u32x4*)(L + OS_OFF + row * 272 + s8 * 32), o1 = *(const LAS u32x4*)(L + OS_OFF + row * 272 + s8 * 32 + 16);
              bf16_t* op = QKV + (t0 + row) * 4096 + 2048 + h * 128 + s8 * 16; if (!dry) { *(u32x4*)op = o0; *(u32x4*)(op + 8) = o1; } }
            if (n + 1 < nch) J2_STORE();
            if (tid < 64) SSQT[(par ^ 1) * 64 + tid] = 0.f;
            LDS_BARRIER();
        }
        { int loff = (4 * q4) * 128 + 16 * w + c; asm volatile("" : "+v"(loff));
#pragma unroll
        for (int mt = 0; mt < 8; ++mt)
#pragma unroll
            for (int e = 0; e < 4; ++e) if (!dry) sout[loff + (16 * mt + e) * 128] = S[mt][e]; }
    }
#undef J2_LOAD
#undef J2_STORE
#undef J2_FRAG
}


#define XB_TMO      128
#define XB_XCNT(j)  (256  + 64 * (j))
#define XB_XSUB(j)  (1280 + 64 * (j))
#define XB_XGEN(j)  (2304 + 64 * (j))
#define XB_TOP      3328
#define XB_TOPGEN   3392
#define XCD_BAR_WORDS 3456
#define XB_SPIN_CAP (1u << 18)
__device__ __forceinline__ unsigned xb_ld(unsigned* p)              { return __hip_atomic_load(p, __ATOMIC_RELAXED, __HIP_MEMORY_SCOPE_AGENT); }
__device__ __forceinline__ unsigned xb_add(unsigned* p, unsigned v) { return __hip_atomic_fetch_add(p, v, __ATOMIC_RELAXED, __HIP_MEMORY_SCOPE_AGENT); }
__device__ __forceinline__ unsigned xb_xcc_id() { return (unsigned)__builtin_amdgcn_s_getreg((3 << 11) | 20) & 0xFu; }
#define XB_SPIN(cond, bar) do { unsigned _sp = 0; while (cond) { __builtin_amdgcn_s_sleep(1); \
    if ((++_sp & 255u) == 0u) { if (xb_ld(&(bar)[XB_TMO])) break; if (_sp > XB_SPIN_CAP) { atomicAdd(&(bar)[XB_TMO], 1u); break; } } } } while (0)
struct XcdBarrier { unsigned* bar; unsigned x; volatile LAS unsigned* st; };
__device__ __forceinline__ XcdBarrier xcd_barrier_post(unsigned* bar, volatile LAS unsigned* st) {
    XcdBarrier b; b.bar = bar; b.x = xb_xcc_id(); b.st = st;
    if (threadIdx.x == 0) (void)xb_add(&bar[XB_XCNT(b.x)], 1u);
    return b;
}
__device__ __forceinline__ void xcd_barrier_complete(unsigned* bar, unsigned x, unsigned& nloc, unsigned& nx) {
    const unsigned G = gridDim.x * gridDim.y * gridDim.z;
    unsigned sum, cnt, mine, sp = 0u;
    for (;;) {
        sum = 0u; cnt = 0u; mine = 0u;
#pragma unroll
        for (unsigned j = 0; j < 16; ++j) { const unsigned c = xb_ld(&bar[XB_XCNT(j)]); sum += c; cnt += (c > 0u) ? 1u : 0u; mine = (j == x) ? c : mine; }
        if (sum == G) break;
        __builtin_amdgcn_s_sleep(1);
        if ((++sp & 255u) == 0u) { if (xb_ld(&bar[XB_TMO])) break; if (sp > XB_SPIN_CAP) { atomicAdd(&bar[XB_TMO], 1u); break; } }
    }
    nloc = mine > 0u ? mine : 1u; nx = cnt > 0u ? cnt : 1u;
}
__device__ __forceinline__ void xcd_barrier(const XcdBarrier& b) {
    asm volatile("s_waitcnt vmcnt(0)" ::: "memory");
    __syncthreads();
    if (threadIdx.x == 0) {
        unsigned* bar = b.bar;
        __builtin_amdgcn_s_waitcnt(0);
        unsigned nloc = b.st[0], nx = b.st[1];
        if (nloc == 0u) { xcd_barrier_complete(bar, b.x, nloc, nx); b.st[0] = nloc; b.st[1] = nx; }
        const unsigned old = xb_add(&bar[XB_XSUB(b.x)], 1u);
        const unsigned gen = old / nloc;
        if (old + 1u == (gen + 1u) * nloc) {
            __builtin_amdgcn_fence(__ATOMIC_RELEASE, "agent");
            asm volatile("s_waitcnt vmcnt(0)" ::: "memory");
            const unsigned og = xb_add(&bar[XB_TOP], 1u);
            const unsigned tg = og / nx;
            if (og + 1u == (tg + 1u) * nx) xb_add(&bar[XB_TOPGEN], 1u);
            else XB_SPIN(xb_ld(&bar[XB_TOPGEN]) == tg, bar);
            __builtin_amdgcn_fence(__ATOMIC_ACQUIRE, "agent");
            xb_add(&bar[XB_XGEN(b.x)], 1u);
            asm volatile("s_waitcnt vmcnt(0)" ::: "memory");
        } else {
            XB_SPIN(xb_ld(&bar[XB_XGEN(b.x)]) == gen, bar);
            __builtin_amdgcn_fence(__ATOMIC_ACQUIRE, "agent");
            asm volatile("s_waitcnt vmcnt(0)" ::: "memory");
        }
    }
    __syncthreads();
}

constexpr int N_PHASES = 14;
#ifndef PH_MASK
#define PH_MASK 0x3fff
#endif
#define PH_ON(n) (((PH_MASK) >> (n)) & 1)
#ifndef REP_MASK
#define REP_MASK 0
#endif
#define REP_ON(n) (((REP_MASK) >> (n)) & 1)
__global__ void __launch_bounds__(NT, 2) mega(Params p, int ph_lo, int ph_hi, int rep_mask) {
    extern __shared__ __attribute__((aligned(16))) unsigned char lds[];
    LAS unsigned char* ldsl = (LAS unsigned char*)lds;
    cg::grid_group grid = cg::this_grid();
    unsigned char* ws = p.ws;
    bf16_t* W1t = (bf16_t*)(ws + WS_W1T); bf16_t* Wgt = (bf16_t*)(ws + WS_WGT); bf16_t* W2t = (bf16_t*)(ws + WS_W2T); bf16_t* W3t = (bf16_t*)(ws + WS_W3T); bf16_t* W4t = (bf16_t*)(ws + WS_W4T);
    float* mod = (float*)(ws + WS_MOD); bf16_t* H = (bf16_t*)(ws + WS_H); bf16_t* R1 = (bf16_t*)(ws + WS_R1); bf16_t* R2 = (bf16_t*)(ws + WS_R2); bf16_t* R3 = (bf16_t*)(ws + WS_R3);
    bf16_t* X1b = (bf16_t*)(ws + WS_R3);
    const int G = gridDim.x, bid = blockIdx.x;
    volatile LAS unsigned* xst = (volatile LAS unsigned*)(ldsl + LDS_BYTES - 16);
    if (threadIdx.x == 0) { xst[0] = 0u; xst[1] = 0u; }
    __syncthreads();
    const XcdBarrier xb = xcd_barrier_post((unsigned*)(ws + WS_BAR), xst);
#define IN(k) (ph_lo <= (k) && (k) < ph_hi)
#define SEAM(k) do { if (IN(k) && IN((k) + 1)) { if (ph_lo < 0) grid.sync(); else xcd_barrier(xb); } } while (0)
    if (PH_ON(0) && IN(0)) { phase_prep(p, lds); }
    SEAM(0);
    if (PH_ON(1) && IN(1)) { phase_norm_mod(p.x_prompt, p.x_sample, p.norm_gain, mod, H); }
    SEAM(1);
    if (PH_ON(2) && IN(2)) { { pg8::Gemm g{H, W1t, T, 4096, 1024, 1024, 1024, 0, 0}; pg8::StaticOrder S; S.init(T, 4096, G, bid); pg8::EpiL0In E{R1, R2}; pg8::gemm_phase(ldsl, g, S, E); } }
    SEAM(2);
    if (PH_ON(3) && IN(3)) { phase_pool(p); }
    SEAM(3);
    if (PH_ON(4) && IN(4)) { { pg8::Gemm g{R3, Wgt, T, 2048, 512, 2048, 512, 2, 1024}; pg8::StaticOrder S; S.init(T, 2048, G, bid); pg8::EpiGrp E{R1, R2, p.pool_scale}; pg8::gemm_phase(ldsl, g, S, E); } }
    SEAM(4);
    if (PH_ON(5) && IN(5)) { { pg8::Gemm g{R1, W2t, T, 1024, 2048, 2048, 2048, 0, 0}; pg8::StaticOrder S; S.init(T, 1024, G, bid); pg8::EpiRes<false> E{p.x_prompt, p.x_sample, nullptr, X1b, mod + 2048}; pg8::gemm_phase(ldsl, g, S, E); } }
    SEAM(5);
    if (PH_ON(6) && IN(6)) { phase_norm_b<0>(X1b, p.norm_gain + 1024, mod + 48 * 3072, H, nullptr); }
    SEAM(6);
    if (PH_ON(7) && IN(7)) { { pg8::Gemm g{H, W3t, T, 4352, 1024, 1024, 1024, 0, 0}; pg8::StaticOrder S; S.init(T, 4352, G, bid); pg8::EpiL1In E{R1, (bf16_t*)(ws + WS_STASH), (float*)(ws + WS_AB)}; pg8::gemm_phase(ldsl, g, S, E); } }
    SEAM(7);
    if (PH_ON(8) && IN(8)) { phase_conv(p); }
    SEAM(8);
    if (PH_ON(9) && IN(9)) { phase_j1(p, lds); }
    SEAM(9);
    if (PH_ON(10) && IN(10)) { phase_j2(p, lds, false); }
    SEAM(10);
    if (PH_ON(11) && IN(11)) { { pg8::Gemm g{H, W3t + (size_t)4352 * 1024, T, 2048, 1024, 1024, 1024, 0, 0}; pg8::StaticOrder S; S.init(T, 2048, G, bid); pg8::EpiZ E{R1}; pg8::gemm_phase(ldsl, g, S, E); } }
    SEAM(11);
    if (PH_ON(12) && IN(12)) { { pg8::Gemm g{R1 + 2048, W4t, T, 1024, 2048, 4096, 2048, 0, 0}; pg8::StaticOrder S; S.init(T, 1024, G, bid); pg8::EpiRes<true> E{nullptr, nullptr, X1b, X1b, mod + 48 * 3072 + 2048}; pg8::gemm_phase(ldsl, g, S, E); } }
    SEAM(12);
    if (PH_ON(13) && IN(13)) { phase_norm_b<1>(X1b, p.final_gain, nullptr, nullptr, p.out + O_Y); }
    SEAM(13);
#undef IN
#undef SEAM
}

#ifndef MK_ONE_LAUNCH
#define MK_ONE_LAUNCH 1
#endif
extern "C" void kernel_launch(void* const* d_in, const int* in_sizes, int n_in, void* d_out, int out_size, void* d_ws, size_t ws_size, hipStream_t stream) {
    static int grid = 0;
    if (grid == 0) {
        if (ws_size < WS_END) { fprintf(stderr, "kernel_launch: workspace too small: %zu < %zu\n", ws_size, (size_t)WS_END); grid = -1; return; }
        int dev = 0, cus = 0, per_cu = 0;
        hipGetDevice(&dev); hipDeviceGetAttribute(&cus, hipDeviceAttributeMultiprocessorCount, dev);
        if (hipFuncSetAttribute((const void*)mega, hipFuncAttributeMaxDynamicSharedMemorySize, LDS_BYTES) != hipSuccess) { fprintf(stderr, "kernel_launch: hipFuncSetAttribute failed\n"); grid = -1; return; }
        if (hipOccupancyMaxActiveBlocksPerMultiprocessor(&per_cu, (const void*)mega, NT, LDS_BYTES) != hipSuccess || per_cu < 1) { fprintf(stderr, "kernel_launch: occupancy query gave %d\n", per_cu); per_cu = 1; }
        (void)hipGetLastError();
        grid = cus * per_cu;
    }
    if (grid < 0) return;
    Params p{};
    p.x_prompt = (const float*)d_in[0]; p.x_sample = (const float*)d_in[1]; p.c_prompt = (const float*)d_in[2]; p.c_sample = (const float*)d_in[3];
    p.state_pool = (const float*)d_in[4]; p.state_conv = (const float*)d_in[5]; p.state_rec = (const float*)d_in[6];
    p.norm_gain = (const float*)d_in[7]; p.ada_w = (const float*)d_in[8]; p.ada_b = (const float*)d_in[9];
    p.pool_w_in = (const float*)d_in[10]; p.pool_w_group = (const float*)d_in[11]; p.pool_scale = (const float*)d_in[12]; p.pool_w_out = (const float*)d_in[13];
    p.gdn_w_in = (const float*)d_in[14]; p.gdn_conv_w = (const float*)d_in[15]; p.gdn_a_log = (const float*)d_in[16]; p.gdn_dt_bias = (const float*)d_in[17]; p.gdn_norm_w = (const float*)d_in[18]; p.gdn_w_out = (const float*)d_in[19];
    p.final_gain = (const float*)d_in[20];
    p.out = (float*)d_out; p.ws = (unsigned char*)d_ws;
    if (hipMemsetAsync((unsigned char*)d_ws + WS_BAR, 0, 16384, stream) != hipSuccess) { fprintf(stderr, "kernel_launch: memset of barrier words failed\n"); return; }
#if MK_ONE_LAUNCH
    int lo = 0, hi = N_PHASES, rep = REP_MASK; void* args[] = {&p, &lo, &hi, &rep};
    hipError_t e = hipLaunchCooperativeKernel((const void*)mega, dim3(grid), dim3(NT), args, LDS_BYTES, stream);
    if (e != hipSuccess) fprintf(stderr, "cooperative launch failed: %s (grid %d)\n", hipGetErrorString(e), grid);
#else
    for (int ph = 0; ph < N_PHASES; ++ph) { hipLaunchKernelGGL(mega, dim3(grid), dim3(NT), LDS_BYTES, stream, p, ph, ph + 1, 0); }
#endif
}
```

```cpp
#include <hip/hip_runtime.h>
#include <hip/hip_cooperative_groups.h>
#include <cstdio>
namespace cg = cooperative_groups;

#define LAS __attribute__((address_space(3)))
typedef unsigned short bf16_t;
typedef short bf16x8 __attribute__((ext_vector_type(8)));
typedef short bf16x4 __attribute__((ext_vector_type(4)));
typedef float f32x4 __attribute__((ext_vector_type(4)));
typedef unsigned u32x4 __attribute__((ext_vector_type(4)));
typedef unsigned u32x2 __attribute__((ext_vector_type(2)));

constexpr int DM = 1024, TP = 65536, TS = 2048, T = TP + TS, NSEQ = 48, NCHUNK = T / 64;
constexpr int NT = 512, LDS_BYTES = 147456;
constexpr float EPS = 1e-6f;

constexpr size_t SZ_BIG = (size_t)T * 2048 * 2;
constexpr size_t WS_W1T = 0;
constexpr size_t WS_WGT = WS_W1T + (size_t)4096 * 1024 * 2;
constexpr size_t WS_W2T = WS_WGT + (size_t)2048 * 512 * 2;
constexpr size_t WS_W3T = WS_W2T + (size_t)1024 * 2048 * 2;
constexpr size_t WS_W4T = WS_W3T + (size_t)6400 * 1024 * 2;
constexpr size_t WS_MOD = WS_W4T + (size_t)1024 * 2048 * 2;
constexpr size_t WS_AB = WS_MOD + (size_t)2 * 48 * 3072 * 4;
constexpr size_t WS_GC = WS_AB + (size_t)T * 32 * 4;
constexpr size_t WS_BETA = WS_GC + (size_t)T * 16 * 4;
constexpr size_t WS_STASH = WS_BETA + (size_t)T * 16 * 4;
constexpr size_t WS_H = WS_STASH + (size_t)NCHUNK * 3 * 4096 * 2;
constexpr size_t WS_R1 = WS_H + (size_t)T * 1024 * 2;
constexpr size_t WS_R2 = WS_R1 + SZ_BIG;
constexpr size_t WS_R3 = WS_R2 + SZ_BIG;
constexpr size_t WS_BAR = WS_R3 + SZ_BIG;
constexpr size_t WS_END = WS_BAR + 16384;

constexpr size_t O_Y = 0;
constexpr size_t O_POOL_P = (size_t)T * 1024;
constexpr size_t O_CONV_P = O_POOL_P + (size_t)16 * 15 * 2048;
constexpr size_t O_REC_P = O_CONV_P + (size_t)16 * 3 * 4096;
constexpr size_t O_POOL_S = O_REC_P + (size_t)16 * 16 * 16384;
constexpr size_t O_CONV_S = O_POOL_S + (size_t)32 * 15 * 2048;
constexpr size_t O_REC_S = O_CONV_S + (size_t)32 * 3 * 4096;

struct Params {
    const float* x_prompt; const float* x_sample; const float* c_prompt; const float* c_sample;
    const float* state_pool; const float* state_conv; const float* state_rec;
    const float* norm_gain; const float* ada_w; const float* ada_b;
    const float* pool_w_in; const float* pool_w_group; const float* pool_scale; const float* pool_w_out;
    const float* gdn_w_in; const float* gdn_conv_w; const float* gdn_a_log; const float* gdn_dt_bias; const float* gdn_norm_w; const float* gdn_w_out;
    const float* final_gain;
    float* out; unsigned char* ws;
};

__device__ __forceinline__ unsigned cvt_pk_bf16(float lo, float hi) { unsigned r; asm("v_cvt_pk_bf16_f32 %0, %1, %2" : "=v"(r) : "v"(lo), "v"(hi)); return r; }
typedef __bf16 bf16x2_t __attribute__((ext_vector_type(2)));
__device__ __forceinline__ unsigned cvt_pk_bf16_c(float lo, float hi) { const bf16x2_t v = {(__bf16)lo, (__bf16)hi}; return __builtin_bit_cast(unsigned, v); }
__device__ __forceinline__ float bf_lo(unsigned w) { return __uint_as_float(w << 16); }
__device__ __forceinline__ float bf_hi(unsigned w) { return __uint_as_float(w & 0xffff0000u); }
__device__ __forceinline__ float silu_f(float x) { return x * __builtin_amdgcn_rcpf(1.0f + __expf(-x)); }
__device__ __forceinline__ void unpack8(const u32x4 w, float (&f)[8]) { f[0] = bf_lo(w.x); f[1] = bf_hi(w.x); f[2] = bf_lo(w.y); f[3] = bf_hi(w.y); f[4] = bf_lo(w.z); f[5] = bf_hi(w.z); f[6] = bf_lo(w.w); f[7] = bf_hi(w.w); }
__device__ __forceinline__ u32x4 pack8c(const float (&f)[8]) { u32x4 w; w.x = cvt_pk_bf16_c(f[0], f[1]); w.y = cvt_pk_bf16_c(f[2], f[3]); w.z = cvt_pk_bf16_c(f[4], f[5]); w.w = cvt_pk_bf16_c(f[6], f[7]); return w; }
__device__ __forceinline__ u32x4 pack8(const float (&f)[8]) { u32x4 w; w.x = cvt_pk_bf16(f[0], f[1]); w.y = cvt_pk_bf16(f[2], f[3]); w.z = cvt_pk_bf16(f[4], f[5]); w.w = cvt_pk_bf16(f[6], f[7]); return w; }
__device__ __forceinline__ int seq_of_row(int row) { return row < TP ? (row >> 12) : 16 + ((row - TP) >> 6); }

__device__ __forceinline__ float dpp_sum16(float v) {
    v += __int_as_float(__builtin_amdgcn_update_dpp(0, __float_as_int(v), 0xB1, 0xF, 0xF, true));
    v += __int_as_float(__builtin_amdgcn_update_dpp(0, __float_as_int(v), 0x4E, 0xF, 0xF, true));
    v += __int_as_float(__builtin_amdgcn_update_dpp(0, __float_as_int(v), 0x141, 0xF, 0xF, true));
    v += __int_as_float(__builtin_amdgcn_update_dpp(0, __float_as_int(v), 0x140, 0xF, 0xF, true));
    return v;
}
#ifndef STAGGER_US
#define STAGGER_US 0
#endif
namespace pg8 {
constexpr int BM = 256, BK = 64, HALF = 128, HTB = HALF * BK * 2, STAGE_BYTES = 8 * HTB, NXCD = 8, WGM = 8;
__device__ __forceinline__ int lds_byte(int r, int c) { const int st = (r >> 4) * 2 + (c >> 5), rr = r & 15, cc = c & 31, ob = rr * 64 + cc * 2; return st * 1024 + (ob ^ (((ob >> 9) & 1) << 5)); }
__device__ __forceinline__ void stage_rc(int b, int& R, int& C) { const int st = b / 1024, sb = b % 1024, swz = sb ^ (((sb >> 9) & 1) << 5); R = (st >> 1) * 16 + swz / 64; C = (st & 1) * 32 + (swz % 64) / 2; }
__device__ __forceinline__ int perm32(int rho) { const int n = rho >> 4, i = rho & 15; return 8 * (i >> 2) + 4 * n + (i & 3); }
struct Unit { int pm, pn; };
struct Gemm { const bf16_t* A; const bf16_t* Bt; int M, N, K, lda, ldb, a_grp_div; long a_gstride; int pm_mask = 0xffff; };
struct StaticOrder {
    int nM, nN, nwg, G, c;
    __device__ void init(int M, int N, int G_, int c_) { nM = M / BM; nN = N / BM; nwg = nM * nN; G = G_; c = c_; }
    __device__ bool next(int i, Unit& u) const {
        const long L = (long)i * G + c; if (L >= nwg) return false;
        int wgid = (int)L; { const int q = nwg / NXCD, r = nwg % NXCD, xcd = wgid % NXCD, off = wgid / NXCD; wgid = (xcd < r ? xcd * (q + 1) : r * (q + 1) + (xcd - r) * q) + off; }
        const int nig = WGM * nN, gid = wgid / nig, fm = gid * WGM, gsz = (nM - fm) < WGM ? (nM - fm) : WGM;
        u.pm = fm + ((wgid % nig) % gsz); u.pn = (wgid % nig) / gsz; return true;
    }
};

template <class Epi>
__device__ __forceinline__ void gemm_phase(LAS unsigned char* lds, const Gemm g, const StaticOrder& S, const Epi& E) {
    const int tid = threadIdx.x, wid = __builtin_amdgcn_readfirstlane(tid >> 6), lane = tid & 63, wr = wid >> 2, wc = wid & 3, fr = lane & 15, fq = lane >> 4;
    const int K = g.K, nt = K / BK;
    unsigned voffA[2], voffB[2];
#pragma unroll
    for (int i = 0; i < 2; ++i) { int R, C; stage_rc(tid * 16 + i * 8192, R, C); const int Rb = Epi::PERM ? ((R & ~31) + perm32(R & 31)) : R;
        voffA[i] = (unsigned)(R * g.lda + C) * 2u; voffB[i] = (unsigned)(Rb * g.ldb + C) * 2u; }
    const size_t kstep = (size_t)(BK * 2);
    const size_t hsA = (size_t)HALF * g.lda * 2, hsB = (size_t)HALF * g.ldb * 2;
    const size_t tsA = 2 * hsA, tsB = 2 * hsB;
    const unsigned ldsw = (unsigned)wid * 1024u;
    const int aoff = lds_byte(wr * 64 + fr, fq * 8), boff = lds_byte(wc * 32 + fr, fq * 8);
#define PG8_SA(b, h) (((b) * 2 + (h)) * HTB)
#define PG8_SB(b, h) ((4 + (b) * 2 + (h)) * HTB)
#define PG8_STAGE(bufoff, gbase, voff) do { _Pragma("unroll") for (int _i = 0; _i < 2; ++_i) \
        __builtin_amdgcn_global_load_lds((const unsigned*)((const char*)(gbase) + (voff)[_i]), (LAS unsigned*)(lds + (bufoff) + ldsw + _i * 8192), 16, 0, 0); } while (0)
#define PG8_LDA(dst, b, h) do { _Pragma("unroll") for (int m = 0; m < 4; ++m) _Pragma("unroll") for (int k = 0; k < 2; ++k) dst[m][k] = *(const LAS bf16x8*)(lds + PG8_SA(b, h) + aoff + m * 2048 + k * 1024); } while (0)
#define PG8_LDB(dst, b, h) do { _Pragma("unroll") for (int n = 0; n < 2; ++n) _Pragma("unroll") for (int k = 0; k < 2; ++k) dst[n][k] = *(const LAS bf16x8*)(lds + PG8_SB(b, h) + boff + n * 2048 + k * 1024); } while (0)
#define PG8_MMA(ai, bj, At, Bt) do { __builtin_amdgcn_s_setprio(1); _Pragma("unroll") for (int m = 0; m < 4; ++m) _Pragma("unroll") for (int n = 0; n < 2; ++n) _Pragma("unroll") for (int k = 0; k < 2; ++k) \
        acc[ai][bj][m][n] = __builtin_amdgcn_mfma_f32_16x16x32_bf16(Bt[n][k], At[m][k], acc[ai][bj][m][n], 0, 0, 0); __builtin_amdgcn_s_setprio(0); } while (0)
#define PG8_WAIT_V(n) asm volatile("s_waitcnt vmcnt(" #n ")" ::: "memory")
#define PG8_WAIT_L(n) asm volatile("s_waitcnt lgkmcnt(" #n ")" ::: "memory")
#define PG8_BAR __builtin_amdgcn_s_barrier()
#define PG8_SCHED __builtin_amdgcn_sched_barrier(0)
#define PG8_APTR(u) ((const char*)g.A + (size_t)((u).pm & g.pm_mask) * tsA + (g.a_grp_div ? (size_t)((u).pn / g.a_grp_div) * (size_t)g.a_gstride : (size_t)0))
#define PG8_BPTR(u) ((const char*)g.Bt + (size_t)(u).pn * tsB)
    Unit cur, nxt; int ui = 0;
    if (!S.next(0, cur)) return;
    if (STAGGER_US > 0 && (S.c & 1)) { const unsigned long long t0_ = __builtin_amdgcn_s_memrealtime(), dl_ = (unsigned long long)(STAGGER_US * 100); while (__builtin_amdgcn_s_memrealtime() - t0_ < dl_) __builtin_amdgcn_s_sleep(8); }
    f32x4 acc[2][2][4][2];
#pragma unroll
    for (int a = 0; a < 2; ++a)
#pragma unroll
        for (int b = 0; b < 2; ++b)
#pragma unroll
            for (int m = 0; m < 4; ++m)
#pragma unroll
                for (int n = 0; n < 2; ++n) acc[a][b][m][n] = (f32x4){0.f, 0.f, 0.f, 0.f};
    bf16x8 At[4][2], B0[2][2], B1[2][2];
    const char* cA = PG8_APTR(cur); const char* cB = PG8_BPTR(cur);
    PG8_STAGE(PG8_SB(0, 0), cB, voffB); PG8_STAGE(PG8_SA(0, 0), cA, voffA); PG8_STAGE(PG8_SB(0, 1), cB + hsB, voffB); PG8_STAGE(PG8_SA(0, 1), cA + hsA, voffA);
    if (wr == 1) PG8_BAR;
    PG8_WAIT_V(4); PG8_BAR;
    PG8_STAGE(PG8_SB(1, 0), cB + kstep, voffB); PG8_STAGE(PG8_SA(1, 0), cA + kstep, voffA); PG8_STAGE(PG8_SB(1, 1), cB + hsB + kstep, voffB);
    PG8_WAIT_V(6); PG8_BAR;
    for (;;) {
        const bool has_next = S.next(ui + 1, nxt);
        const char* nA = has_next ? PG8_APTR(nxt) : cA; const char* nB = has_next ? PG8_BPTR(nxt) : cB;
        for (int t = 0; t < nt; t += 2) {
            const bool last = (t == nt - 2);
            const char* a1 = cA + (size_t)(t + 1) * kstep;
            const char* a2 = last ? nA : cA + (size_t)(t + 2) * kstep; const char* b2 = last ? nB : cB + (size_t)(t + 2) * kstep;
            const char* a3 = a2 + kstep; const char* b3 = b2 + kstep;
            PG8_LDB(B0, 0, 0); PG8_SCHED; PG8_LDA(At, 0, 0); PG8_STAGE(PG8_SA(1, 1), a1 + hsA, voffA);
            PG8_WAIT_L(8); PG8_BAR; PG8_WAIT_L(0); PG8_MMA(0, 0, At, B0); PG8_BAR; PG8_SCHED;
            PG8_LDB(B1, 0, 1); PG8_STAGE(PG8_SB(0, 0), b2, voffB);
            PG8_BAR; PG8_WAIT_L(0); PG8_MMA(0, 1, At, B1); PG8_BAR;
            PG8_LDA(At, 0, 1); PG8_STAGE(PG8_SA(0, 0), a2, voffA);
            PG8_BAR; PG8_WAIT_L(0); PG8_MMA(1, 0, At, B0); PG8_BAR; PG8_SCHED;
            PG8_STAGE(PG8_SB(0, 1), b2 + hsB, voffB);
            PG8_WAIT_V(6); PG8_BAR; PG8_MMA(1, 1, At, B1); PG8_BAR;
            PG8_LDB(B0, 1, 0); PG8_SCHED; PG8_LDA(At, 1, 0); PG8_STAGE(PG8_SA(0, 1), a2 + hsA, voffA);
            PG8_WAIT_L(8); PG8_BAR; PG8_WAIT_L(0); PG8_MMA(0, 0, At, B0); PG8_BAR; PG8_SCHED;
            PG8_LDB(B1, 1, 1); PG8_STAGE(PG8_SB(1, 0), b3, voffB);
            PG8_BAR; PG8_WAIT_L(0); PG8_MMA(0, 1, At, B1); PG8_BAR;
            PG8_LDA(At, 1, 1); PG8_STAGE(PG8_SA(1, 0), a3, voffA);
            PG8_BAR; PG8_WAIT_L(0); PG8_MMA(1, 0, At, B0); PG8_BAR; PG8_SCHED;
            PG8_STAGE(PG8_SB(1, 1), b3 + hsB, voffB);
            PG8_WAIT_V(6); PG8_BAR; PG8_MMA(1, 1, At, B1); PG8_BAR;
        }
        E(acc, cur, wr, wc, fr, fq);
        if (!has_next) break;
#pragma unroll
        for (int a = 0; a < 2; ++a)
#pragma unroll
            for (int b = 0; b < 2; ++b)
#pragma unroll
                for (int m = 0; m < 4; ++m)
#pragma unroll
                    for (int n = 0; n < 2; ++n) acc[a][b][m][n] = (f32x4){0.f, 0.f, 0.f, 0.f};
        cur = nxt; cA = nA; cB = nB; ++ui;
    }
    PG8_WAIT_V(0);
    if (wr == 0) PG8_BAR;
    PG8_BAR;
#undef PG8_SA
#undef PG8_SB
#undef PG8_STAGE
#undef PG8_LDA
#undef PG8_LDB
#undef PG8_MMA
#undef PG8_WAIT_V
#undef PG8_WAIT_L
#undef PG8_BAR
#undef PG8_SCHED
#undef PG8_APTR
#undef PG8_BPTR
}

struct EpiL0In {
    static constexpr bool PERM = true;
    bf16_t* U; bf16_t* SZ;
    __device__ __forceinline__ void operator()(const f32x4 (&acc)[2][2][4][2], const Unit& u, int wr, int wc, int fr, int fq) const {
        const int row0 = u.pm * BM + wr * 64 + fr; const bool isz = u.pn >= 8;
        bf16_t* base = isz ? SZ : U; const int col0 = (isz ? u.pn - 8 : u.pn) * BM + wc * 32 + 8 * fq;
#pragma unroll
        for (int ai = 0; ai < 2; ++ai)
#pragma unroll
            for (int m = 0; m < 4; ++m) { bf16_t* rowp = base + (size_t)(row0 + ai * HALF + m * 16) * 2048 + col0;
#pragma unroll
                for (int bj = 0; bj < 2; ++bj) { f32x4 v0 = acc[ai][bj][m][0], v1 = acc[ai][bj][m][1];
                    if (isz) {
#pragma unroll
                        for (int j = 0; j < 4; ++j) { v0[j] = silu_f(v0[j]); v1[j] = silu_f(v1[j]); } }
                    u32x4 w; w.x = cvt_pk_bf16_c(v0[0], v0[1]); w.y = cvt_pk_bf16_c(v0[2], v0[3]); w.z = cvt_pk_bf16_c(v1[0], v1[1]); w.w = cvt_pk_bf16_c(v1[2], v1[3]);
                    __builtin_nontemporal_store(w, (u32x4*)(rowp + bj * HALF)); } }
    }
};
struct EpiGrp {
    static constexpr bool PERM = true;
    bf16_t* YY; const bf16_t* SZ; const float* scale;
    __device__ __forceinline__ void operator()(const f32x4 (&acc)[2][2][4][2], const Unit& u, int wr, int wc, int fr, int fq) const {
        const int row0 = u.pm * BM + wr * 64 + fr; const int col0 = u.pn * BM + wc * 32 + 8 * fq;
        f32x4 sc[2][2];
#pragma unroll
        for (int bj = 0; bj < 2; ++bj) { sc[bj][0] = *(const f32x4*)(scale + col0 + bj * HALF); sc[bj][1] = *(const f32x4*)(scale + col0 + bj * HALF + 4); }
#pragma unroll
        for (int ai = 0; ai < 2; ++ai) {
            u32x4 zz[4][2];
#pragma unroll
            for (int m = 0; m < 4; ++m)
#pragma unroll
                for (int bj = 0; bj < 2; ++bj) zz[m][bj] = *(const u32x4*)(SZ + (size_t)(row0 + ai * HALF + m * 16) * 2048 + col0 + bj * HALF);
#pragma unroll
            for (int m = 0; m < 4; ++m) { const size_t off = (size_t)(row0 + ai * HALF + m * 16) * 2048 + col0;
#pragma unroll
                for (int bj = 0; bj < 2; ++bj) { float zf[8]; unpack8(zz[m][bj], zf);
                    const f32x4 v0 = acc[ai][bj][m][0] * sc[bj][0], v1 = acc[ai][bj][m][1] * sc[bj][1];
                    u32x4 w; w.x = cvt_pk_bf16_c(v0[0] * zf[0], v0[1] * zf[1]); w.y = cvt_pk_bf16_c(v0[2] * zf[2], v0[3] * zf[3]); w.z = cvt_pk_bf16_c(v1[0] * zf[4], v1[1] * zf[5]); w.w = cvt_pk_bf16_c(v1[2] * zf[6], v1[3] * zf[7]);
                    __builtin_nontemporal_store(w, (u32x4*)(YY + off + bj * HALF)); } } }
    }
};
template <bool BASE_BF16> struct EpiRes {
    static constexpr bool PERM = true;
    const float* base_lo; const float* base_hi; const bf16_t* base_b; bf16_t* OUT; const float* gate;
    __device__ __forceinline__ void operator()(const f32x4 (&acc)[2][2][4][2], const Unit& u, int wr, int wc, int fr, int fq) const {
        const int row0 = u.pm * BM + wr * 64 + fr, col0 = u.pn * BM + wc * 32 + 8 * fq;
#pragma unroll
        for (int ai = 0; ai < 2; ++ai) {
            const float* gp = gate + (size_t)seq_of_row(u.pm * BM + ai * HALF + wr * 64) * 3072 + col0;
            f32x4 gv[2][2];
#pragma unroll
            for (int bj = 0; bj < 2; ++bj) { gv[bj][0] = *(const f32x4*)(gp + bj * HALF); gv[bj][1] = *(const f32x4*)(gp + bj * HALF + 4); }
            u32x4 bb[4][2]; f32x4 fb[4][2][2];
            if (!BASE_BF16) {
#pragma unroll
                for (int m = 0; m < 4; ++m) { const int row = row0 + ai * HALF + m * 16; const float* bp = (row < TP ? base_lo + (size_t)row * 1024 : base_hi + (size_t)(row - TP) * 1024) + col0;
#pragma unroll
                    for (int bj = 0; bj < 2; ++bj) { fb[m][bj][0] = *(const f32x4*)(bp + bj * HALF); fb[m][bj][1] = *(const f32x4*)(bp + bj * HALF + 4); } } }
            if (BASE_BF16) {
#pragma unroll
                for (int m = 0; m < 4; ++m)
#pragma unroll
                    for (int bj = 0; bj < 2; ++bj) bb[m][bj] = *(const u32x4*)(base_b + (size_t)(row0 + ai * HALF + m * 16) * 1024 + col0 + bj * HALF); }
#pragma unroll
            for (int m = 0; m < 4; ++m) { const int row = row0 + ai * HALF + m * 16; bf16_t* op = OUT + (size_t)row * 1024 + col0;
#pragma unroll
                for (int bj = 0; bj < 2; ++bj) { float bs[8];
                    if (BASE_BF16) unpack8(bb[m][bj], bs);
                    else { const f32x4 b0 = fb[m][bj][0], b1 = fb[m][bj][1];
                        bs[0] = b0[0]; bs[1] = b0[1]; bs[2] = b0[2]; bs[3] = b0[3]; bs[4] = b1[0]; bs[5] = b1[1]; bs[6] = b1[2]; bs[7] = b1[3]; }
                    const f32x4 v0 = acc[ai][bj][m][0] * gv[bj][0], v1 = acc[ai][bj][m][1] * gv[bj][1];
                    u32x4 w; w.x = cvt_pk_bf16_c(bs[0] + v0[0], bs[1] + v0[1]); w.y = cvt_pk_bf16_c(bs[2] + v0[2], bs[3] + v0[3]); w.z = cvt_pk_bf16_c(bs[4] + v1[0], bs[5] + v1[1]); w.w = cvt_pk_bf16_c(bs[6] + v1[2], bs[7] + v1[3]);
                    __builtin_nontemporal_store(w, (u32x4*)(op + bj * HALF)); } } }
    }
};
struct EpiL1In {
    static constexpr bool PERM = true;
    bf16_t* QKV; bf16_t* STASH; float* AB;
    __device__ __forceinline__ void operator()(const f32x4 (&acc)[2][2][4][2], const Unit& u, int wr, int wc, int fr, int fq) const {
        const int row0 = u.pm * BM + wr * 64 + fr;
        if (u.pn < 16) {
            const int col0 = u.pn * BM + wc * 32 + 8 * fq;
#pragma unroll
            for (int ai = 0; ai < 2; ++ai)
#pragma unroll
                for (int m = 0; m < 4; ++m) { const int row = row0 + ai * HALF + m * 16; bf16_t* rowp = QKV + (size_t)row * 4096 + col0; const int rl = row & 63;
#pragma unroll
                    for (int bj = 0; bj < 2; ++bj) { const f32x4 v0 = acc[ai][bj][m][0], v1 = acc[ai][bj][m][1];
                        u32x4 w; w.x = cvt_pk_bf16_c(v0[0], v0[1]); w.y = cvt_pk_bf16_c(v0[2], v0[3]); w.z = cvt_pk_bf16_c(v1[0], v1[1]); w.w = cvt_pk_bf16_c(v1[2], v1[3]);
                        __builtin_nontemporal_store(w, (u32x4*)(rowp + bj * HALF));
                        if (rl >= 61) *(u32x4*)(STASH + ((size_t)(row >> 6) * 3 + (rl - 61)) * 4096 + col0 + bj * HALF) = w; } }
        } else if (wc == 0) {
#pragma unroll
            for (int ai = 0; ai < 2; ++ai)
#pragma unroll
                for (int m = 0; m < 4; ++m) { const int row = row0 + ai * HALF + m * 16; float* rowp = AB + (size_t)row * 32 + 8 * fq;
                    *(f32x4*)(rowp) = acc[ai][0][m][0]; *(f32x4*)(rowp + 4) = acc[ai][0][m][1]; }
        }
    }
};
struct EpiZ {
    static constexpr bool PERM = true;
    bf16_t* QKV;
    __device__ __forceinline__ void operator()(const f32x4 (&acc)[2][2][4][2], const Unit& u, int wr, int wc, int fr, int fq) const {
        const int row0 = u.pm * BM + wr * 64 + fr; const int col0 = 2048 + u.pn * BM + wc * 32 + 8 * fq;
#pragma unroll
        for (int ai = 0; ai < 2; ++ai) {
            u32x4 oo[4][2];
#pragma unroll
            for (int m = 0; m < 4; ++m)
#pragma unroll
                for (int bj = 0; bj < 2; ++bj) oo[m][bj] = *(const u32x4*)(QKV + (size_t)(row0 + ai * HALF + m * 16) * 4096 + col0 + bj * HALF);
#pragma unroll
            for (int m = 0; m < 4; ++m) { bf16_t* rowp = QKV + (size_t)(row0 + ai * HALF + m * 16) * 4096 + col0;
#pragma unroll
                for (int bj = 0; bj < 2; ++bj) { float of[8]; unpack8(oo[m][bj], of);
                    const f32x4 v0 = acc[ai][bj][m][0], v1 = acc[ai][bj][m][1];
                    u32x4 w; w.x = cvt_pk_bf16_c(of[0] * silu_f(v0[0]), of[1] * silu_f(v0[1])); w.y = cvt_pk_bf16_c(of[2] * silu_f(v0[2]), of[3] * silu_f(v0[3]));
                    w.z = cvt_pk_bf16_c(of[4] * silu_f(v1[0]), of[5] * silu_f(v1[1])); w.w = cvt_pk_bf16_c(of[6] * silu_f(v1[2]), of[7] * silu_f(v1[3]));
                    __builtin_nontemporal_store(w, (u32x4*)(rowp + bj * HALF)); } } }
    }
};
struct EpiNull {
    static constexpr bool PERM = true;
    float* sink;
    __device__ __forceinline__ void operator()(const f32x4 (&acc)[2][2][4][2], const Unit& u, int wr, int wc, int fr, int fq) const {
        float t = 0.f;
#pragma unroll
        for (int ai = 0; ai < 2; ++ai)
#pragma unroll
            for (int bj = 0; bj < 2; ++bj)
#pragma unroll
                for (int m = 0; m < 4; ++m)
#pragma unroll
                    for (int n = 0; n < 2; ++n) t += acc[ai][bj][m][n][0] + acc[ai][bj][m][n][1] + acc[ai][bj][m][n][2] + acc[ai][bj][m][n][3];
        if (t == 12345.678f) sink[0] = t;
    }
};
}

__device__ void transpose_tile(const float* src, int ld_src, int k0, int ncol0, int ncols_valid, bf16_t* dst, int ld_dst, int dst_row0, float* tile) {
    const int tid = threadIdx.x;
    { const int r = tid >> 4, c4 = (tid & 15) * 4;
#pragma unroll
        for (int i = 0; i < 2; ++i) { const int row = r + 32 * i; f32x4 v = (f32x4){0.f, 0.f, 0.f, 0.f};
            if (ncol0 + c4 < ncols_valid) v = *(const f32x4*)(src + (size_t)(k0 + row) * ld_src + ncol0 + c4);
            tile[row * 65 + c4 + 0] = v[0]; tile[row * 65 + c4 + 1] = v[1]; tile[row * 65 + c4 + 2] = v[2]; tile[row * 65 + c4 + 3] = v[3]; } }
    __syncthreads();
    { const int n = tid >> 3, k8 = (tid & 7) * 8; float f[8];
#pragma unroll
        for (int j = 0; j < 8; ++j) f[j] = tile[(k8 + j) * 65 + n];
        *(u32x4*)(dst + (size_t)(dst_row0 + n) * ld_dst + k0 + k8) = pack8(f); }
    __syncthreads();
}
__device__ void phase_prep(const Params& p, unsigned char* lds_g) {
    float* tile = (float*)lds_g;
    bf16_t* W1t = (bf16_t*)(p.ws + WS_W1T); bf16_t* Wgt = (bf16_t*)(p.ws + WS_WGT); bf16_t* W2t = (bf16_t*)(p.ws + WS_W2T); bf16_t* W3t = (bf16_t*)(p.ws + WS_W3T); bf16_t* W4t = (bf16_t*)(p.ws + WS_W4T);
    float* mod = (float*)(p.ws + WS_MOD);
    const int tid = threadIdx.x;
    constexpr int N_MOD = 256, N_W1 = 1024, N_WG = 256, N_W2 = 512, N_W3 = 1600, N_W4 = 512, N_ALL = N_MOD + N_W1 + N_WG + N_W2 + N_W3 + N_W4;
    for (int it = blockIdx.x; it < N_ALL; it += gridDim.x) {
        int i = it;
        if (i < N_MOD) {
            const int colchunk = i & 63, rg = i >> 6; const int cl = tid % 96, ksl = tid / 96; const int col = colchunk * 96 + cl, layer = col / 3072, cc = col % 3072;
            for (int idx = tid; idx < 12288; idx += NT) { const int k = idx / 12, r = idx % 12, row = rg * 12 + r;
                const float cv = row < 16 ? p.c_prompt[row * 1024 + k] : p.c_sample[(row - 16) * 1024 + k]; tile[idx] = silu_f(cv); }
            __syncthreads();
            float a[12];
#pragma unroll
            for (int r = 0; r < 12; ++r) a[r] = 0.f;
            if (ksl < 4) {
                const float* wp = p.ada_w + (size_t)layer * 1024 * 3072 + (size_t)(ksl * 256) * 3072 + cc; const float* tp = tile + ksl * 256 * 12;
#pragma unroll 16
                for (int k = 0; k < 256; ++k) { const float w = wp[(size_t)k * 3072]; const f32x4 s0 = *(const f32x4*)(tp + k * 12), s1 = *(const f32x4*)(tp + k * 12 + 4), s2 = *(const f32x4*)(tp + k * 12 + 8);
                    a[0] += w * s0[0]; a[1] += w * s0[1]; a[2] += w * s0[2]; a[3] += w * s0[3]; a[4] += w * s1[0]; a[5] += w * s1[1]; a[6] += w * s1[2]; a[7] += w * s1[3]; a[8] += w * s2[0]; a[9] += w * s2[1]; a[10] += w * s2[2]; a[11] += w * s2[3]; }
            }
            __syncthreads();
            if (ksl < 4) {
#pragma unroll
                for (int r = 0; r < 12; ++r) tile[(ksl * 12 + r) * 96 + cl] = a[r]; }
            __syncthreads();
            if (tid < 96) { const float bias = p.ada_b[layer * 3072 + cc];
#pragma unroll
                for (int r = 0; r < 12; ++r) mod[((size_t)layer * 48 + rg * 12 + r) * 3072 + cc] = tile[r * 96 + tid] + tile[(12 + r) * 96 + tid] + tile[(24 + r) * 96 + tid] + tile[(36 + r) * 96 + tid] + bias; }
            __syncthreads();
            continue;
        }
        i -= N_MOD;
        if (i < N_W1) { const int kt = i & 15, ntile = i >> 4; transpose_tile(p.pool_w_in, 4096, kt * 64, ntile * 64, 4096, W1t, 1024, ntile * 64, tile); continue; }
        i -= N_W1;
        if (i < N_WG) { const int g = i >> 6, r = i & 63, kt = r & 7, ntile = r >> 3; transpose_tile(p.pool_w_group + (size_t)g * 512 * 512, 512, kt * 64, ntile * 64, 512, Wgt + (size_t)g * 512 * 512, 512, ntile * 64, tile); continue; }
        i -= N_WG;
        if (i < N_W2) { const int kt = i & 31, ntile = i >> 5; transpose_tile(p.pool_w_out, 1024, kt * 64, ntile * 64, 1024, W2t, 2048, ntile * 64, tile); continue; }
        i -= N_W2;
        if (i < N_W3) { const int kt = i & 15, ntile = i >> 4; const int n0 = ntile * 64;
            const int src0 = n0 < 4096 ? n0 : (n0 < 4352 ? 6144 + (n0 - 4096) : 4096 + (n0 - 4352));
            const int valid = (n0 >= 4096 && n0 < 4352) ? 6176 : 1 << 30;
            transpose_tile(p.gdn_w_in, 6176, kt * 64, src0, valid, W3t, 1024, n0, tile); continue; }
        i -= N_W3;
        { const int kt = i & 31, ntile = i >> 5; transpose_tile(p.gdn_w_out, 1024, kt * 64, ntile * 64, 1024, W4t, 2048, ntile * 64, tile); }
    }
}

constexpr int NR = 4;
__device__ void phase_norm_mod(const float* x_lo, const float* x_hi, const float* gain, const float* modl, bf16_t* H) {
    const int lane = threadIdx.x & 63, wid = threadIdx.x >> 6;
    for (int rp = blockIdx.x * 8 + wid; rp < T / NR; rp += gridDim.x * 8) {
        f32x4 v[NR][4]; float ss[NR];
#pragma unroll
        for (int q = 0; q < NR; ++q) { const int row = rp * NR + q; const float* xr = row < TP ? x_lo + (size_t)row * 1024 : x_hi + (size_t)(row - TP) * 1024;
#pragma unroll
            for (int j = 0; j < 4; ++j) v[q][j] = __builtin_nontemporal_load((const f32x4*)(xr + j * 256 + lane * 4)); }
#pragma unroll
        for (int q = 0; q < NR; ++q) { float a = 0.f;
#pragma unroll
            for (int j = 0; j < 4; ++j) a += v[q][j][0] * v[q][j][0] + v[q][j][1] * v[q][j][1] + v[q][j][2] * v[q][j][2] + v[q][j][3] * v[q][j][3];
#pragma unroll
            for (int o = 32; o >= 1; o >>= 1) a += __shfl_xor(a, o);
            ss[q] = a; }
#pragma unroll
        for (int q = 0; q < NR; ++q) { const int row = rp * NR + q; const float r = rsqrtf(ss[q] * (1.0f / 1024.0f) + EPS);
            const float* ms = modl + (size_t)seq_of_row(row) * 3072;
#pragma unroll
            for (int j = 0; j < 4; ++j) { const int c = j * 256 + lane * 4; const f32x4 gn = *(const f32x4*)(gain + c), sh = *(const f32x4*)(ms + c), sc = *(const f32x4*)(ms + 1024 + c);
                const f32x4 o = v[q][j] * r * gn * (sc + 1.0f) + sh; u32x2 w; w.x = cvt_pk_bf16(o[0], o[1]); w.y = cvt_pk_bf16(o[2], o[3]); *(u32x2*)(H + (size_t)row * 1024 + c) = w; } }
    }
}
template <int MODE>
__device__ void phase_norm_b(const bf16_t* X, const float* gain, const float* modl, bf16_t* H, float* out) {
    constexpr int NRB = 8;
    const int lane = threadIdx.x & 63, wid = threadIdx.x >> 6;
    for (int rp = blockIdx.x * 8 + wid; rp < T / NRB; rp += gridDim.x * 8) {
        u32x4 raw[NRB][2]; float ss[NRB];
#pragma unroll
        for (int q = 0; q < NRB; ++q) { const bf16_t* xr = X + (size_t)(rp * NRB + q) * 1024;
#pragma unroll
            for (int j = 0; j < 2; ++j) raw[q][j] = __builtin_nontemporal_load((const u32x4*)(xr + j * 512 + lane * 8)); }
#pragma unroll
        for (int q = 0; q < NRB; ++q) { float a = 0.f;
#pragma unroll
            for (int j = 0; j < 2; ++j) { float f[8]; unpack8(raw[q][j], f);
#pragma unroll
                for (int e = 0; e < 8; ++e) a += f[e] * f[e]; }
#pragma unroll
            for (int o = 32; o >= 1; o >>= 1) a += __shfl_xor(a, o);
            ss[q] = a; }
#pragma unroll
        for (int q = 0; q < NRB; ++q) { const int row = rp * NRB + q; const float r = rsqrtf(ss[q] * (1.0f / 1024.0f) + EPS);
#pragma unroll
            for (int j = 0; j < 2; ++j) { const int c = j * 512 + lane * 8; float f[8], o[8]; unpack8(raw[q][j], f);
                const f32x4 g0 = *(const f32x4*)(gain + c), g1 = *(const f32x4*)(gain + c + 4);
                if (MODE == 0) { const float* ms = modl + (size_t)seq_of_row(row) * 3072; const f32x4 sh0 = *(const f32x4*)(ms + c), sh1 = *(const f32x4*)(ms + c + 4), sc0 = *(const f32x4*)(ms + 1024 + c), sc1 = *(const f32x4*)(ms + 1024 + c + 4);
#pragma unroll
                    for (int e = 0; e < 4; ++e) { o[e] = f[e] * r * g0[e] * (sc0[e] + 1.0f) + sh0[e]; o[4 + e] = f[4 + e] * r * g1[e] * (sc1[e] + 1.0f) + sh1[e]; }
                    *(u32x4*)(H + (size_t)row * 1024 + c) = pack8(o); }
                else { __builtin_nontemporal_store((f32x4){f[0] * r * g0[0], f[1] * r * g0[1], f[2] * r * g0[2], f[3] * r * g0[3]}, (f32x4*)(out + (size_t)row * 1024 + c));
                    __builtin_nontemporal_store((f32x4){f[4] * r * g1[0], f[5] * r * g1[1], f[6] * r * g1[2], f[7] * r * g1[3]}, (f32x4*)(out + (size_t)row * 1024 + c + 4)); } }
        }
    }
}

struct SeqInfo { int sq, lc, seq_t0; bool sample, last; };
__device__ __forceinline__ SeqInfo chunk_info(int chunk) { SeqInfo s; if (chunk < 1024) { s.sq = chunk >> 6; s.lc = chunk & 63; s.seq_t0 = s.sq * 4096; s.sample = false; s.last = (s.lc == 63); } else { const int cs = chunk - 1024; s.sq = 16 + cs; s.lc = 0; s.seq_t0 = TP + cs * 64; s.sample = true; s.last = true; } return s; }
__device__ __forceinline__ void pool_fetch(const bf16_t* U, const float* spool, const SeqInfo& si, int pos, int c, float (&f)[8]) {
    if (pos >= 0) { const u32x4 w = *(const u32x4*)(U + (size_t)(si.seq_t0 + pos) * 2048 + c); unpack8(w, f); }
    else if (si.sample) { const float* sp = spool + ((size_t)(si.sq - 16) * 15 + 15 + pos) * 2048 + c; const f32x4 a = *(const f32x4*)sp, b = *(const f32x4*)(sp + 4);
        f[0] = a[0]; f[1] = a[1]; f[2] = a[2]; f[3] = a[3]; f[4] = b[0]; f[5] = b[1]; f[6] = b[2]; f[7] = b[3]; }
    else {
#pragma unroll
        for (int j = 0; j < 8; ++j) f[j] = 0.f; }
}
template <int W>
__device__ __forceinline__ void pool_fast(const Params& p, const bf16_t* U, bf16_t* D, const SeqInfo& si, int g, int col8, int rs) {
    const int c = g * 512 + col8 * 8; const int p0 = si.lc * 64 + rs * 8;
    u32x4 raw[W + 7];
#pragma unroll
    for (int k = 0; k < W + 7; ++k) { const int pos = p0 - (W - 1) + k; raw[k] = pos >= 0 ? *(const u32x4*)(U + (size_t)(si.seq_t0 + pos) * 2048 + c) : (u32x4){0u, 0u, 0u, 0u}; }
    float s[8], cur[8], old[8];
#pragma unroll
    for (int j = 0; j < 8; ++j) s[j] = 0.f;
#pragma unroll
    for (int k = 0; k < W - 1; ++k) { unpack8(raw[k], cur);
#pragma unroll
        for (int j = 0; j < 8; ++j) s[j] += cur[j]; }
#pragma unroll
    for (int i = 0; i < 8; ++i) { const int pos = p0 + i; unpack8(raw[W - 1 + i], cur);
        if (i > 0) { unpack8(raw[i - 1], old);
#pragma unroll
            for (int j = 0; j < 8; ++j) s[j] -= old[j]; }
#pragma unroll
        for (int j = 0; j < 8; ++j) s[j] += cur[j];
        const float inv = 1.0f / fminf((float)(pos + 1), (float)W);
        float d[8];
#pragma unroll
        for (int j = 0; j < 8; ++j) d[j] = s[j] * inv - cur[j];
        *(u32x4*)(D + (size_t)(si.seq_t0 + pos) * 2048 + c) = pack8(d);
        const int rl = rs * 8 + i;
        if (si.last && rl >= 49) { float* op = p.out + O_POOL_P + ((size_t)si.sq * 15 + (rl - 49)) * 2048 + c;
            *(f32x4*)op = (f32x4){cur[0], cur[1], cur[2], cur[3]}; *(f32x4*)(op + 4) = (f32x4){cur[4], cur[5], cur[6], cur[7]}; }
    }
}
__device__ void phase_pool(const Params& p) {
    const bf16_t* U = (const bf16_t*)(p.ws + WS_R1); bf16_t* D = (bf16_t*)(p.ws + WS_R3);
    const int tid = threadIdx.x, col8 = tid & 63, rs = tid >> 6;
    for (int it = blockIdx.x; it < NCHUNK * 4; it += gridDim.x) {
        const int chunk = it >> 2, g = it & 3, w = 2 << g; const SeqInfo si = chunk_info(chunk);
        if (!si.sample) {
            if (g == 0) pool_fast<2>(p, U, D, si, g, col8, rs); else if (g == 1) pool_fast<4>(p, U, D, si, g, col8, rs); else if (g == 2) pool_fast<8>(p, U, D, si, g, col8, rs); else pool_fast<16>(p, U, D, si, g, col8, rs);
            continue;
        }
        const int c = g * 512 + col8 * 8; const int p0 = si.lc * 64 + rs * 8;
        float s[8], cur[8], old[8];
#pragma unroll
        for (int j = 0; j < 8; ++j) s[j] = 0.f;
        for (int q = p0 - w + 1; q < p0; ++q) { pool_fetch(U, p.state_pool, si, q, c, cur);
#pragma unroll
            for (int j = 0; j < 8; ++j) s[j] += cur[j]; }
#pragma unroll 1
        for (int i = 0; i < 8; ++i) { const int pos = p0 + i;
            pool_fetch(U, p.state_pool, si, pos, c, cur);
            if (i > 0) { pool_fetch(U, p.state_pool, si, pos - w, c, old);
#pragma unroll
                for (int j = 0; j < 8; ++j) s[j] -= old[j]; }
#pragma unroll
            for (int j = 0; j < 8; ++j) s[j] += cur[j];
            const float inv = 1.0f / (float)w;
            float d[8];
#pragma unroll
            for (int j = 0; j < 8; ++j) d[j] = s[j] * inv - cur[j];
            *(u32x4*)(D + (size_t)(si.seq_t0 + pos) * 2048 + c) = pack8(d);
            const int rl = rs * 8 + i;
            if (rl >= 49) { float* op = p.out + O_POOL_S + ((size_t)(si.sq - 16) * 15 + (rl - 49)) * 2048 + c;
                *(f32x4*)op = (f32x4){cur[0], cur[1], cur[2], cur[3]}; *(f32x4*)(op + 4) = (f32x4){cur[4], cur[5], cur[6], cur[7]}; }
        }
    }
}

__device__ void phase_conv(const Params& p) {
    bf16_t* QKV = (bf16_t*)(p.ws + WS_R1); const bf16_t* STASH = (const bf16_t*)(p.ws + WS_STASH); const float* AB = (const float*)(p.ws + WS_AB);
    float* GC = (float*)(p.ws + WS_GC); float* BETA = (float*)(p.ws + WS_BETA);
    const int tid = threadIdx.x, stream = tid >> 7, ct = tid & 127, lane = tid & 63, wid = tid >> 6;
    const int qt = blockIdx.x & 3;
    const int ch = qt * 1024 + ct * 8; const int r0 = stream * 16;
    float wv[4][8];
#pragma unroll
    for (int t = 0; t < 4; ++t) { const f32x4 a = *(const f32x4*)(p.gdn_conv_w + t * 4096 + ch), b = *(const f32x4*)(p.gdn_conv_w + t * 4096 + ch + 4);
        wv[t][0] = a[0]; wv[t][1] = a[1]; wv[t][2] = a[2]; wv[t][3] = a[3]; wv[t][4] = b[0]; wv[t][5] = b[1]; wv[t][6] = b[2]; wv[t][7] = b[3]; }
    u32x4 nx[16], nh[3];
#define CONV_LOADX(it_, lo_) do { const size_t t0_ = (size_t)((it_) >> 2) * 64; \
        _Pragma("unroll") for (int i_ = (lo_); i_ < (lo_) + 8; ++i_) nx[i_] = *(const u32x4*)(QKV + (t0_ + r0 + i_) * 4096 + ch); } while (0)
#define CONV_LOADH(it_) do { const int chunk_ = (it_) >> 2; const SeqInfo si_ = chunk_info(chunk_); const size_t t0_ = (size_t)chunk_ * 64; \
        if (stream > 0) { _Pragma("unroll") for (int j_ = 0; j_ < 3; ++j_) nh[j_] = *(const u32x4*)(QKV + (t0_ + r0 - 3 + j_) * 4096 + ch); } \
        else if (si_.lc > 0) { _Pragma("unroll") for (int j_ = 0; j_ < 3; ++j_) nh[j_] = *(const u32x4*)(STASH + ((size_t)(chunk_ - 1) * 3 + j_) * 4096 + ch); } \
        else { _Pragma("unroll") for (int j_ = 0; j_ < 3; ++j_) nh[j_] = (u32x4){0u, 0u, 0u, 0u}; } } while (0)
    if ((int)blockIdx.x < NCHUNK * 4) { CONV_LOADH((int)blockIdx.x); CONV_LOADX((int)blockIdx.x, 0); CONV_LOADX((int)blockIdx.x, 8); }
    for (int it = blockIdx.x; it < NCHUNK * 4; it += gridDim.x) {
        const int chunk = it >> 2; const SeqInfo si = chunk_info(chunk); const int t0 = chunk * 64;
        const int nit = it + (int)gridDim.x; const bool has_next = nit < NCHUNK * 4;
        __syncthreads();
        float h0[8], h1[8], h2[8];
        unpack8(nh[0], h0); unpack8(nh[1], h1); unpack8(nh[2], h2);
        if (stream == 0 && si.lc == 0 && si.sample) { const float* sp = p.state_conv + (size_t)(si.sq - 16) * 3 * 4096 + ch;
#pragma unroll
            for (int j = 0; j < 8; ++j) { h0[j] = sp[j]; h1[j] = sp[4096 + j]; h2[j] = sp[8192 + j]; } }
        if (has_next) CONV_LOADH(nit);
#pragma unroll
        for (int i = 0; i < 16; ++i) {
            bf16_t* rp = QKV + (size_t)(t0 + r0 + i) * 4096 + ch; float x[8], o[8]; unpack8(nx[i], x);
            float ss = 0.f;
#pragma unroll
            for (int j = 0; j < 8; ++j) { const float cv = wv[0][j] * h0[j] + wv[1][j] * h1[j] + wv[2][j] * h2[j] + wv[3][j] * x[j]; o[j] = silu_f(cv); ss += o[j] * o[j]; h0[j] = h1[j]; h1[j] = h2[j]; h2[j] = x[j]; }
            if (qt < 2) { ss = dpp_sum16(ss);
                const float sc = rsqrtf(ss + EPS) * (qt == 0 ? 0.08838834764831845f : 1.0f);
#pragma unroll
                for (int j = 0; j < 8; ++j) o[j] *= sc; }
            *(u32x4*)rp = pack8c(o);
            if (si.last && stream == 3 && i >= 13) { float* op = p.out + (si.sample ? O_CONV_S + ((size_t)(si.sq - 16) * 3 + (i - 13)) * 4096 : O_CONV_P + ((size_t)si.sq * 3 + (i - 13)) * 4096) + ch;
                *(f32x4*)op = (f32x4){x[0], x[1], x[2], x[3]}; *(f32x4*)(op + 4) = (f32x4){x[4], x[5], x[6], x[7]}; }
            if (i == 7 && has_next) CONV_LOADX(nit, 0);
            if (i == 15 && has_next) CONV_LOADX(nit, 8);
        }
        if (wid < 4) {
            { const int h = qt * 4 + wid; const float a = AB[(size_t)(t0 + lane) * 32 + h], b = AB[(size_t)(t0 + lane) * 32 + 16 + h];
                const float xx = a + p.gdn_dt_bias[h]; const float sp = xx > 20.f ? xx : log1pf(expf(xx)); float g = -expf(p.gdn_a_log[h]) * sp;
#pragma unroll
                for (int o = 1; o < 64; o <<= 1) { const float t = __shfl_up(g, o); if (lane >= o) g += t; }
                GC[((size_t)chunk * 16 + h) * 64 + lane] = g; BETA[((size_t)chunk * 16 + h) * 64 + lane] = 1.0f / (1.0f + expf(-b)); }
        }
    }
#undef CONV_LOADX
#undef CONV_LOADH
}

__device__ void phase_j1(const Params& p, unsigned char* lds_g) {
    const bf16_t* QKV = (const bf16_t*)(p.ws + WS_R1); const float* GC = (const float*)(p.ws + WS_GC); const float* BETA = (const float*)(p.ws + WS_BETA);
    bf16_t* AH = (bf16_t*)(p.out + O_Y); bf16_t* AQK = AH + (size_t)NCHUNK * 16 * 4096;
    const int lane = threadIdx.x & 63, wid = threadIdx.x >> 6, c = lane & 15, q4 = lane >> 4;
    LAS unsigned char* Wl = (LAS unsigned char*)lds_g + wid * 18432;
    LAS float* Ld = (LAS float*)Wl;
    LAS bf16_t* Lb = (LAS bf16_t*)(Wl + 5120);
    LAS bf16_t* TT = (LAS bf16_t*)(Wl + 5120 + 4992);
    LAS bf16_t* Dm = (LAS bf16_t*)(Wl + 5120 + 9984);
#define J1_SYNC() asm volatile("s_waitcnt lgkmcnt(0)" ::: "memory")
#define J1_A_L(i_, j_) ({ const u32x2 a_ = *(const LAS u32x2*)(Lb + (16 * ((i_) - 1) + c) * 52 + 16 * (j_) + 4 * q4); u32x4 w_; w_.x = a_.x; w_.y = a_.y; w_.z = 0u; w_.w = 0u; __builtin_bit_cast(bf16x8, w_); })
#define J1_A_D(i_) ({ const u32x2 a_ = *(const LAS u32x2*)(Dm + (((i_) - 1) * 16 + c) * 20 + 4 * q4); u32x4 w_; w_.x = a_.x; w_.y = a_.y; w_.z = 0u; w_.w = 0u; __builtin_bit_cast(bf16x8, w_); })
#define J1_B_T(kb_, nb_) ({ const u32x2 a_ = *(const LAS u32x2*)(TT + (16 * (nb_) + c) * 52 + 16 * (kb_) + 4 * q4); u32x4 w_; w_.x = a_.x; w_.y = a_.y; w_.z = 0u; w_.w = 0u; __builtin_bit_cast(bf16x8, w_); })
#define J1_B_ACC(w4_) ({ u32x4 w_; w_.x = cvt_pk_bf16_c((w4_)[0], (w4_)[1]); w_.y = cvt_pk_bf16_c((w4_)[2], (w4_)[3]); w_.z = 0u; w_.w = 0u; __builtin_bit_cast(bf16x8, w_); })
#define J1_MM(A_, B_, acc_) __builtin_amdgcn_mfma_f32_16x16x32_bf16(A_, B_, acc_, 0, 0, 0)
    const f32x4 z4 = (f32x4){0.f, 0.f, 0.f, 0.f};
    for (int wi = blockIdx.x * 8 + wid; wi < NCHUNK * 16; wi += gridDim.x * 8) {
        const int chunk = wi >> 4, h = wi & 15, hk = h >> 1; const size_t t0 = (size_t)chunk * 64;
        const bf16_t* kb = QKV + t0 * 4096 + 1024 + hk * 128; const bf16_t* qb = QKV + t0 * 4096 + hk * 128;
        const float* gcp = GC + (size_t)wi * 64; const float* btp = BETA + (size_t)wi * 64;
        bf16_t* ahb = AH + (size_t)wi * 4096;
        bf16x8 kf[4][4];
#pragma unroll
        for (int mt = 0; mt < 4; ++mt)
#pragma unroll
            for (int ks = 0; ks < 4; ++ks) kf[mt][ks] = *(const bf16x8*)(kb + (size_t)(16 * mt + c) * 4096 + 32 * ks + 8 * q4);
        float gcc[4], btc[4];
#pragma unroll
        for (int nt = 0; nt < 4; ++nt) { gcc[nt] = gcp[16 * nt + c]; btc[nt] = btp[16 * nt + c]; }
#pragma unroll
        for (int mt = 0; mt < 4; ++mt) {
            bf16x8 qf[4];
#pragma unroll
            for (int ks = 0; ks < 4; ++ks) qf[ks] = *(const bf16x8*)(qb + (size_t)(16 * mt + c) * 4096 + 32 * ks + 8 * q4);
            const f32x4 gcr = *(const f32x4*)(gcp + 16 * mt + 4 * q4), btr = *(const f32x4*)(btp + 16 * mt + 4 * q4);
#pragma unroll
            for (int nt = 0; nt < 4; ++nt) {
                bf16_t* aq = AQK + ((size_t)wi * 64 + 16 * mt + 4 * q4) * 64 + 16 * nt + c;
                if (nt <= mt) {
                    f32x4 kk = z4, qk = z4;
#pragma unroll
                    for (int ks = 0; ks < 4; ++ks) { kk = __builtin_amdgcn_mfma_f32_16x16x32_bf16(kf[mt][ks], kf[nt][ks], kk, 0, 0, 0); qk = __builtin_amdgcn_mfma_f32_16x16x32_bf16(qf[ks], kf[nt][ks], qk, 0, 0, 0); }
                    float lv[4];
#pragma unroll
                    for (int e = 0; e < 4; ++e) { const int i = 16 * mt + 4 * q4 + e, j = 16 * nt + c; const float dec = __expf(fminf(gcr[e] - gcc[nt], 0.f));
                        lv[e] = (i > j) ? btr[e] * kk[e] * dec : 0.f;
                        const float a = (i >= j) ? qk[e] * dec : 0.f; aq[e * 64] = (bf16_t)(cvt_pk_bf16_c(a, 0.f) & 0xffffu); }
                    if (nt == mt) {
#pragma unroll
                        for (int e = 0; e < 4; ++e) Ld[(mt * 16 + 4 * q4 + e) * 20 + c] = lv[e]; }
                    else {
#pragma unroll
                        for (int e = 0; e < 4; ++e) Lb[(16 * (mt - 1) + 4 * q4 + e) * 52 + 16 * nt + c] = (bf16_t)(cvt_pk_bf16_c(lv[e], 0.f) & 0xffffu); }
                } else {
#pragma unroll
                    for (int e = 0; e < 4; ++e) aq[e * 64] = (bf16_t)0;
                }
            }
        }
        { const int bz = lane >> 4; bf16_t* zr = ahb + lane * 64; const u32x4 z = (u32x4){0u, 0u, 0u, 0u};
#pragma unroll
          for (int bb = 1; bb < 4; ++bb) if (bb > bz) { *(u32x4*)(zr + 16 * bb) = z; *(u32x4*)(zr + 16 * bb + 8) = z; } }
        J1_SYNC();
        float t[16];
#pragma unroll
        for (int i = 0; i < 16; ++i) {
            float s0 = (c == i) ? 1.f : 0.f, s1 = 0.f, s2 = 0.f, s3 = 0.f;
#pragma unroll
            for (int j4 = 0; j4 < i; j4 += 4) { const f32x4 l = *(const LAS f32x4*)(Ld + (q4 * 16 + i) * 20 + j4);
                s0 -= l[0] * t[j4]; if (j4 + 1 < i) s1 -= l[1] * t[j4 + 1]; if (j4 + 2 < i) s2 -= l[2] * t[j4 + 2]; if (j4 + 3 < i) s3 -= l[3] * t[j4 + 3]; }
            t[i] = (s0 + s1) + (s2 + s3);
        }
        {
            const float bcol = btc[0] * (q4 == 0 ? 1.f : 0.f) + btc[1] * (q4 == 1 ? 1.f : 0.f) + btc[2] * (q4 == 2 ? 1.f : 0.f) + btc[3] * (q4 == 3 ? 1.f : 0.f);
            if (q4 < 3) {
#pragma unroll
                for (int i4 = 0; i4 < 4; ++i4) { u32x2 w; w.x = cvt_pk_bf16_c(t[4 * i4], t[4 * i4 + 1]); w.y = cvt_pk_bf16_c(t[4 * i4 + 2], t[4 * i4 + 3]); *(LAS u32x2*)(TT + (16 * q4 + c) * 52 + 16 * q4 + 4 * i4) = w; } }
            if (q4 > 0) {
#pragma unroll
                for (int i = 0; i < 16; ++i) Dm[((q4 - 1) * 16 + i) * 20 + c] = (bf16_t)(cvt_pk_bf16_c(t[i], 0.f) & 0xffffu); }
#pragma unroll
            for (int i = 0; i < 16; ++i) ahb[(16 * q4 + i) * 64 + 16 * q4 + c] = (bf16_t)(cvt_pk_bf16_c(t[i] * bcol, 0.f) & 0xffffu);
        }
        J1_SYNC();
#define J1_PUT(x4_, i_, j_, keep_) do { if (keep_) { u32x2 w_; w_.x = cvt_pk_bf16_c((x4_)[0], (x4_)[1]); w_.y = cvt_pk_bf16_c((x4_)[2], (x4_)[3]); *(LAS u32x2*)(TT + (16 * (j_) + c) * 52 + 16 * (i_) + 4 * q4) = w_; } \
        _Pragma("unroll") for (int e_ = 0; e_ < 4; ++e_) ahb[(16 * (i_) + 4 * q4 + e_) * 64 + 16 * (j_) + c] = (bf16_t)(cvt_pk_bf16_c((x4_)[e_] * btc[j_], 0.f) & 0xffffu); } while (0)
        {
            f32x4 w10 = J1_MM(J1_A_L(1, 0), J1_B_T(0, 0), z4), w21 = J1_MM(J1_A_L(2, 1), J1_B_T(1, 1), z4), w32 = J1_MM(J1_A_L(3, 2), J1_B_T(2, 2), z4);
            f32x4 t10 = -J1_MM(J1_A_D(1), J1_B_ACC(w10), z4), t21 = -J1_MM(J1_A_D(2), J1_B_ACC(w21), z4), t32 = -J1_MM(J1_A_D(3), J1_B_ACC(w32), z4);
            J1_PUT(t10, 1, 0, true); J1_PUT(t21, 2, 1, true); J1_PUT(t32, 3, 2, false);
            J1_SYNC();
            f32x4 w20 = J1_MM(J1_A_L(2, 0), J1_B_T(0, 0), z4); w20 = J1_MM(J1_A_L(2, 1), J1_B_T(1, 0), w20);
            f32x4 w31 = J1_MM(J1_A_L(3, 1), J1_B_T(1, 1), z4); w31 = J1_MM(J1_A_L(3, 2), J1_B_T(2, 1), w31);
            f32x4 t20 = -J1_MM(J1_A_D(2), J1_B_ACC(w20), z4), t31 = -J1_MM(J1_A_D(3), J1_B_ACC(w31), z4);
            J1_PUT(t20, 2, 0, true); J1_PUT(t31, 3, 1, false);
            J1_SYNC();
            f32x4 w30 = J1_MM(J1_A_L(3, 0), J1_B_T(0, 0), z4); w30 = J1_MM(J1_A_L(3, 1), J1_B_T(1, 0), w30); w30 = J1_MM(J1_A_L(3, 2), J1_B_T(2, 0), w30);
            f32x4 t30 = -J1_MM(J1_A_D(3), J1_B_ACC(w30), z4);
            J1_PUT(t30, 3, 0, false);
        }
        J1_SYNC();
    }
#undef J1_SYNC
#undef J1_A_L
#undef J1_A_D
#undef J1_B_T
#undef J1_B_ACC
#undef J1_MM
#undef J1_PUT
}

__device__ __forceinline__ bf16x8 pack_acc2(const f32x4 a, const f32x4 b) { u32x4 w; w.x = cvt_pk_bf16_c(a[0], a[1]); w.y = cvt_pk_bf16_c(a[2], a[3]); w.z = cvt_pk_bf16_c(b[0], b[1]); w.w = cvt_pk_bf16_c(b[2], b[3]); return __builtin_bit_cast(bf16x8, w); }
__device__ __forceinline__ bf16x8 ld_perm(const bf16_t* ptr) { const u32x2 a = *(const u32x2*)ptr, b = *(const u32x2*)(ptr + 16); u32x4 w; w.x = a.x; w.y = a.y; w.z = b.x; w.w = b.y; return __builtin_bit_cast(bf16x8, w); }
#define LDS_BARRIER() do { asm volatile("s_waitcnt lgkmcnt(0)" ::: "memory"); __builtin_amdgcn_s_barrier(); asm volatile("" ::: "memory"); } while (0)
__device__ void phase_j2(const Params& p, unsigned char* lds_g, bool dry) {
    bf16_t* QKV = (bf16_t*)(p.ws + WS_R1); const float* GC = (const float*)(p.ws + WS_GC);
    const bf16_t* AH = (const bf16_t*)(p.out + O_Y); const bf16_t* AQK = AH + (size_t)NCHUNK * 16 * 4096;
    const int tid = threadIdx.x, lane = tid & 63, w = tid >> 6, c = lane & 15, q4 = lane >> 4;
    constexpr int KN_OFF = 0, QN_OFF = 17408, KT_OFF = 34816, VT_OFF = 53248, AH_OFF = 71680, AQ_OFF = 80896, OS_OFF = 90112, SSQ_OFF = 107520;
    LAS unsigned char* L = (LAS unsigned char*)lds_g;
    LAS bf16_t* KT = (LAS bf16_t*)(L + KT_OFF); LAS bf16_t* VT = (LAS bf16_t*)(L + VT_OFF); LAS bf16_t* OS = (LAS bf16_t*)(L + OS_OFF);
    LAS float* SSQ = (LAS float*)(L + SSQ_OFF);
    const float nw = p.gdn_norm_w[16 * w + c];
    const int rowl = tid & 63, seg = tid >> 6;
    int par = 0;
    if (tid < 128) ((LAS float*)(L + 111616 + 1024))[tid] = 0.f;
    u32x4 rk0, rk1, rq0, rq1, rv0, rv1, ra, rqk; float ngate, ngl;
    LAS float* GEX = (LAS float*)(L + 111616);
    LAS float* SSQT = (LAS float*)(L + 111616 + 1024);
#define J2_LOAD(chunk_) do { const size_t t0_ = (size_t)(chunk_) * 64; const size_t ci_ = (size_t)(chunk_) * 16 + h; \
        const bf16_t* kb_ = QKV + (t0_ + rowl) * 4096 + 1024 + hk * 128 + seg * 16; const bf16_t* qb_ = QKV + (t0_ + rowl) * 4096 + hk * 128 + seg * 16; const bf16_t* vb_ = QKV + (t0_ + rowl) * 4096 + 2048 + h * 128 + seg * 16; \
        rk0 = *(const u32x4*)kb_; rk1 = *(const u32x4*)(kb_ + 8); rq0 = *(const u32x4*)qb_; rq1 = *(const u32x4*)(qb_ + 8); rv0 = *(const u32x4*)vb_; rv1 = *(const u32x4*)(vb_ + 8); \
        ra = *(const u32x4*)(AH + ci_ * 4096 + tid * 8); rqk = *(const u32x4*)(AQK + ci_ * 4096 + tid * 8); \
        ngate = GC[ci_ * 64 + rowl]; ngl = GC[ci_ * 64 + 63]; } while (0)
#define J2_STORE() do { *(LAS u32x4*)(L + KN_OFF + rowl * 272 + seg * 32) = rk0; *(LAS u32x4*)(L + KN_OFF + rowl * 272 + seg * 32 + 16) = rk1; \
        *(LAS u32x4*)(L + QN_OFF + rowl * 272 + seg * 32) = rq0; *(LAS u32x4*)(L + QN_OFF + rowl * 272 + seg * 32 + 16) = rq1; \
        { const unsigned kw_[8] = {rk0.x, rk0.y, rk0.z, rk0.w, rk1.x, rk1.y, rk1.z, rk1.w}; const unsigned vw_[8] = {rv0.x, rv0.y, rv0.z, rv0.w, rv1.x, rv1.y, rv1.z, rv1.w}; \
          _Pragma("unroll") for (int j_ = 0; j_ < 8; ++j_) { KT[(seg * 16 + 2 * j_) * 72 + rowl] = (bf16_t)(kw_[j_] & 0xffffu); KT[(seg * 16 + 2 * j_ + 1) * 72 + rowl] = (bf16_t)(kw_[j_] >> 16); \
              VT[(seg * 16 + 2 * j_) * 72 + rowl] = (bf16_t)(vw_[j_] & 0xffffu); VT[(seg * 16 + 2 * j_ + 1) * 72 + rowl] = (bf16_t)(vw_[j_] >> 16); } } \
        *(LAS u32x4*)(L + AH_OFF + (tid >> 3) * 144 + (tid & 7) * 16) = ra; *(LAS u32x4*)(L + AQ_OFF + (tid >> 3) * 144 + (tid & 7) * 16) = rqk; if (tid < 64) { GEX[tid] = __expf(ngate); GEX[64 + tid] = __expf(ngl - ngate); if (tid == 63) GEX[128] = __expf(ngl); } } while (0)
#define J2_FRAG(off_) ({ const u32x2 a_ = *(const LAS u32x2*)(L + (off_)); const u32x2 b_ = *(const LAS u32x2*)(L + (off_) + 32); u32x4 w_; w_.x = a_.x; w_.y = a_.y; w_.z = b_.x; w_.w = b_.y; __builtin_bit_cast(bf16x8, w_); })
    for (int item = blockIdx.x; item < 768; item += gridDim.x) {
        int chunk0, nch, h; const float* s0 = nullptr; float* sout;
        if (item < 256) { const int b = item >> 4; h = item & 15; chunk0 = b * 64; nch = 64; sout = p.out + O_REC_P + ((size_t)b * 16 + h) * 16384; }
        else { const int b = (item - 256) >> 4; h = item & 15; chunk0 = 1024 + b; nch = 1; s0 = p.state_rec + ((size_t)b * 16 + h) * 16384; sout = p.out + O_REC_S + ((size_t)b * 16 + h) * 16384; }
        const int hk = h >> 1;
        f32x4 S[8];
        { int loff = (4 * q4) * 128 + 16 * w + c; asm volatile("" : "+v"(loff));
#pragma unroll
        for (int mt = 0; mt < 8; ++mt) {
            if (s0) {
#pragma unroll
                for (int e = 0; e < 4; ++e) S[mt][e] = s0[loff + (16 * mt + e) * 128]; }
            else S[mt] = (f32x4){0.f, 0.f, 0.f, 0.f};
        } }
        J2_LOAD(chunk0);
        LDS_BARRIER();
        J2_STORE();
        LDS_BARRIER();
        for (int n = 0; n < nch; ++n, par ^= 1) {
            const int chunk = chunk0 + n; const size_t t0 = (size_t)chunk * 64; const size_t ci = (size_t)chunk * 16 + h;
            const float egl = GEX[128];
            if (n + 1 < nch) J2_LOAD(chunk + 1);
            LAS float* ssq = SSQT + par * 64;
            bf16x8 Sb[4];
#pragma unroll
            for (int ks = 0; ks < 4; ++ks) Sb[ks] = pack_acc2(S[2 * ks], S[2 * ks + 1]);
#define J2_SB() __builtin_amdgcn_sched_barrier(0)
#define J2_LDKQ(dstk, dstq, mt_) do { _Pragma("unroll") for (int ks_ = 0; ks_ < 4; ++ks_) { const int o_ = (16 * (mt_) + c) * 272 + (32 * ks_ + 4 * q4) * 2; dstk[ks_] = J2_FRAG(KN_OFF + o_); dstq[ks_] = J2_FRAG(QN_OFF + o_); } } while (0)
#define J2_MMKQ(srck, srcq, mt_) do { _Pragma("unroll") for (int ks_ = 0; ks_ < 4; ++ks_) { P[mt_] = __builtin_amdgcn_mfma_f32_16x16x32_bf16(srck[ks_], Sb[ks_], P[mt_], 0, 0, 0); QS[mt_] = __builtin_amdgcn_mfma_f32_16x16x32_bf16(srcq[ks_], Sb[ks_], QS[mt_], 0, 0, 0); } } while (0)
            f32x4 P[4], QS[4];
#pragma unroll
            for (int mt = 0; mt < 4; ++mt) { P[mt] = (f32x4){0.f, 0.f, 0.f, 0.f}; QS[mt] = (f32x4){0.f, 0.f, 0.f, 0.f}; }
            bf16x8 ka[4], qa[4], kb2[4], qb2[4]; u32x2 vv[4];
            J2_LDKQ(ka, qa, 0); J2_LDKQ(kb2, qb2, 1);
            J2_SB(); J2_MMKQ(ka, qa, 0); J2_LDKQ(ka, qa, 2);
            J2_SB(); J2_MMKQ(kb2, qb2, 1); J2_LDKQ(kb2, qb2, 3);
            J2_SB(); J2_MMKQ(ka, qa, 2);
            bf16x8 ahf[4][2], aqf[4][2];
#pragma unroll
            for (int mt = 0; mt < 4; ++mt)
#pragma unroll
                for (int k2 = 0; k2 < 2; ++k2) ahf[mt][k2] = J2_FRAG(AH_OFF + (16 * mt + c) * 144 + (32 * k2 + 4 * q4) * 2);
            f32x4 egc[4];
#pragma unroll
            for (int mt = 0; mt < 4; ++mt) { egc[mt] = *(const LAS f32x4*)(GEX + 16 * mt + 4 * q4);
                vv[mt] = *(const LAS u32x2*)(L + VT_OFF + (16 * w + c) * 144 + (16 * mt + 4 * q4) * 2); }
            J2_SB(); J2_MMKQ(kb2, qb2, 3);
            J2_SB();
            f32x4 edl[4];
#pragma unroll
            for (int mt = 0; mt < 4; ++mt) edl[mt] = *(const LAS f32x4*)(GEX + 64 + 16 * mt + 4 * q4);
            f32x4 R[4];
#pragma unroll
            for (int mt = 0; mt < 4; ++mt) { R[mt][0] = bf_lo(vv[mt].x) - egc[mt][0] * P[mt][0]; R[mt][1] = bf_hi(vv[mt].x) - egc[mt][1] * P[mt][1]; R[mt][2] = bf_lo(vv[mt].y) - egc[mt][2] * P[mt][2]; R[mt][3] = bf_hi(vv[mt].y) - egc[mt][3] * P[mt][3]; }
            bf16x8 Rb[2];
#pragma unroll
            for (int k2 = 0; k2 < 2; ++k2) Rb[k2] = pack_acc2(R[2 * k2], R[2 * k2 + 1]);
            J2_SB();
            f32x4 Vn[4];
#pragma unroll
            for (int mt = 0; mt < 4; ++mt) { Vn[mt] = (f32x4){0.f, 0.f, 0.f, 0.f};
#pragma unroll
                for (int k2 = 0; k2 < 2; ++k2) Vn[mt] = __builtin_amdgcn_mfma_f32_16x16x32_bf16(ahf[mt][k2], Rb[k2], Vn[mt], 0, 0, 0); }
            J2_SB();
#pragma unroll
            for (int mt = 0; mt < 4; ++mt)
#pragma unroll
                for (int k2 = 0; k2 < 2; ++k2) aqf[mt][k2] = J2_FRAG(AQ_OFF + (16 * mt + c) * 144 + (32 * k2 + 4 * q4) * 2);
            bf16x8 ktf[4][2];
#pragma unroll
            for (int mt = 0; mt < 4; ++mt)
#pragma unroll
                for (int k2 = 0; k2 < 2; ++k2) ktf[mt][k2] = J2_FRAG(KT_OFF + (16 * mt + c) * 144 + (32 * k2 + 4 * q4) * 2);
            bf16x8 Vb[2], Vsb[2];
#pragma unroll
            for (int k2 = 0; k2 < 2; ++k2) { Vb[k2] = pack_acc2(Vn[2 * k2], Vn[2 * k2 + 1]); Vsb[k2] = pack_acc2(Vn[2 * k2] * edl[2 * k2], Vn[2 * k2 + 1] * edl[2 * k2 + 1]); }
            J2_SB();
            f32x4 O[4];
#pragma unroll
            for (int mt = 0; mt < 4; ++mt) { O[mt] = QS[mt] * egc[mt];
#pragma unroll
                for (int k2 = 0; k2 < 2; ++k2) O[mt] = __builtin_amdgcn_mfma_f32_16x16x32_bf16(aqf[mt][k2], Vb[k2], O[mt], 0, 0, 0); }
            J2_SB();
#pragma unroll
            for (int mt = 0; mt < 4; ++mt) { S[mt] = S[mt] * egl;
#pragma unroll
                for (int k2 = 0; k2 < 2; ++k2) S[mt] = __builtin_amdgcn_mfma_f32_16x16x32_bf16(ktf[mt][k2], Vsb[k2], S[mt], 0, 0, 0); }
            J2_SB();
#pragma unroll
            for (int mt = 0; mt < 4; ++mt)
#pragma unroll
                for (int k2 = 0; k2 < 2; ++k2) ktf[mt][k2] = J2_FRAG(KT_OFF + (16 * (mt + 4) + c) * 144 + (32 * k2 + 4 * q4) * 2);
#pragma unroll
            for (int mt = 0; mt < 4; ++mt) { f32x4 sq = O[mt] * O[mt]; sq[0] = dpp_sum16(sq[0]); sq[1] = dpp_sum16(sq[1]); sq[2] = dpp_sum16(sq[2]); sq[3] = dpp_sum16(sq[3]);
                if (c == 0) {
#pragma unroll
                    for (int e = 0; e < 4; ++e) __hip_atomic_fetch_add(ssq + 16 * mt + 4 * q4 + e, sq[e], __ATOMIC_RELAXED, __HIP_MEMORY_SCOPE_WORKGROUP); } }
            J2_SB();
#pragma unroll
            for (int mt = 0; mt < 4; ++mt) { S[mt + 4] = S[mt + 4] * egl;
#pragma unroll
                for (int k2 = 0; k2 < 2; ++k2) S[mt + 4] = __builtin_amdgcn_mfma_f32_16x16x32_bf16(ktf[mt][k2], Vsb[k2], S[mt + 4], 0, 0, 0); }
#undef J2_SB
#undef J2_LDKQ
#undef J2_MMKQ
            LDS_BARRIER();
#pragma unroll
            for (int mt = 0; mt < 4; ++mt) { const f32x4 tot = *(const LAS f32x4*)(ssq + 16 * mt + 4 * q4);
#pragma unroll
                for (int e = 0; e < 4; ++e) { const float r = rsqrtf(tot[e] * (1.0f / 128.0f) + EPS); OS[(16 * mt + 4 * q4 + e) * 136 + 16 * w + c] = (bf16_t)(cvt_pk_bf16_c(O[mt][e] * r * nw, 0.f) & 0xffffu); } }
            LDS_BARRIER();
            { const int row = tid >> 3, s8 = tid & 7; const u32x4 o0 = *(const LAS u32x4*)(L + OS_OFF + row * 272 + s8 * 32), o1 = *(const LAS u32x4*)(L + OS_OFF + row * 272 + s8 * 32 + 16);
              bf16_t* op = QKV + (t0 + row) * 4096 + 2048 + h * 128 + s8 * 16; if (!dry) { *(u32x4*)op = o0; *(u32x4*)(op + 8) = o1; } }
            if (n + 1 < nch) J2_STORE();
            if (tid < 64) SSQT[(par ^ 1) * 64 + tid] = 0.f;
            LDS_BARRIER();
        }
        { int loff = (4 * q4) * 128 + 16 * w + c; asm volatile("" : "+v"(loff));
#pragma unroll
        for (int mt = 0; mt < 8; ++mt)
#pragma unroll
            for (int e = 0; e < 4; ++e) if (!dry) sout[loff + (16 * mt + e) * 128] = S[mt][e]; }
    }
#undef J2_LOAD
#undef J2_STORE
#undef J2_FRAG
}


#define XB_TMO      128
#define XB_XCNT(j)  (256  + 64 * (j))
#define XB_XSUB(j)  (1280 + 64 * (j))
#define XB_XGEN(j)  (2304 + 64 * (j))
#define XB_TOP      3328
#define XB_TOPGEN   3392
#define XCD_BAR_WORDS 3456
#define XB_SPIN_CAP (1u << 18)
__device__ __forceinline__ unsigned xb_ld(unsigned* p)              { return __hip_atomic_load(p, __ATOMIC_RELAXED, __HIP_MEMORY_SCOPE_AGENT); }
__device__ __forceinline__ unsigned xb_add(unsigned* p, unsigned v) { return __hip_atomic_fetch_add(p, v, __ATOMIC_RELAXED, __HIP_MEMORY_SCOPE_AGENT); }
__device__ __forceinline__ unsigned xb_xcc_id() { return (unsigned)__builtin_amdgcn_s_getreg((3 << 11) | 20) & 0xFu; }
#define XB_SPIN(cond, bar) do { unsigned _sp = 0; while (cond) { __builtin_amdgcn_s_sleep(1); \
    if ((++_sp & 255u) == 0u) { if (xb_ld(&(bar)[XB_TMO])) break; if (_sp > XB_SPIN_CAP) { atomicAdd(&(bar)[XB_TMO], 1u); break; } } } } while (0)
struct XcdBarrier { unsigned* bar; unsigned x; volatile LAS unsigned* st; };
__device__ __forceinline__ XcdBarrier xcd_barrier_post(unsigned* bar, volatile LAS unsigned* st) {
    XcdBarrier b; b.bar = bar; b.x = xb_xcc_id(); b.st = st;
    if (threadIdx.x == 0) (void)xb_add(&bar[XB_XCNT(b.x)], 1u);
    return b;
}
__device__ __forceinline__ void xcd_barrier_complete(unsigned* bar, unsigned x, unsigned& nloc, unsigned& nx) {
    const unsigned G = gridDim.x * gridDim.y * gridDim.z;
    unsigned sum, cnt, mine, sp = 0u;
    for (;;) {
        sum = 0u; cnt = 0u; mine = 0u;
#pragma unroll
        for (unsigned j = 0; j < 16; ++j) { const unsigned c = xb_ld(&bar[XB_XCNT(j)]); sum += c; cnt += (c > 0u) ? 1u : 0u; mine = (j == x) ? c : mine; }
        if (sum == G) break;
        __builtin_amdgcn_s_sleep(1);
        if ((++sp & 255u) == 0u) { if (xb_ld(&bar[XB_TMO])) break; if (sp > XB_SPIN_CAP) { atomicAdd(&bar[XB_TMO], 1u); break; } }
    }
    nloc = mine > 0u ? mine : 1u; nx = cnt > 0u ? cnt : 1u;
}
__device__ __forceinline__ void xcd_barrier(const XcdBarrier& b) {
    asm volatile("s_waitcnt vmcnt(0)" ::: "memory");
    __syncthreads();
    if (threadIdx.x == 0) {
        unsigned* bar = b.bar;
        __builtin_amdgcn_s_waitcnt(0);
        unsigned nloc = b.st[0], nx = b.st[1];
        if (nloc == 0u) { xcd_barrier_complete(bar, b.x, nloc, nx); b.st[0] = nloc; b.st[1] = nx; }
        const unsigned old = xb_add(&bar[XB_XSUB(b.x)], 1u);
        const unsigned gen = old / nloc;
        if (old + 1u == (gen + 1u) * nloc) {
            __builtin_amdgcn_fence(__ATOMIC_RELEASE, "agent");
            asm volatile("s_waitcnt vmcnt(0)" ::: "memory");
            const unsigned og = xb_add(&bar[XB_TOP], 1u);
            const unsigned tg = og / nx;
            if (og + 1u == (tg + 1u) * nx) xb_add(&bar[XB_TOPGEN], 1u);
            else XB_SPIN(xb_ld(&bar[XB_TOPGEN]) == tg, bar);
            __builtin_amdgcn_fence(__ATOMIC_ACQUIRE, "agent");
            xb_add(&bar[XB_XGEN(b.x)], 1u);
            asm volatile("s_waitcnt vmcnt(0)" ::: "memory");
        } else {
            XB_SPIN(xb_ld(&bar[XB_XGEN(b.x)]) == gen, bar);
            __builtin_amdgcn_fence(__ATOMIC_ACQUIRE, "agent");
            asm volatile("s_waitcnt vmcnt(0)" ::: "memory");
        }
    }
    __syncthreads();
}

constexpr int N_PHASES = 14;
#ifndef PH_MASK
#define PH_MASK 0x3fff
#endif
#define PH_ON(n) (((PH_MASK) >> (n)) & 1)
#ifndef REP_MASK
#define REP_MASK 0
#endif
#define REP_ON(n) (((REP_MASK) >> (n)) & 1)
__global__ void __launch_bounds__(NT, 2) mega(Params p, int ph_lo, int ph_hi, int rep_mask) {
    extern __shared__ __attribute__((aligned(16))) unsigned char lds[];
    LAS unsigned char* ldsl = (LAS unsigned char*)lds;
    cg::grid_group grid = cg::this_grid();
    unsigned char* ws = p.ws;
    bf16_t* W1t = (bf16_t*)(ws + WS_W1T); bf16_t* Wgt = (bf16_t*)(ws + WS_WGT); bf16_t* W2t = (bf16_t*)(ws + WS_W2T); bf16_t* W3t = (bf16_t*)(ws + WS_W3T); bf16_t* W4t = (bf16_t*)(ws + WS_W4T);
    float* mod = (float*)(ws + WS_MOD); bf16_t* H = (bf16_t*)(ws + WS_H); bf16_t* R1 = (bf16_t*)(ws + WS_R1); bf16_t* R2 = (bf16_t*)(ws + WS_R2); bf16_t* R3 = (bf16_t*)(ws + WS_R3);
    bf16_t* X1b = (bf16_t*)(ws + WS_R3);
    const int G = gridDim.x, bid = blockIdx.x;
    volatile LAS unsigned* xst = (volatile LAS unsigned*)(ldsl + LDS_BYTES - 16);
    if (threadIdx.x == 0) { xst[0] = 0u; xst[1] = 0u; }
    __syncthreads();
    const XcdBarrier xb = xcd_barrier_post((unsigned*)(ws + WS_BAR), xst);
#define IN(k) (ph_lo <= (k) && (k) < ph_hi)
#define SEAM(k) do { if (IN(k) && IN((k) + 1)) { if (ph_lo < 0) grid.sync(); else xcd_barrier(xb); } } while (0)
    if (PH_ON(0) && IN(0)) { phase_prep(p, lds); }
    SEAM(0);
    if (PH_ON(1) && IN(1)) { phase_norm_mod(p.x_prompt, p.x_sample, p.norm_gain, mod, H); }
    SEAM(1);
    if (PH_ON(2) && IN(2)) { { pg8::Gemm g{H, W1t, T, 4096, 1024, 1024, 1024, 0, 0}; pg8::StaticOrder S; S.init(T, 4096, G, bid); pg8::EpiL0In E{R1, R2}; pg8::gemm_phase(ldsl, g, S, E); } }
    SEAM(2);
    if (PH_ON(3) && IN(3)) { phase_pool(p); }
    SEAM(3);
    if (PH_ON(4) && IN(4)) { { pg8::Gemm g{R3, Wgt, T, 2048, 512, 2048, 512, 2, 1024}; pg8::StaticOrder S; S.init(T, 2048, G, bid); pg8::EpiGrp E{R1, R2, p.pool_scale}; pg8::gemm_phase(ldsl, g, S, E); } }
    SEAM(4);
    if (PH_ON(5) && IN(5)) { { pg8::Gemm g{R1, W2t, T, 1024, 2048, 2048, 2048, 0, 0}; pg8::StaticOrder S; S.init(T, 1024, G, bid); pg8::EpiRes<false> E{p.x_prompt, p.x_sample, nullptr, X1b, mod + 2048}; pg8::gemm_phase(ldsl, g, S, E); } }
    SEAM(5);
    if (PH_ON(6) && IN(6)) { phase_norm_b<0>(X1b, p.norm_gain + 1024, mod + 48 * 3072, H, nullptr); }
    SEAM(6);
    if (PH_ON(7) && IN(7)) { { pg8::Gemm g{H, W3t, T, 4352, 1024, 1024, 1024, 0, 0}; pg8::StaticOrder S; S.init(T, 4352, G, bid); pg8::EpiL1In E{R1, (bf16_t*)(ws + WS_STASH), (float*)(ws + WS_AB)}; pg8::gemm_phase(ldsl, g, S, E); } }
    SEAM(7);
    if (PH_ON(8) && IN(8)) { phase_conv(p); }
    SEAM(8);
    if (PH_ON(9) && IN(9)) { phase_j1(p, lds); }
    SEAM(9);
    if (PH_ON(10) && IN(10)) { phase_j2(p, lds, false); }
    SEAM(10);
    if (PH_ON(11) && IN(11)) { { pg8::Gemm g{H, W3t + (size_t)4352 * 1024, T, 2048, 1024, 1024, 1024, 0, 0}; pg8::StaticOrder S; S.init(T, 2048, G, bid); pg8::EpiZ E{R1}; pg8::gemm_phase(ldsl, g, S, E); } }
    SEAM(11);
    if (PH_ON(12) && IN(12)) { { pg8::Gemm g{R1 + 2048, W4t, T, 1024, 2048, 4096, 2048, 0, 0}; pg8::StaticOrder S; S.init(T, 1024, G, bid); pg8::EpiRes<true> E{nullptr, nullptr, X1b, X1b, mod + 48 * 3072 + 2048}; pg8::gemm_phase(ldsl, g, S, E); } }
    SEAM(12);
    if (PH_ON(13) && IN(13)) { phase_norm_b<1>(X1b, p.final_gain, nullptr, nullptr, p.out + O_Y); }
    SEAM(13);
#undef IN
#undef SEAM
}

#ifndef MK_ONE_LAUNCH
#define MK_ONE_LAUNCH 1
#endif
extern "C" void kernel_launch(void* const* d_in, const int* in_sizes, int n_in, void* d_out, int out_size, void* d_ws, size_t ws_size, hipStream_t stream) {
    static int grid = 0;
    if (grid == 0) {
        if (ws_size < WS_END) { fprintf(stderr, "kernel_launch: workspace too small: %zu < %zu\n", ws_size, (size_t)WS_END); grid = -1; return; }
        int dev = 0, cus = 0, per_cu = 0;
        hipGetDevice(&dev); hipDeviceGetAttribute(&cus, hipDeviceAttributeMultiprocessorCount, dev);
        if (hipFuncSetAttribute((const void*)mega, hipFuncAttributeMaxDynamicSharedMemorySize, LDS_BYTES) != hipSuccess) { fprintf(stderr, "kernel_launch: hipFuncSetAttribute failed\n"); grid = -1; return; }
        if (hipOccupancyMaxActiveBlocksPerMultiprocessor(&per_cu, (const void*)mega, NT, LDS_BYTES) != hipSuccess || per_cu < 1) { fprintf(stderr, "kernel_launch: occupancy query gave %d\n", per_cu); per_cu = 1; }
        (void)hipGetLastError();
        grid = (cus * per_cu) & ~3;
    }
    if (grid < 0) return;
    Params p{};
    p.x_prompt = (const float*)d_in[0]; p.x_sample = (const float*)d_in[1]; p.c_prompt = (const float*)d_in[2]; p.c_sample = (const float*)d_in[3];
    p.state_pool = (const float*)d_in[4]; p.state_conv = (const float*)d_in[5]; p.state_rec = (const float*)d_in[6];
    p.norm_gain = (const float*)d_in[7]; p.ada_w = (const float*)d_in[8]; p.ada_b = (const float*)d_in[9];
    p.pool_w_in = (const float*)d_in[10]; p.pool_w_group = (const float*)d_in[11]; p.pool_scale = (const float*)d_in[12]; p.pool_w_out = (const float*)d_in[13];
    p.gdn_w_in = (const float*)d_in[14]; p.gdn_conv_w = (const float*)d_in[15]; p.gdn_a_log = (const float*)d_in[16]; p.gdn_dt_bias = (const float*)d_in[17]; p.gdn_norm_w = (const float*)d_in[18]; p.gdn_w_out = (const float*)d_in[19];
    p.final_gain = (const float*)d_in[20];
    p.out = (float*)d_out; p.ws = (unsigned char*)d_ws;
    if (hipMemsetAsync((unsigned char*)d_ws + WS_BAR, 0, 16384, stream) != hipSuccess) { fprintf(stderr, "kernel_launch: memset of barrier words failed\n"); return; }
#if MK_ONE_LAUNCH
    int lo = 0, hi = N_PHASES, rep = REP_MASK; void* args[] = {&p, &lo, &hi, &rep};
    hipError_t e = hipLaunchCooperativeKernel((const void*)mega, dim3(grid), dim3(NT), args, LDS_BYTES, stream);
    if (e != hipSuccess) fprintf(stderr, "cooperative launch failed: %s (grid %d)\n", hipGetErrorString(e), grid);
#else
    for (int ph = 0; ph < N_PHASES; ++ph) { hipLaunchKernelGGL(mega, dim3(grid), dim3(NT), LDS_BYTES, stream, p, ph, ph + 1, 0); }
#endif
}
```

```cpp
#include <hip/hip_runtime.h>
#include <hip/hip_cooperative_groups.h>
#include <cstdio>
namespace cg = cooperative_groups;

#define LAS __attribute__((address_space(3)))
typedef unsigned short bf16_t;
typedef short bf16x8 __attribute__((ext_vector_type(8)));
typedef short bf16x4 __attribute__((ext_vector_type(4)));
typedef float f32x4 __attribute__((ext_vector_type(4)));
typedef unsigned u32x4 __attribute__((ext_vector_type(4)));
typedef unsigned u32x2 __attribute__((ext_vector_type(2)));

constexpr int DM = 1024, TP = 65536, TS = 2048, T = TP + TS, NSEQ = 48, NCHUNK = T / 64;
constexpr int NT = 512, LDS_BYTES = 147456;
constexpr float EPS = 1e-6f;

constexpr size_t SZ_BIG = (size_t)T * 2048 * 2;
constexpr size_t WS_W1T = 0;
constexpr size_t WS_WGT = WS_W1T + (size_t)4096 * 1024 * 2;
constexpr size_t WS_W2T = WS_WGT + (size_t)2048 * 512 * 2;
constexpr size_t WS_W3T = WS_W2T + (size_t)1024 * 2048 * 2;
constexpr size_t WS_W4T = WS_W3T + (size_t)6400 * 1024 * 2;
constexpr size_t WS_MOD = WS_W4T + (size_t)1024 * 2048 * 2;
constexpr size_t WS_AB = WS_MOD + (size_t)2 * 48 * 3072 * 4;
constexpr size_t WS_GC = WS_AB + (size_t)T * 32 * 4;
constexpr size_t WS_BETA = WS_GC + (size_t)T * 16 * 4;
constexpr size_t WS_STASH = WS_BETA + (size_t)T * 16 * 4;
constexpr size_t WS_H = WS_STASH + (size_t)NCHUNK * 3 * 4096 * 2;
constexpr size_t WS_R1 = WS_H + (size_t)T * 1024 * 2;
constexpr size_t WS_R2 = WS_R1 + SZ_BIG;
constexpr size_t WS_R3 = WS_R2 + SZ_BIG;
constexpr size_t WS_BAR = WS_R3 + SZ_BIG;
constexpr size_t WS_END = WS_BAR + 16384;

constexpr size_t O_Y = 0;
constexpr size_t O_POOL_P = (size_t)T * 1024;
constexpr size_t O_CONV_P = O_POOL_P + (size_t)16 * 15 * 2048;
constexpr size_t O_REC_P = O_CONV_P + (size_t)16 * 3 * 4096;
constexpr size_t O_POOL_S = O_REC_P + (size_t)16 * 16 * 16384;
constexpr size_t O_CONV_S = O_POOL_S + (size_t)32 * 15 * 2048;
constexpr size_t O_REC_S = O_CONV_S + (size_t)32 * 3 * 4096;

struct Params {
    const float* x_prompt; const float* x_sample; const float* c_prompt; const float* c_sample;
    const float* state_pool; const float* state_conv; const float* state_rec;
    const float* norm_gain; const float* ada_w; const float* ada_b;
    const float* pool_w_in; const float* pool_w_group; const float* pool_scale; const float* pool_w_out;
    const float* gdn_w_in; const float* gdn_conv_w; const float* gdn_a_log; const float* gdn_dt_bias; const float* gdn_norm_w; const float* gdn_w_out;
    const float* final_gain;
    float* out; unsigned char* ws;
};

__device__ __forceinline__ unsigned cvt_pk_bf16(float lo, float hi) { unsigned r; asm("v_cvt_pk_bf16_f32 %0, %1, %2" : "=v"(r) : "v"(lo), "v"(hi)); return r; }
typedef __bf16 bf16x2_t __attribute__((ext_vector_type(2)));
__device__ __forceinline__ unsigned cvt_pk_bf16_c(float lo, float hi) { const bf16x2_t v = {(__bf16)lo, (__bf16)hi}; return __builtin_bit_cast(unsigned, v); }
__device__ __forceinline__ float bf_lo(unsigned w) { return __uint_as_float(w << 16); }
__device__ __forceinline__ float bf_hi(unsigned w) { return __uint_as_float(w & 0xffff0000u); }
__device__ __forceinline__ float silu_f(float x) { return x * __builtin_amdgcn_rcpf(1.0f + __expf(-x)); }
__device__ __forceinline__ void unpack8(const u32x4 w, float (&f)[8]) { f[0] = bf_lo(w.x); f[1] = bf_hi(w.x); f[2] = bf_lo(w.y); f[3] = bf_hi(w.y); f[4] = bf_lo(w.z); f[5] = bf_hi(w.z); f[6] = bf_lo(w.w); f[7] = bf_hi(w.w); }
__device__ __forceinline__ u32x4 pack8c(const float (&f)[8]) { u32x4 w; w.x = cvt_pk_bf16_c(f[0], f[1]); w.y = cvt_pk_bf16_c(f[2], f[3]); w.z = cvt_pk_bf16_c(f[4], f[5]); w.w = cvt_pk_bf16_c(f[6], f[7]); return w; }
__device__ __forceinline__ u32x4 pack8(const float (&f)[8]) { u32x4 w; w.x = cvt_pk_bf16(f[0], f[1]); w.y = cvt_pk_bf16(f[2], f[3]); w.z = cvt_pk_bf16(f[4], f[5]); w.w = cvt_pk_bf16(f[6], f[7]); return w; }
__device__ __forceinline__ int seq_of_row(int row) { return row < TP ? (row >> 12) : 16 + ((row - TP) >> 6); }

__device__ __forceinline__ float dpp_sum16(float v) {
    v += __int_as_float(__builtin_amdgcn_update_dpp(0, __float_as_int(v), 0xB1, 0xF, 0xF, true));
    v += __int_as_float(__builtin_amdgcn_update_dpp(0, __float_as_int(v), 0x4E, 0xF, 0xF, true));
    v += __int_as_float(__builtin_amdgcn_update_dpp(0, __float_as_int(v), 0x141, 0xF, 0xF, true));
    v += __int_as_float(__builtin_amdgcn_update_dpp(0, __float_as_int(v), 0x140, 0xF, 0xF, true));
    return v;
}
#ifndef STAGGER_US
#define STAGGER_US 0
#endif
namespace pg8 {
constexpr int BM = 256, BK = 64, HALF = 128, HTB = HALF * BK * 2, STAGE_BYTES = 8 * HTB, NXCD = 8, WGM = 8;
__device__ __forceinline__ int lds_byte(int r, int c) { const int st = (r >> 4) * 2 + (c >> 5), rr = r & 15, cc = c & 31, ob = rr * 64 + cc * 2; return st * 1024 + (ob ^ (((ob >> 9) & 1) << 5)); }
__device__ __forceinline__ void stage_rc(int b, int& R, int& C) { const int st = b / 1024, sb = b % 1024, swz = sb ^ (((sb >> 9) & 1) << 5); R = (st >> 1) * 16 + swz / 64; C = (st & 1) * 32 + (swz % 64) / 2; }
__device__ __forceinline__ int perm32(int rho) { const int n = rho >> 4, i = rho & 15; return 8 * (i >> 2) + 4 * n + (i & 3); }
struct Unit { int pm, pn; };
struct Gemm { const bf16_t* A; const bf16_t* Bt; int M, N, K, lda, ldb, a_grp_div; long a_gstride; int pm_mask = 0xffff; };
struct StaticOrder {
    int nM, nN, nwg, G, c;
    __device__ void init(int M, int N, int G_, int c_) { nM = M / BM; nN = N / BM; nwg = nM * nN; G = G_; c = c_; }
    __device__ bool next(int i, Unit& u) const {
        const long L = (long)i * G + c; if (L >= nwg) return false;
        int wgid = (int)L; { const int q = nwg / NXCD, r = nwg % NXCD, xcd = wgid % NXCD, off = wgid / NXCD; wgid = (xcd < r ? xcd * (q + 1) : r * (q + 1) + (xcd - r) * q) + off; }
        const int nig = WGM * nN, gid = wgid / nig, fm = gid * WGM, gsz = (nM - fm) < WGM ? (nM - fm) : WGM;
        u.pm = fm + ((wgid % nig) % gsz); u.pn = (wgid % nig) / gsz; return true;
    }
};

template <class Epi>
__device__ __forceinline__ void gemm_phase(LAS unsigned char* lds, const Gemm g, const StaticOrder& S, const Epi& E) {
    const int tid = threadIdx.x, wid = __builtin_amdgcn_readfirstlane(tid >> 6), lane = tid & 63, wr = wid >> 2, wc = wid & 3, fr = lane & 15, fq = lane >> 4;
    const int K = g.K, nt = K / BK;
    unsigned voffA[2], voffB[2];
#pragma unroll
    for (int i = 0; i < 2; ++i) { int R, C; stage_rc(tid * 16 + i * 8192, R, C); const int Rb = Epi::PERM ? ((R & ~31) + perm32(R & 31)) : R;
        voffA[i] = (unsigned)(R * g.lda + C) * 2u; voffB[i] = (unsigned)(Rb * g.ldb + C) * 2u; }
    const size_t kstep = (size_t)(BK * 2);
    const size_t hsA = (size_t)HALF * g.lda * 2, hsB = (size_t)HALF * g.ldb * 2;
    const size_t tsA = 2 * hsA, tsB = 2 * hsB;
    const unsigned ldsw = (unsigned)wid * 1024u;
    const int aoff = lds_byte(wr * 64 + fr, fq * 8), boff = lds_byte(wc * 32 + fr, fq * 8);
#define PG8_SA(b, h) (((b) * 2 + (h)) * HTB)
#define PG8_SB(b, h) ((4 + (b) * 2 + (h)) * HTB)
#define PG8_STAGE(bufoff, gbase, voff) do { _Pragma("unroll") for (int _i = 0; _i < 2; ++_i) \
        __builtin_amdgcn_global_load_lds((const unsigned*)((const char*)(gbase) + (voff)[_i]), (LAS unsigned*)(lds + (bufoff) + ldsw + _i * 8192), 16, 0, 0); } while (0)
#define PG8_LDA(dst, b, h) do { _Pragma("unroll") for (int m = 0; m < 4; ++m) _Pragma("unroll") for (int k = 0; k < 2; ++k) dst[m][k] = *(const LAS bf16x8*)(lds + PG8_SA(b, h) + aoff + m * 2048 + k * 1024); } while (0)
#define PG8_LDB(dst, b, h) do { _Pragma("unroll") for (int n = 0; n < 2; ++n) _Pragma("unroll") for (int k = 0; k < 2; ++k) dst[n][k] = *(const LAS bf16x8*)(lds + PG8_SB(b, h) + boff + n * 2048 + k * 1024); } while (0)
#define PG8_MMA(ai, bj, At, Bt) do { __builtin_amdgcn_s_setprio(1); _Pragma("unroll") for (int m = 0; m < 4; ++m) _Pragma("unroll") for (int n = 0; n < 2; ++n) _Pragma("unroll") for (int k = 0; k < 2; ++k) \
        acc[ai][bj][m][n] = __builtin_amdgcn_mfma_f32_16x16x32_bf16(Bt[n][k], At[m][k], acc[ai][bj][m][n], 0, 0, 0); __builtin_amdgcn_s_setprio(0); } while (0)
#define PG8_WAIT_V(n) asm volatile("s_waitcnt vmcnt(" #n ")" ::: "memory")
#define PG8_WAIT_L(n) asm volatile("s_waitcnt lgkmcnt(" #n ")" ::: "memory")
#define PG8_BAR __builtin_amdgcn_s_barrier()
#define PG8_SCHED __builtin_amdgcn_sched_barrier(0)
#define PG8_APTR(u) ((const char*)g.A + (size_t)((u).pm & g.pm_mask) * tsA + (g.a_grp_div ? (size_t)((u).pn / g.a_grp_div) * (size_t)g.a_gstride : (size_t)0))
#define PG8_BPTR(u) ((const char*)g.Bt + (size_t)(u).pn * tsB)
    Unit cur, nxt; int ui = 0;
    if (!S.next(0, cur)) return;
    if (STAGGER_US > 0 && (S.c & 1)) { const unsigned long long t0_ = __builtin_amdgcn_s_memrealtime(), dl_ = (unsigned long long)(STAGGER_US * 100); while (__builtin_amdgcn_s_memrealtime() - t0_ < dl_) __builtin_amdgcn_s_sleep(8); }
    f32x4 acc[2][2][4][2];
#pragma unroll
    for (int a = 0; a < 2; ++a)
#pragma unroll
        for (int b = 0; b < 2; ++b)
#pragma unroll
            for (int m = 0; m < 4; ++m)
#pragma unroll
                for (int n = 0; n < 2; ++n) acc[a][b][m][n] = (f32x4){0.f, 0.f, 0.f, 0.f};
    bf16x8 At[4][2], B0[2][2], B1[2][2];
    const char* cA = PG8_APTR(cur); const char* cB = PG8_BPTR(cur);
    PG8_STAGE(PG8_SB(0, 0), cB, voffB); PG8_STAGE(PG8_SA(0, 0), cA, voffA); PG8_STAGE(PG8_SB(0, 1), cB + hsB, voffB); PG8_STAGE(PG8_SA(0, 1), cA + hsA, voffA);
    if (wr == 1) PG8_BAR;
    PG8_WAIT_V(4); PG8_BAR;
    PG8_STAGE(PG8_SB(1, 0), cB + kstep, voffB); PG8_STAGE(PG8_SA(1, 0), cA + kstep, voffA); PG8_STAGE(PG8_SB(1, 1), cB + hsB + kstep, voffB);
    PG8_WAIT_V(6); PG8_BAR;
    for (;;) {
        const bool has_next = S.next(ui + 1, nxt);
        const char* nA = has_next ? PG8_APTR(nxt) : cA; const char* nB = has_next ? PG8_BPTR(nxt) : cB;
        for (int t = 0; t < nt; t += 2) {
            const bool last = (t == nt - 2);
            const char* a1 = cA + (size_t)(t + 1) * kstep;
            const char* a2 = last ? nA : cA + (size_t)(t + 2) * kstep; const char* b2 = last ? nB : cB + (size_t)(t + 2) * kstep;
            const char* a3 = a2 + kstep; const char* b3 = b2 + kstep;
            PG8_LDB(B0, 0, 0); PG8_SCHED; PG8_LDA(At, 0, 0); PG8_STAGE(PG8_SA(1, 1), a1 + hsA, voffA);
            PG8_WAIT_L(8); PG8_BAR; PG8_WAIT_L(0); PG8_MMA(0, 0, At, B0); PG8_BAR; PG8_SCHED;
            PG8_LDB(B1, 0, 1); PG8_STAGE(PG8_SB(0, 0), b2, voffB);
            PG8_BAR; PG8_WAIT_L(0); PG8_MMA(0, 1, At, B1); PG8_BAR;
            PG8_LDA(At, 0, 1); PG8_STAGE(PG8_SA(0, 0), a2, voffA);
            PG8_BAR; PG8_WAIT_L(0); PG8_MMA(1, 0, At, B0); PG8_BAR; PG8_SCHED;
            PG8_STAGE(PG8_SB(0, 1), b2 + hsB, voffB);
            PG8_WAIT_V(6); PG8_BAR; PG8_MMA(1, 1, At, B1); PG8_BAR;
            PG8_LDB(B0, 1, 0); PG8_SCHED; PG8_LDA(At, 1, 0); PG8_STAGE(PG8_SA(0, 1), a2 + hsA, voffA);
            PG8_WAIT_L(8); PG8_BAR; PG8_WAIT_L(0); PG8_MMA(0, 0, At, B0); PG8_BAR; PG8_SCHED;
            PG8_LDB(B1, 1, 1); PG8_STAGE(PG8_SB(1, 0), b3, voffB);
            PG8_BAR; PG8_WAIT_L(0); PG8_MMA(0, 1, At, B1); PG8_BAR;
            PG8_LDA(At, 1, 1); PG8_STAGE(PG8_SA(1, 0), a3, voffA);
            PG8_BAR; PG8_WAIT_L(0); PG8_MMA(1, 0, At, B0); PG8_BAR; PG8_SCHED;
            PG8_STAGE(PG8_SB(1, 1), b3 + hsB, voffB);
            PG8_WAIT_V(6); PG8_BAR; PG8_MMA(1, 1, At, B1); PG8_BAR;
        }
        E(acc, cur, wr, wc, fr, fq);
        if (!has_next) break;
#pragma unroll
        for (int a = 0; a < 2; ++a)
#pragma unroll
            for (int b = 0; b < 2; ++b)
#pragma unroll
                for (int m = 0; m < 4; ++m)
#pragma unroll
                    for (int n = 0; n < 2; ++n) acc[a][b][m][n] = (f32x4){0.f, 0.f, 0.f, 0.f};
        cur = nxt; cA = nA; cB = nB; ++ui;
    }
    PG8_WAIT_V(0);
    if (wr == 0) PG8_BAR;
    PG8_BAR;
#undef PG8_SA
#undef PG8_SB
#undef PG8_STAGE
#undef PG8_LDA
#undef PG8_LDB
#undef PG8_MMA
#undef PG8_WAIT_V
#undef PG8_WAIT_L
#undef PG8_BAR
#undef PG8_SCHED
#undef PG8_APTR
#undef PG8_BPTR
}

struct EpiL0In {
    static constexpr bool PERM = true;
    bf16_t* U; bf16_t* SZ;
    __device__ __forceinline__ void operator()(const f32x4 (&acc)[2][2][4][2], const Unit& u, int wr, int wc, int fr, int fq) const {
        const int row0 = u.pm * BM + wr * 64 + fr; const bool isz = u.pn >= 8;
        bf16_t* base = isz ? SZ : U; const int col0 = (isz ? u.pn - 8 : u.pn) * BM + wc * 32 + 8 * fq;
#pragma unroll
        for (int ai = 0; ai < 2; ++ai)
#pragma unroll
            for (int m = 0; m < 4; ++m) { bf16_t* rowp = base + (size_t)(row0 + ai * HALF + m * 16) * 2048 + col0;
#pragma unroll
                for (int bj = 0; bj < 2; ++bj) { f32x4 v0 = acc[ai][bj][m][0], v1 = acc[ai][bj][m][1];
                    if (isz) {
#pragma unroll
                        for (int j = 0; j < 4; ++j) { v0[j] = silu_f(v0[j]); v1[j] = silu_f(v1[j]); } }
                    u32x4 w; w.x = cvt_pk_bf16_c(v0[0], v0[1]); w.y = cvt_pk_bf16_c(v0[2], v0[3]); w.z = cvt_pk_bf16_c(v1[0], v1[1]); w.w = cvt_pk_bf16_c(v1[2], v1[3]);
                    __builtin_nontemporal_store(w, (u32x4*)(rowp + bj * HALF)); } }
    }
};
struct EpiGrp {
    static constexpr bool PERM = true;
    bf16_t* YY; const bf16_t* SZ; const float* scale;
    __device__ __forceinline__ void operator()(const f32x4 (&acc)[2][2][4][2], const Unit& u, int wr, int wc, int fr, int fq) const {
        const int row0 = u.pm * BM + wr * 64 + fr; const int col0 = u.pn * BM + wc * 32 + 8 * fq;
        f32x4 sc[2][2];
#pragma unroll
        for (int bj = 0; bj < 2; ++bj) { sc[bj][0] = *(const f32x4*)(scale + col0 + bj * HALF); sc[bj][1] = *(const f32x4*)(scale + col0 + bj * HALF + 4); }
#pragma unroll
        for (int ai = 0; ai < 2; ++ai) {
            u32x4 zz[4][2];
#pragma unroll
            for (int m = 0; m < 4; ++m)
#pragma unroll
                for (int bj = 0; bj < 2; ++bj) zz[m][bj] = *(const u32x4*)(SZ + (size_t)(row0 + ai * HALF + m * 16) * 2048 + col0 + bj * HALF);
#pragma unroll
            for (int m = 0; m < 4; ++m) { const size_t off = (size_t)(row0 + ai * HALF + m * 16) * 2048 + col0;
#pragma unroll
                for (int bj = 0; bj < 2; ++bj) { float zf[8]; unpack8(zz[m][bj], zf);
                    const f32x4 v0 = acc[ai][bj][m][0] * sc[bj][0], v1 = acc[ai][bj][m][1] * sc[bj][1];
                    u32x4 w; w.x = cvt_pk_bf16_c(v0[0] * zf[0], v0[1] * zf[1]); w.y = cvt_pk_bf16_c(v0[2] * zf[2], v0[3] * zf[3]); w.z = cvt_pk_bf16_c(v1[0] * zf[4], v1[1] * zf[5]); w.w = cvt_pk_bf16_c(v1[2] * zf[6], v1[3] * zf[7]);
                    __builtin_nontemporal_store(w, (u32x4*)(YY + off + bj * HALF)); } } }
    }
};
template <bool BASE_BF16> struct EpiRes {
    static constexpr bool PERM = true;
    const float* base_lo; const float* base_hi; const bf16_t* base_b; bf16_t* OUT; const float* gate;
    __device__ __forceinline__ void operator()(const f32x4 (&acc)[2][2][4][2], const Unit& u, int wr, int wc, int fr, int fq) const {
        const int row0 = u.pm * BM + wr * 64 + fr, col0 = u.pn * BM + wc * 32 + 8 * fq;
#pragma unroll
        for (int ai = 0; ai < 2; ++ai) {
            const float* gp = gate + (size_t)seq_of_row(u.pm * BM + ai * HALF + wr * 64) * 3072 + col0;
            f32x4 gv[2][2];
#pragma unroll
            for (int bj = 0; bj < 2; ++bj) { gv[bj][0] = *(const f32x4*)(gp + bj * HALF); gv[bj][1] = *(const f32x4*)(gp + bj * HALF + 4); }
            u32x4 bb[4][2]; f32x4 fb[4][2][2];
            if (!BASE_BF16) {
#pragma unroll
                for (int m = 0; m < 4; ++m) { const int row = row0 + ai * HALF + m * 16; const float* bp = (row < TP ? base_lo + (size_t)row * 1024 : base_hi + (size_t)(row - TP) * 1024) + col0;
#pragma unroll
                    for (int bj = 0; bj < 2; ++bj) { fb[m][bj][0] = *(const f32x4*)(bp + bj * HALF); fb[m][bj][1] = *(const f32x4*)(bp + bj * HALF + 4); } } }
            if (BASE_BF16) {
#pragma unroll
                for (int m = 0; m < 4; ++m)
#pragma unroll
                    for (int bj = 0; bj < 2; ++bj) bb[m][bj] = *(const u32x4*)(base_b + (size_t)(row0 + ai * HALF + m * 16) * 1024 + col0 + bj * HALF); }
#pragma unroll
            for (int m = 0; m < 4; ++m) { const int row = row0 + ai * HALF + m * 16; bf16_t* op = OUT + (size_t)row * 1024 + col0;
#pragma unroll
                for (int bj = 0; bj < 2; ++bj) { float bs[8];
                    if (BASE_BF16) unpack8(bb[m][bj], bs);
                    else { const f32x4 b0 = fb[m][bj][0], b1 = fb[m][bj][1];
                        bs[0] = b0[0]; bs[1] = b0[1]; bs[2] = b0[2]; bs[3] = b0[3]; bs[4] = b1[0]; bs[5] = b1[1]; bs[6] = b1[2]; bs[7] = b1[3]; }
                    const f32x4 v0 = acc[ai][bj][m][0] * gv[bj][0], v1 = acc[ai][bj][m][1] * gv[bj][1];
                    u32x4 w; w.x = cvt_pk_bf16_c(bs[0] + v0[0], bs[1] + v0[1]); w.y = cvt_pk_bf16_c(bs[2] + v0[2], bs[3] + v0[3]); w.z = cvt_pk_bf16_c(bs[4] + v1[0], bs[5] + v1[1]); w.w = cvt_pk_bf16_c(bs[6] + v1[2], bs[7] + v1[3]);
                    __builtin_nontemporal_store(w, (u32x4*)(op + bj * HALF)); } } }
    }
};
struct EpiL1In {
    static constexpr bool PERM = true;
    bf16_t* QKV; bf16_t* STASH; float* AB;
    __device__ __forceinline__ void operator()(const f32x4 (&acc)[2][2][4][2], const Unit& u, int wr, int wc, int fr, int fq) const {
        const int row0 = u.pm * BM + wr * 64 + fr;
        if (u.pn < 16) {
            const int col0 = u.pn * BM + wc * 32 + 8 * fq;
#pragma unroll
            for (int ai = 0; ai < 2; ++ai)
#pragma unroll
                for (int m = 0; m < 4; ++m) { const int row = row0 + ai * HALF + m * 16; bf16_t* rowp = QKV + (size_t)row * 4096 + col0; const int rl = row & 63;
#pragma unroll
                    for (int bj = 0; bj < 2; ++bj) { const f32x4 v0 = acc[ai][bj][m][0], v1 = acc[ai][bj][m][1];
                        u32x4 w; w.x = cvt_pk_bf16_c(v0[0], v0[1]); w.y = cvt_pk_bf16_c(v0[2], v0[3]); w.z = cvt_pk_bf16_c(v1[0], v1[1]); w.w = cvt_pk_bf16_c(v1[2], v1[3]);
                        __builtin_nontemporal_store(w, (u32x4*)(rowp + bj * HALF));
                        if (rl >= 61) *(u32x4*)(STASH + ((size_t)(row >> 6) * 3 + (rl - 61)) * 4096 + col0 + bj * HALF) = w; } }
        } else if (wc == 0) {
#pragma unroll
            for (int ai = 0; ai < 2; ++ai)
#pragma unroll
                for (int m = 0; m < 4; ++m) { const int row = row0 + ai * HALF + m * 16; float* rowp = AB + (size_t)row * 32 + 8 * fq;
                    *(f32x4*)(rowp) = acc[ai][0][m][0]; *(f32x4*)(rowp + 4) = acc[ai][0][m][1]; }
        }
    }
};
struct EpiZ {
    static constexpr bool PERM = true;
    bf16_t* QKV;
    __device__ __forceinline__ void operator()(const f32x4 (&acc)[2][2][4][2], const Unit& u, int wr, int wc, int fr, int fq) const {
        const int row0 = u.pm * BM + wr * 64 + fr; const int col0 = 2048 + u.pn * BM + wc * 32 + 8 * fq;
#pragma unroll
        for (int ai = 0; ai < 2; ++ai) {
            u32x4 oo[4][2];
#pragma unroll
            for (int m = 0; m < 4; ++m)
#pragma unroll
                for (int bj = 0; bj < 2; ++bj) oo[m][bj] = *(const u32x4*)(QKV + (size_t)(row0 + ai * HALF + m * 16) * 4096 + col0 + bj * HALF);
#pragma unroll
            for (int m = 0; m < 4; ++m) { bf16_t* rowp = QKV + (size_t)(row0 + ai * HALF + m * 16) * 4096 + col0;
#pragma unroll
                for (int bj = 0; bj < 2; ++bj) { float of[8]; unpack8(oo[m][bj], of);
                    const f32x4 v0 = acc[ai][bj][m][0], v1 = acc[ai][bj][m][1];
                    u32x4 w; w.x = cvt_pk_bf16_c(of[0] * silu_f(v0[0]), of[1] * silu_f(v0[1])); w.y = cvt_pk_bf16_c(of[2] * silu_f(v0[2]), of[3] * silu_f(v0[3]));
                    w.z = cvt_pk_bf16_c(of[4] * silu_f(v1[0]), of[5] * silu_f(v1[1])); w.w = cvt_pk_bf16_c(of[6] * silu_f(v1[2]), of[7] * silu_f(v1[3]));
                    __builtin_nontemporal_store(w, (u32x4*)(rowp + bj * HALF)); } } }
    }
};
struct EpiNull {
    static constexpr bool PERM = true;
    float* sink;
    __device__ __forceinline__ void operator()(const f32x4 (&acc)[2][2][4][2], const Unit& u, int wr, int wc, int fr, int fq) const {
        float t = 0.f;
#pragma unroll
        for (int ai = 0; ai < 2; ++ai)
#pragma unroll
            for (int bj = 0; bj < 2; ++bj)
#pragma unroll
                for (int m = 0; m < 4; ++m)
#pragma unroll
                    for (int n = 0; n < 2; ++n) t += acc[ai][bj][m][n][0] + acc[ai][bj][m][n][1] + acc[ai][bj][m][n][2] + acc[ai][bj][m][n][3];
        if (t == 12345.678f) sink[0] = t;
    }
};
}

__device__ void transpose_tile(const float* src, int ld_src, int k0, int ncol0, int ncols_valid, bf16_t* dst, int ld_dst, int dst_row0, float* tile) {
    const int tid = threadIdx.x;
    { const int r = tid >> 4, c4 = (tid & 15) * 4;
#pragma unroll
        for (int i = 0; i < 2; ++i) { const int row = r + 32 * i; f32x4 v = (f32x4){0.f, 0.f, 0.f, 0.f};
            if (ncol0 + c4 < ncols_valid) v = *(const f32x4*)(src + (size_t)(k0 + row) * ld_src + ncol0 + c4);
            tile[row * 65 + c4 + 0] = v[0]; tile[row * 65 + c4 + 1] = v[1]; tile[row * 65 + c4 + 2] = v[2]; tile[row * 65 + c4 + 3] = v[3]; } }
    __syncthreads();
    { const int n = tid >> 3, k8 = (tid & 7) * 8; float f[8];
#pragma unroll
        for (int j = 0; j < 8; ++j) f[j] = tile[(k8 + j) * 65 + n];
        *(u32x4*)(dst + (size_t)(dst_row0 + n) * ld_dst + k0 + k8) = pack8(f); }
    __syncthreads();
}
__device__ void phase_prep(const Params& p, unsigned char* lds_g) {
    float* tile = (float*)lds_g;
    bf16_t* W1t = (bf16_t*)(p.ws + WS_W1T); bf16_t* Wgt = (bf16_t*)(p.ws + WS_WGT); bf16_t* W2t = (bf16_t*)(p.ws + WS_W2T); bf16_t* W3t = (bf16_t*)(p.ws + WS_W3T); bf16_t* W4t = (bf16_t*)(p.ws + WS_W4T);
    float* mod = (float*)(p.ws + WS_MOD);
    const int tid = threadIdx.x;
    constexpr int N_MOD = 256, N_W1 = 1024, N_WG = 256, N_W2 = 512, N_W3 = 1600, N_W4 = 512, N_ALL = N_MOD + N_W1 + N_WG + N_W2 + N_W3 + N_W4;
    for (int it = blockIdx.x; it < N_ALL; it += gridDim.x) {
        int i = it;
        if (i < N_MOD) {
            const int colchunk = i & 63, rg = i >> 6; const int cl = tid % 96, ksl = tid / 96; const int col = colchunk * 96 + cl, layer = col / 3072, cc = col % 3072;
            for (int idx = tid; idx < 12288; idx += NT) { const int k = idx / 12, r = idx % 12, row = rg * 12 + r;
                const float cv = row < 16 ? p.c_prompt[row * 1024 + k] : p.c_sample[(row - 16) * 1024 + k]; tile[idx] = silu_f(cv); }
            __syncthreads();
            float a[12];
#pragma unroll
            for (int r = 0; r < 12; ++r) a[r] = 0.f;
            if (ksl < 4) {
                const float* wp = p.ada_w + (size_t)layer * 1024 * 3072 + (size_t)(ksl * 256) * 3072 + cc; const float* tp = tile + ksl * 256 * 12;
#pragma unroll 16
                for (int k = 0; k < 256; ++k) { const float w = wp[(size_t)k * 3072]; const f32x4 s0 = *(const f32x4*)(tp + k * 12), s1 = *(const f32x4*)(tp + k * 12 + 4), s2 = *(const f32x4*)(tp + k * 12 + 8);
                    a[0] += w * s0[0]; a[1] += w * s0[1]; a[2] += w * s0[2]; a[3] += w * s0[3]; a[4] += w * s1[0]; a[5] += w * s1[1]; a[6] += w * s1[2]; a[7] += w * s1[3]; a[8] += w * s2[0]; a[9] += w * s2[1]; a[10] += w * s2[2]; a[11] += w * s2[3]; }
            }
            __syncthreads();
            if (ksl < 4) {
#pragma unroll
                for (int r = 0; r < 12; ++r) tile[(ksl * 12 + r) * 96 + cl] = a[r]; }
            __syncthreads();
            if (tid < 96) { const float bias = p.ada_b[layer * 3072 + cc];
#pragma unroll
                for (int r = 0; r < 12; ++r) mod[((size_t)layer * 48 + rg * 12 + r) * 3072 + cc] = tile[r * 96 + tid] + tile[(12 + r) * 96 + tid] + tile[(24 + r) * 96 + tid] + tile[(36 + r) * 96 + tid] + bias; }
            __syncthreads();
            continue;
        }
        i -= N_MOD;
        if (i < N_W1) { const int kt = i & 15, ntile = i >> 4; transpose_tile(p.pool_w_in, 4096, kt * 64, ntile * 64, 4096, W1t, 1024, ntile * 64, tile); continue; }
        i -= N_W1;
        if (i < N_WG) { const int g = i >> 6, r = i & 63, kt = r & 7, ntile = r >> 3; transpose_tile(p.pool_w_group + (size_t)g * 512 * 512, 512, kt * 64, ntile * 64, 512, Wgt + (size_t)g * 512 * 512, 512, ntile * 64, tile); continue; }
        i -= N_WG;
        if (i < N_W2) { const int kt = i & 31, ntile = i >> 5; transpose_tile(p.pool_w_out, 1024, kt * 64, ntile * 64, 1024, W2t, 2048, ntile * 64, tile); continue; }
        i -= N_W2;
        if (i < N_W3) { const int kt = i & 15, ntile = i >> 4; const int n0 = ntile * 64;
            const int src0 = n0 < 4096 ? n0 : (n0 < 4352 ? 6144 + (n0 - 4096) : 4096 + (n0 - 4352));
            const int valid = (n0 >= 4096 && n0 < 4352) ? 6176 : 1 << 30;
            transpose_tile(p.gdn_w_in, 6176, kt * 64, src0, valid, W3t, 1024, n0, tile); continue; }
        i -= N_W3;
        { const int kt = i & 31, ntile = i >> 5; transpose_tile(p.gdn_w_out, 1024, kt * 64, ntile * 64, 1024, W4t, 2048, ntile * 64, tile); }
    }
}

constexpr int NR = 6;
__device__ void phase_norm_mod(const float* x_lo, const float* x_hi, const float* gain, const float* modl, bf16_t* H) {
    const int lane = threadIdx.x & 63, wid = threadIdx.x >> 6;
    for (int rp = blockIdx.x * 8 + wid; rp < T / NR; rp += gridDim.x * 8) {
        f32x4 v[NR][4]; float ss[NR];
#pragma unroll
        for (int q = 0; q < NR; ++q) { const int row = rp * NR + q; const float* xr = row < TP ? x_lo + (size_t)row * 1024 : x_hi + (size_t)(row - TP) * 1024;
#pragma unroll
            for (int j = 0; j < 4; ++j) v[q][j] = __builtin_nontemporal_load((const f32x4*)(xr + j * 256 + lane * 4)); }
#pragma unroll
        for (int q = 0; q < NR; ++q) { float a = 0.f;
#pragma unroll
            for (int j = 0; j < 4; ++j) a += v[q][j][0] * v[q][j][0] + v[q][j][1] * v[q][j][1] + v[q][j][2] * v[q][j][2] + v[q][j][3] * v[q][j][3];
#pragma unroll
            for (int o = 32; o >= 1; o >>= 1) a += __shfl_xor(a, o);
            ss[q] = a; }
#pragma unroll
        for (int q = 0; q < NR; ++q) { const int row = rp * NR + q; const float r = rsqrtf(ss[q] * (1.0f / 1024.0f) + EPS);
            const float* ms = modl + (size_t)seq_of_row(row) * 3072;
#pragma unroll
            for (int j = 0; j < 4; ++j) { const int c = j * 256 + lane * 4; const f32x4 gn = *(const f32x4*)(gain + c), sh = *(const f32x4*)(ms + c), sc = *(const f32x4*)(ms + 1024 + c);
                const f32x4 o = v[q][j] * r * gn * (sc + 1.0f) + sh; u32x2 w; w.x = cvt_pk_bf16(o[0], o[1]); w.y = cvt_pk_bf16(o[2], o[3]); *(u32x2*)(H + (size_t)row * 1024 + c) = w; } }
    }
}
template <int MODE>
__device__ void phase_norm_b(const bf16_t* X, const float* gain, const float* modl, bf16_t* H, float* out) {
    constexpr int NRB = 8;
    const int lane = threadIdx.x & 63, wid = threadIdx.x >> 6;
    for (int rp = blockIdx.x * 8 + wid; rp < T / NRB; rp += gridDim.x * 8) {
        u32x4 raw[NRB][2]; float ss[NRB];
#pragma unroll
        for (int q = 0; q < NRB; ++q) { const bf16_t* xr = X + (size_t)(rp * NRB + q) * 1024;
#pragma unroll
            for (int j = 0; j < 2; ++j) raw[q][j] = __builtin_nontemporal_load((const u32x4*)(xr + j * 512 + lane * 8)); }
#pragma unroll
        for (int q = 0; q < NRB; ++q) { float a = 0.f;
#pragma unroll
            for (int j = 0; j < 2; ++j) { float f[8]; unpack8(raw[q][j], f);
#pragma unroll
                for (int e = 0; e < 8; ++e) a += f[e] * f[e]; }
#pragma unroll
            for (int o = 32; o >= 1; o >>= 1) a += __shfl_xor(a, o);
            ss[q] = a; }
#pragma unroll
        for (int q = 0; q < NRB; ++q) { const int row = rp * NRB + q; const float r = rsqrtf(ss[q] * (1.0f / 1024.0f) + EPS);
#pragma unroll
            for (int j = 0; j < 2; ++j) { const int c = j * 512 + lane * 8; float f[8], o[8]; unpack8(raw[q][j], f);
                const f32x4 g0 = *(const f32x4*)(gain + c), g1 = *(const f32x4*)(gain + c + 4);
                if (MODE == 0) { const float* ms = modl + (size_t)seq_of_row(row) * 3072; const f32x4 sh0 = *(const f32x4*)(ms + c), sh1 = *(const f32x4*)(ms + c + 4), sc0 = *(const f32x4*)(ms + 1024 + c), sc1 = *(const f32x4*)(ms + 1024 + c + 4);
#pragma unroll
                    for (int e = 0; e < 4; ++e) { o[e] = f[e] * r * g0[e] * (sc0[e] + 1.0f) + sh0[e]; o[4 + e] = f[4 + e] * r * g1[e] * (sc1[e] + 1.0f) + sh1[e]; }
                    *(u32x4*)(H + (size_t)row * 1024 + c) = pack8(o); }
                else { __builtin_nontemporal_store((f32x4){f[0] * r * g0[0], f[1] * r * g0[1], f[2] * r * g0[2], f[3] * r * g0[3]}, (f32x4*)(out + (size_t)row * 1024 + c));
                    __builtin_nontemporal_store((f32x4){f[4] * r * g1[0], f[5] * r * g1[1], f[6] * r * g1[2], f[7] * r * g1[3]}, (f32x4*)(out + (size_t)row * 1024 + c + 4)); } }
        }
    }
}

struct SeqInfo { int sq, lc, seq_t0; bool sample, last; };
__device__ __forceinline__ SeqInfo chunk_info(int chunk) { SeqInfo s; if (chunk < 1024) { s.sq = chunk >> 6; s.lc = chunk & 63; s.seq_t0 = s.sq * 4096; s.sample = false; s.last = (s.lc == 63); } else { const int cs = chunk - 1024; s.sq = 16 + cs; s.lc = 0; s.seq_t0 = TP + cs * 64; s.sample = true; s.last = true; } return s; }
__device__ __forceinline__ void pool_fetch(const bf16_t* U, const float* spool, const SeqInfo& si, int pos, int c, float (&f)[8]) {
    if (pos >= 0) { const u32x4 w = *(const u32x4*)(U + (size_t)(si.seq_t0 + pos) * 2048 + c); unpack8(w, f); }
    else if (si.sample) { const float* sp = spool + ((size_t)(si.sq - 16) * 15 + 15 + pos) * 2048 + c; const f32x4 a = *(const f32x4*)sp, b = *(const f32x4*)(sp + 4);
        f[0] = a[0]; f[1] = a[1]; f[2] = a[2]; f[3] = a[3]; f[4] = b[0]; f[5] = b[1]; f[6] = b[2]; f[7] = b[3]; }
    else {
#pragma unroll
        for (int j = 0; j < 8; ++j) f[j] = 0.f; }
}
template <int W>
__device__ __forceinline__ void pool_fast(const Params& p, const bf16_t* U, bf16_t* D, const SeqInfo& si, int g, int col8, int rs) {
    const int c = g * 512 + col8 * 8; const int p0 = si.lc * 64 + rs * 8;
    u32x4 raw[W + 7];
#pragma unroll
    for (int k = 0; k < W + 7; ++k) { const int pos = p0 - (W - 1) + k; raw[k] = pos >= 0 ? *(const u32x4*)(U + (size_t)(si.seq_t0 + pos) * 2048 + c) : (u32x4){0u, 0u, 0u, 0u}; }
    float s[8], cur[8], old[8];
#pragma unroll
    for (int j = 0; j < 8; ++j) s[j] = 0.f;
#pragma unroll
    for (int k = 0; k < W - 1; ++k) { unpack8(raw[k], cur);
#pragma unroll
        for (int j = 0; j < 8; ++j) s[j] += cur[j]; }
#pragma unroll
    for (int i = 0; i < 8; ++i) { const int pos = p0 + i; unpack8(raw[W - 1 + i], cur);
        if (i > 0) { unpack8(raw[i - 1], old);
#pragma unroll
            for (int j = 0; j < 8; ++j) s[j] -= old[j]; }
#pragma unroll
        for (int j = 0; j < 8; ++j) s[j] += cur[j];
        const float inv = 1.0f / fminf((float)(pos + 1), (float)W);
        float d[8];
#pragma unroll
        for (int j = 0; j < 8; ++j) d[j] = s[j] * inv - cur[j];
        *(u32x4*)(D + (size_t)(si.seq_t0 + pos) * 2048 + c) = pack8(d);
        const int rl = rs * 8 + i;
        if (si.last && rl >= 49) { float* op = p.out + O_POOL_P + ((size_t)si.sq * 15 + (rl - 49)) * 2048 + c;
            *(f32x4*)op = (f32x4){cur[0], cur[1], cur[2], cur[3]}; *(f32x4*)(op + 4) = (f32x4){cur[4], cur[5], cur[6], cur[7]}; }
    }
}
__device__ void phase_pool(const Params& p) {
    const bf16_t* U = (const bf16_t*)(p.ws + WS_R1); bf16_t* D = (bf16_t*)(p.ws + WS_R3);
    const int tid = threadIdx.x, col8 = tid & 63, rs = tid >> 6;
    for (int it = blockIdx.x; it < NCHUNK * 4; it += gridDim.x) {
        const int chunk = it >> 2, g = it & 3, w = 2 << g; const SeqInfo si = chunk_info(chunk);
        if (!si.sample) {
            if (g == 0) pool_fast<2>(p, U, D, si, g, col8, rs); else if (g == 1) pool_fast<4>(p, U, D, si, g, col8, rs); else if (g == 2) pool_fast<8>(p, U, D, si, g, col8, rs); else pool_fast<16>(p, U, D, si, g, col8, rs);
            continue;
        }
        const int c = g * 512 + col8 * 8; const int p0 = si.lc * 64 + rs * 8;
        float s[8], cur[8], old[8];
#pragma unroll
        for (int j = 0; j < 8; ++j) s[j] = 0.f;
        for (int q = p0 - w + 1; q < p0; ++q) { pool_fetch(U, p.state_pool, si, q, c, cur);
#pragma unroll
            for (int j = 0; j < 8; ++j) s[j] += cur[j]; }
#pragma unroll 1
        for (int i = 0; i < 8; ++i) { const int pos = p0 + i;
            pool_fetch(U, p.state_pool, si, pos, c, cur);
            if (i > 0) { pool_fetch(U, p.state_pool, si, pos - w, c, old);
#pragma unroll
                for (int j = 0; j < 8; ++j) s[j] -= old[j]; }
#pragma unroll
            for (int j = 0; j < 8; ++j) s[j] += cur[j];
            const float inv = 1.0f / (float)w;
            float d[8];
#pragma unroll
            for (int j = 0; j < 8; ++j) d[j] = s[j] * inv - cur[j];
            *(u32x4*)(D + (size_t)(si.seq_t0 + pos) * 2048 + c) = pack8(d);
            const int rl = rs * 8 + i;
            if (rl >= 49) { float* op = p.out + O_POOL_S + ((size_t)(si.sq - 16) * 15 + (rl - 49)) * 2048 + c;
                *(f32x4*)op = (f32x4){cur[0], cur[1], cur[2], cur[3]}; *(f32x4*)(op + 4) = (f32x4){cur[4], cur[5], cur[6], cur[7]}; }
        }
    }
}

__device__ void phase_conv(const Params& p) {
    bf16_t* QKV = (bf16_t*)(p.ws + WS_R1); const bf16_t* STASH = (const bf16_t*)(p.ws + WS_STASH); const float* AB = (const float*)(p.ws + WS_AB);
    float* GC = (float*)(p.ws + WS_GC); float* BETA = (float*)(p.ws + WS_BETA);
    const int tid = threadIdx.x, stream = tid >> 7, ct = tid & 127, lane = tid & 63, wid = tid >> 6;
    const int qt = blockIdx.x & 3;
    const int ch = qt * 1024 + ct * 8; const int r0 = stream * 16;
    float wv[4][8];
#pragma unroll
    for (int t = 0; t < 4; ++t) { const f32x4 a = *(const f32x4*)(p.gdn_conv_w + t * 4096 + ch), b = *(const f32x4*)(p.gdn_conv_w + t * 4096 + ch + 4);
        wv[t][0] = a[0]; wv[t][1] = a[1]; wv[t][2] = a[2]; wv[t][3] = a[3]; wv[t][4] = b[0]; wv[t][5] = b[1]; wv[t][6] = b[2]; wv[t][7] = b[3]; }
    u32x4 nx[16], nh[3];
#define CONV_LOADX(it_, lo_) do { const size_t t0_ = (size_t)((it_) >> 2) * 64; \
        _Pragma("unroll") for (int i_ = (lo_); i_ < (lo_) + 8; ++i_) nx[i_] = *(const u32x4*)(QKV + (t0_ + r0 + i_) * 4096 + ch); } while (0)
#define CONV_LOADH(it_) do { const int chunk_ = (it_) >> 2; const SeqInfo si_ = chunk_info(chunk_); const size_t t0_ = (size_t)chunk_ * 64; \
        if (stream > 0) { _Pragma("unroll") for (int j_ = 0; j_ < 3; ++j_) nh[j_] = *(const u32x4*)(QKV + (t0_ + r0 - 3 + j_) * 4096 + ch); } \
        else if (si_.lc > 0) { _Pragma("unroll") for (int j_ = 0; j_ < 3; ++j_) nh[j_] = *(const u32x4*)(STASH + ((size_t)(chunk_ - 1) * 3 + j_) * 4096 + ch); } \
        else { _Pragma("unroll") for (int j_ = 0; j_ < 3; ++j_) nh[j_] = (u32x4){0u, 0u, 0u, 0u}; } } while (0)
    if ((int)blockIdx.x < NCHUNK * 4) { CONV_LOADH((int)blockIdx.x); CONV_LOADX((int)blockIdx.x, 0); CONV_LOADX((int)blockIdx.x, 8); }
    for (int it = blockIdx.x; it < NCHUNK * 4; it += gridDim.x) {
        const int chunk = it >> 2; const SeqInfo si = chunk_info(chunk); const int t0 = chunk * 64;
        const int nit = it + (int)gridDim.x; const bool has_next = nit < NCHUNK * 4;
        __syncthreads();
        float h0[8], h1[8], h2[8];
        unpack8(nh[0], h0); unpack8(nh[1], h1); unpack8(nh[2], h2);
        if (stream == 0 && si.lc == 0 && si.sample) { const float* sp = p.state_conv + (size_t)(si.sq - 16) * 3 * 4096 + ch;
#pragma unroll
            for (int j = 0; j < 8; ++j) { h0[j] = sp[j]; h1[j] = sp[4096 + j]; h2[j] = sp[8192 + j]; } }
        if (has_next) CONV_LOADH(nit);
#pragma unroll
        for (int i = 0; i < 16; ++i) {
            bf16_t* rp = QKV + (size_t)(t0 + r0 + i) * 4096 + ch; float x[8], o[8]; unpack8(nx[i], x);
            float ss = 0.f;
#pragma unroll
            for (int j = 0; j < 8; ++j) { const float cv = wv[0][j] * h0[j] + wv[1][j] * h1[j] + wv[2][j] * h2[j] + wv[3][j] * x[j]; o[j] = silu_f(cv); ss += o[j] * o[j]; h0[j] = h1[j]; h1[j] = h2[j]; h2[j] = x[j]; }
            if (qt < 2) { ss = dpp_sum16(ss);
                const float sc = rsqrtf(ss + EPS) * (qt == 0 ? 0.08838834764831845f : 1.0f);
#pragma unroll
                for (int j = 0; j < 8; ++j) o[j] *= sc; }
            *(u32x4*)rp = pack8c(o);
            if (si.last && stream == 3 && i >= 13) { float* op = p.out + (si.sample ? O_CONV_S + ((size_t)(si.sq - 16) * 3 + (i - 13)) * 4096 : O_CONV_P + ((size_t)si.sq * 3 + (i - 13)) * 4096) + ch;
                *(f32x4*)op = (f32x4){x[0], x[1], x[2], x[3]}; *(f32x4*)(op + 4) = (f32x4){x[4], x[5], x[6], x[7]}; }
            if (i == 7 && has_next) CONV_LOADX(nit, 0);
            if (i == 15 && has_next) CONV_LOADX(nit, 8);
        }
        if (wid < 4) {
            { const int h = qt * 4 + wid; const float a = AB[(size_t)(t0 + lane) * 32 + h], b = AB[(size_t)(t0 + lane) * 32 + 16 + h];
                const float xx = a + p.gdn_dt_bias[h]; const float sp = xx > 20.f ? xx : log1pf(expf(xx)); float g = -expf(p.gdn_a_log[h]) * sp;
#pragma unroll
                for (int o = 1; o < 64; o <<= 1) { const float t = __shfl_up(g, o); if (lane >= o) g += t; }
                GC[((size_t)chunk * 16 + h) * 64 + lane] = g; BETA[((size_t)chunk * 16 + h) * 64 + lane] = 1.0f / (1.0f + expf(-b)); }
        }
    }
#undef CONV_LOADX
#undef CONV_LOADH
}

__device__ void phase_j1(const Params& p, unsigned char* lds_g) {
    const bf16_t* QKV = (const bf16_t*)(p.ws + WS_R1); const float* GC = (const float*)(p.ws + WS_GC); const float* BETA = (const float*)(p.ws + WS_BETA);
    bf16_t* AH = (bf16_t*)(p.out + O_Y); bf16_t* AQK = AH + (size_t)NCHUNK * 16 * 4096;
    const int lane = threadIdx.x & 63, wid = threadIdx.x >> 6, c = lane & 15, q4 = lane >> 4;
    LAS unsigned char* Wl = (LAS unsigned char*)lds_g + wid * 18432;
    LAS float* Ld = (LAS float*)Wl;
    LAS bf16_t* Lb = (LAS bf16_t*)(Wl + 5120);
    LAS bf16_t* TT = (LAS bf16_t*)(Wl + 5120 + 4992);
    LAS bf16_t* Dm = (LAS bf16_t*)(Wl + 5120 + 9984);
#define J1_SYNC() asm volatile("s_waitcnt lgkmcnt(0)" ::: "memory")
#define J1_A_L(i_, j_) ({ const u32x2 a_ = *(const LAS u32x2*)(Lb + (16 * ((i_) - 1) + c) * 52 + 16 * (j_) + 4 * q4); u32x4 w_; w_.x = a_.x; w_.y = a_.y; w_.z = 0u; w_.w = 0u; __builtin_bit_cast(bf16x8, w_); })
#define J1_A_D(i_) ({ const u32x2 a_ = *(const LAS u32x2*)(Dm + (((i_) - 1) * 16 + c) * 20 + 4 * q4); u32x4 w_; w_.x = a_.x; w_.y = a_.y; w_.z = 0u; w_.w = 0u; __builtin_bit_cast(bf16x8, w_); })
#define J1_B_T(kb_, nb_) ({ const u32x2 a_ = *(const LAS u32x2*)(TT + (16 * (nb_) + c) * 52 + 16 * (kb_) + 4 * q4); u32x4 w_; w_.x = a_.x; w_.y = a_.y; w_.z = 0u; w_.w = 0u; __builtin_bit_cast(bf16x8, w_); })
#define J1_B_ACC(w4_) ({ u32x4 w_; w_.x = cvt_pk_bf16_c((w4_)[0], (w4_)[1]); w_.y = cvt_pk_bf16_c((w4_)[2], (w4_)[3]); w_.z = 0u; w_.w = 0u; __builtin_bit_cast(bf16x8, w_); })
#define J1_MM(A_, B_, acc_) __builtin_amdgcn_mfma_f32_16x16x32_bf16(A_, B_, acc_, 0, 0, 0)
    const f32x4 z4 = (f32x4){0.f, 0.f, 0.f, 0.f};
    for (int wi = blockIdx.x * 8 + wid; wi < NCHUNK * 16; wi += gridDim.x * 8) {
        const int chunk = wi >> 4, h = wi & 15, hk = h >> 1; const size_t t0 = (size_t)chunk * 64;
        const bf16_t* kb = QKV + t0 * 4096 + 1024 + hk * 128; const bf16_t* qb = QKV + t0 * 4096 + hk * 128;
        const float* gcp = GC + (size_t)wi * 64; const float* btp = BETA + (size_t)wi * 64;
        bf16_t* ahb = AH + (size_t)wi * 4096;
        bf16x8 kf[4][4];
#pragma unroll
        for (int mt = 0; mt < 4; ++mt)
#pragma unroll
            for (int ks = 0; ks < 4; ++ks) kf[mt][ks] = *(const bf16x8*)(kb + (size_t)(16 * mt + c) * 4096 + 32 * ks + 8 * q4);
        float gcc[4], btc[4];
#pragma unroll
        for (int nt = 0; nt < 4; ++nt) { gcc[nt] = gcp[16 * nt + c]; btc[nt] = btp[16 * nt + c]; }
#pragma unroll
        for (int mt = 0; mt < 4; ++mt) {
            bf16x8 qf[4];
#pragma unroll
            for (int ks = 0; ks < 4; ++ks) qf[ks] = *(const bf16x8*)(qb + (size_t)(16 * mt + c) * 4096 + 32 * ks + 8 * q4);
            const f32x4 gcr = *(const f32x4*)(gcp + 16 * mt + 4 * q4), btr = *(const f32x4*)(btp + 16 * mt + 4 * q4);
#pragma unroll
            for (int nt = 0; nt < 4; ++nt) {
                bf16_t* aq = AQK + ((size_t)wi * 64 + 16 * mt + 4 * q4) * 64 + 16 * nt + c;
                if (nt <= mt) {
                    f32x4 kk = z4, qk = z4;
#pragma unroll
                    for (int ks = 0; ks < 4; ++ks) { kk = __builtin_amdgcn_mfma_f32_16x16x32_bf16(kf[mt][ks], kf[nt][ks], kk, 0, 0, 0); qk = __builtin_amdgcn_mfma_f32_16x16x32_bf16(qf[ks], kf[nt][ks], qk, 0, 0, 0); }
                    float lv[4];
#pragma unroll
                    for (int e = 0; e < 4; ++e) { const int i = 16 * mt + 4 * q4 + e, j = 16 * nt + c; const float dec = __expf(fminf(gcr[e] - gcc[nt], 0.f));
                        lv[e] = (i > j) ? btr[e] * kk[e] * dec : 0.f;
                        const float a = (i >= j) ? qk[e] * dec : 0.f; aq[e * 64] = (bf16_t)(cvt_pk_bf16_c(a, 0.f) & 0xffffu); }
                    if (nt == mt) {
#pragma unroll
                        for (int e = 0; e < 4; ++e) Ld[(mt * 16 + 4 * q4 + e) * 20 + c] = lv[e]; }
                    else {
#pragma unroll
                        for (int e = 0; e < 4; ++e) Lb[(16 * (mt - 1) + 4 * q4 + e) * 52 + 16 * nt + c] = (bf16_t)(cvt_pk_bf16_c(lv[e], 0.f) & 0xffffu); }
                } else {
#pragma unroll
                    for (int e = 0; e < 4; ++e) aq[e * 64] = (bf16_t)0;
                }
            }
        }
        { const int bz = lane >> 4; bf16_t* zr = ahb + lane * 64; const u32x4 z = (u32x4){0u, 0u, 0u, 0u};
#pragma unroll
          for (int bb = 1; bb < 4; ++bb) if (bb > bz) { *(u32x4*)(zr + 16 * bb) = z; *(u32x4*)(zr + 16 * bb + 8) = z; } }
        J1_SYNC();
        float t[16];
#pragma unroll
        for (int i = 0; i < 16; ++i) {
            float s0 = (c == i) ? 1.f : 0.f, s1 = 0.f, s2 = 0.f, s3 = 0.f;
#pragma unroll
            for (int j4 = 0; j4 < i; j4 += 4) { const f32x4 l = *(const LAS f32x4*)(Ld + (q4 * 16 + i) * 20 + j4);
                s0 -= l[0] * t[j4]; if (j4 + 1 < i) s1 -= l[1] * t[j4 + 1]; if (j4 + 2 < i) s2 -= l[2] * t[j4 + 2]; if (j4 + 3 < i) s3 -= l[3] * t[j4 + 3]; }
            t[i] = (s0 + s1) + (s2 + s3);
        }
        {
            const float bcol = btc[0] * (q4 == 0 ? 1.f : 0.f) + btc[1] * (q4 == 1 ? 1.f : 0.f) + btc[2] * (q4 == 2 ? 1.f : 0.f) + btc[3] * (q4 == 3 ? 1.f : 0.f);
            if (q4 < 3) {
#pragma unroll
                for (int i4 = 0; i4 < 4; ++i4) { u32x2 w; w.x = cvt_pk_bf16_c(t[4 * i4], t[4 * i4 + 1]); w.y = cvt_pk_bf16_c(t[4 * i4 + 2], t[4 * i4 + 3]); *(LAS u32x2*)(TT + (16 * q4 + c) * 52 + 16 * q4 + 4 * i4) = w; } }
            if (q4 > 0) {
#pragma unroll
                for (int i = 0; i < 16; ++i) Dm[((q4 - 1) * 16 + i) * 20 + c] = (bf16_t)(cvt_pk_bf16_c(t[i], 0.f) & 0xffffu); }
#pragma unroll
            for (int i = 0; i < 16; ++i) ahb[(16 * q4 + i) * 64 + 16 * q4 + c] = (bf16_t)(cvt_pk_bf16_c(t[i] * bcol, 0.f) & 0xffffu);
        }
        J1_SYNC();
#define J1_PUT(x4_, i_, j_, keep_) do { if (keep_) { u32x2 w_; w_.x = cvt_pk_bf16_c((x4_)[0], (x4_)[1]); w_.y = cvt_pk_bf16_c((x4_)[2], (x4_)[3]); *(LAS u32x2*)(TT + (16 * (j_) + c) * 52 + 16 * (i_) + 4 * q4) = w_; } \
        _Pragma("unroll") for (int e_ = 0; e_ < 4; ++e_) ahb[(16 * (i_) + 4 * q4 + e_) * 64 + 16 * (j_) + c] = (bf16_t)(cvt_pk_bf16_c((x4_)[e_] * btc[j_], 0.f) & 0xffffu); } while (0)
        {
            f32x4 w10 = J1_MM(J1_A_L(1, 0), J1_B_T(0, 0), z4), w21 = J1_MM(J1_A_L(2, 1), J1_B_T(1, 1), z4), w32 = J1_MM(J1_A_L(3, 2), J1_B_T(2, 2), z4);
            f32x4 t10 = -J1_MM(J1_A_D(1), J1_B_ACC(w10), z4), t21 = -J1_MM(J1_A_D(2), J1_B_ACC(w21), z4), t32 = -J1_MM(J1_A_D(3), J1_B_ACC(w32), z4);
            J1_PUT(t10, 1, 0, true); J1_PUT(t21, 2, 1, true); J1_PUT(t32, 3, 2, false);
            J1_SYNC();
            f32x4 w20 = J1_MM(J1_A_L(2, 0), J1_B_T(0, 0), z4); w20 = J1_MM(J1_A_L(2, 1), J1_B_T(1, 0), w20);
            f32x4 w31 = J1_MM(J1_A_L(3, 1), J1_B_T(1, 1), z4); w31 = J1_MM(J1_A_L(3, 2), J1_B_T(2, 1), w31);
            f32x4 t20 = -J1_MM(J1_A_D(2), J1_B_ACC(w20), z4), t31 = -J1_MM(J1_A_D(3), J1_B_ACC(w31), z4);
            J1_PUT(t20, 2, 0, true); J1_PUT(t31, 3, 1, false);
            J1_SYNC();
            f32x4 w30 = J1_MM(J1_A_L(3, 0), J1_B_T(0, 0), z4); w30 = J1_MM(J1_A_L(3, 1), J1_B_T(1, 0), w30); w30 = J1_MM(J1_A_L(3, 2), J1_B_T(2, 0), w30);
            f32x4 t30 = -J1_MM(J1_A_D(3), J1_B_ACC(w30), z4);
            J1_PUT(t30, 3, 0, false);
        }
        J1_SYNC();
    }
#undef J1_SYNC
#undef J1_A_L
#undef J1_A_D
#undef J1_B_T
#undef J1_B_ACC
#undef J1_MM
#undef J1_PUT
}

__device__ __forceinline__ bf16x8 pack_acc2(const f32x4 a, const f32x4 b) { u32x4 w; w.x = cvt_pk_bf16_c(a[0], a[1]); w.y = cvt_pk_bf16_c(a[2], a[3]); w.z = cvt_pk_bf16_c(b[0], b[1]); w.w = cvt_pk_bf16_c(b[2], b[3]); return __builtin_bit_cast(bf16x8, w); }
__device__ __forceinline__ bf16x8 ld_perm(const bf16_t* ptr) { const u32x2 a = *(const u32x2*)ptr, b = *(const u32x2*)(ptr + 16); u32x4 w; w.x = a.x; w.y = a.y; w.z = b.x; w.w = b.y; return __builtin_bit_cast(bf16x8, w); }
#define LDS_BARRIER() do { asm volatile("s_waitcnt lgkmcnt(0)" ::: "memory"); __builtin_amdgcn_s_barrier(); asm volatile("" ::: "memory"); } while (0)
__device__ void phase_j2(const Params& p, unsigned char* lds_g, bool dry) {
    bf16_t* QKV = (bf16_t*)(p.ws + WS_R1); const float* GC = (const float*)(p.ws + WS_GC);
    const bf16_t* AH = (const bf16_t*)(p.out + O_Y); const bf16_t* AQK = AH + (size_t)NCHUNK * 16 * 4096;
    const int tid = threadIdx.x, lane = tid & 63, w = tid >> 6, c = lane & 15, q4 = lane >> 4;
    constexpr int KN_OFF = 0, QN_OFF = 17408, KT_OFF = 34816, VT_OFF = 53248, AH_OFF = 71680, AQ_OFF = 80896, OS_OFF = 90112, SSQ_OFF = 107520;
    LAS unsigned char* L = (LAS unsigned char*)lds_g;
    LAS bf16_t* KT = (LAS bf16_t*)(L + KT_OFF); LAS bf16_t* VT = (LAS bf16_t*)(L + VT_OFF); LAS bf16_t* OS = (LAS bf16_t*)(L + OS_OFF);
    LAS float* SSQ = (LAS float*)(L + SSQ_OFF);
    const float nw = p.gdn_norm_w[16 * w + c];
    const int rowl = tid & 63, seg = tid >> 6;
    int par = 0;
    if (tid < 128) ((LAS float*)(L + 111616 + 1024))[tid] = 0.f;
    u32x4 rk0, rk1, rq0, rq1, rv0, rv1, ra, rqk; float ngate, ngl;
    LAS float* GEX = (LAS float*)(L + 111616);
    LAS float* SSQT = (LAS float*)(L + 111616 + 1024);
#define J2_LOAD(chunk_) do { const size_t t0_ = (size_t)(chunk_) * 64; const size_t ci_ = (size_t)(chunk_) * 16 + h; \
        const bf16_t* kb_ = QKV + (t0_ + rowl) * 4096 + 1024 + hk * 128 + seg * 16; const bf16_t* qb_ = QKV + (t0_ + rowl) * 4096 + hk * 128 + seg * 16; const bf16_t* vb_ = QKV + (t0_ + rowl) * 4096 + 2048 + h * 128 + seg * 16; \
        rk0 = *(const u32x4*)kb_; rk1 = *(const u32x4*)(kb_ + 8); rq0 = *(const u32x4*)qb_; rq1 = *(const u32x4*)(qb_ + 8); rv0 = *(const u32x4*)vb_; rv1 = *(const u32x4*)(vb_ + 8); \
        ra = *(const u32x4*)(AH + ci_ * 4096 + tid * 8); rqk = *(const u32x4*)(AQK + ci_ * 4096 + tid * 8); \
        ngate = GC[ci_ * 64 + rowl]; ngl = GC[ci_ * 64 + 63]; } while (0)
#define J2_STORE() do { *(LAS u32x4*)(L + KN_OFF + rowl * 272 + seg * 32) = rk0; *(LAS u32x4*)(L + KN_OFF + rowl * 272 + seg * 32 + 16) = rk1; \
        *(LAS u32x4*)(L + QN_OFF + rowl * 272 + seg * 32) = rq0; *(LAS u32x4*)(L + QN_OFF + rowl * 272 + seg * 32 + 16) = rq1; \
        { const unsigned kw_[8] = {rk0.x, rk0.y, rk0.z, rk0.w, rk1.x, rk1.y, rk1.z, rk1.w}; const unsigned vw_[8] = {rv0.x, rv0.y, rv0.z, rv0.w, rv1.x, rv1.y, rv1.z, rv1.w}; \
          _Pragma("unroll") for (int j_ = 0; j_ < 8; ++j_) { KT[(seg * 16 + 2 * j_) * 72 + rowl] = (bf16_t)(kw_[j_] & 0xffffu); KT[(seg * 16 + 2 * j_ + 1) * 72 + rowl] = (bf16_t)(kw_[j_] >> 16); \
              VT[(seg * 16 + 2 * j_) * 72 + rowl] = (bf16_t)(vw_[j_] & 0xffffu); VT[(seg * 16 + 2 * j_ + 1) * 72 + rowl] = (bf16_t)(vw_[j_] >> 16); } } \
        *(LAS u32x4*)(L + AH_OFF + (tid >> 3) * 144 + (tid & 7) * 16) = ra; *(LAS u32x4*)(L + AQ_OFF + (tid >> 3) * 144 + (tid & 7) * 16) = rqk; if (tid < 64) { GEX[tid] = __expf(ngate); GEX[64 + tid] = __expf(ngl - ngate); if (tid == 63) GEX[128] = __expf(ngl); } } while (0)
#define J2_FRAG(off_) ({ const u32x2 a_ = *(const LAS u32x2*)(L + (off_)); const u32x2 b_ = *(const LAS u32x2*)(L + (off_) + 32); u32x4 w_; w_.x = a_.x; w_.y = a_.y; w_.z = b_.x; w_.w = b_.y; __builtin_bit_cast(bf16x8, w_); })
    for (int item = blockIdx.x; item < 768; item += gridDim.x) {
        int chunk0, nch, h; const float* s0 = nullptr; float* sout;
        if (item < 256) { const int b = item >> 4; h = item & 15; chunk0 = b * 64; nch = 64; sout = p.out + O_REC_P + ((size_t)b * 16 + h) * 16384; }
        else { const int b = (item - 256) >> 4; h = item & 15; chunk0 = 1024 + b; nch = 1; s0 = p.state_rec + ((size_t)b * 16 + h) * 16384; sout = p.out + O_REC_S + ((size_t)b * 16 + h) * 16384; }
        const int hk = h >> 1;
        f32x4 S[8];
        { int loff = (4 * q4) * 128 + 16 * w + c; asm volatile("" : "+v"(loff));
#pragma unroll
        for (int mt = 0; mt < 8; ++mt) {
            if (s0) {
#pragma unroll
                for (int e = 0; e < 4; ++e) S[mt][e] = s0[loff + (16 * mt + e) * 128]; }
            else S[mt] = (f32x4){0.f, 0.f, 0.f, 0.f};
        } }
        J2_LOAD(chunk0);
        LDS_BARRIER();
        J2_STORE();
        LDS_BARRIER();
        for (int n = 0; n < nch; ++n, par ^= 1) {
            const int chunk = chunk0 + n; const size_t t0 = (size_t)chunk * 64; const size_t ci = (size_t)chunk * 16 + h;
            const float egl = GEX[128];
            if (n + 1 < nch) J2_LOAD(chunk + 1);
            LAS float* ssq = SSQT + par * 64;
            bf16x8 Sb[4];
#pragma unroll
            for (int ks = 0; ks < 4; ++ks) Sb[ks] = pack_acc2(S[2 * ks], S[2 * ks + 1]);
#define J2_SB() __builtin_amdgcn_sched_barrier(0)
#define J2_LDKQ(dstk, dstq, mt_) do { _Pragma("unroll") for (int ks_ = 0; ks_ < 4; ++ks_) { const int o_ = (16 * (mt_) + c) * 272 + (32 * ks_ + 4 * q4) * 2; dstk[ks_] = J2_FRAG(KN_OFF + o_); dstq[ks_] = J2_FRAG(QN_OFF + o_); } } while (0)
#define J2_MMKQ(srck, srcq, mt_) do { _Pragma("unroll") for (int ks_ = 0; ks_ < 4; ++ks_) { P[mt_] = __builtin_amdgcn_mfma_f32_16x16x32_bf16(srck[ks_], Sb[ks_], P[mt_], 0, 0, 0); QS[mt_] = __builtin_amdgcn_mfma_f32_16x16x32_bf16(srcq[ks_], Sb[ks_], QS[mt_], 0, 0, 0); } } while (0)
            f32x4 P[4], QS[4];
#pragma unroll
            for (int mt = 0; mt < 4; ++mt) { P[mt] = (f32x4){0.f, 0.f, 0.f, 0.f}; QS[mt] = (f32x4){0.f, 0.f, 0.f, 0.f}; }
            bf16x8 ka[4], qa[4], kb2[4], qb2[4]; u32x2 vv[4];
            J2_LDKQ(ka, qa, 0); J2_LDKQ(kb2, qb2, 1);
            J2_SB(); J2_MMKQ(ka, qa, 0); J2_LDKQ(ka, qa, 2);
            J2_SB(); J2_MMKQ(kb2, qb2, 1); J2_LDKQ(kb2, qb2, 3);
            J2_SB(); J2_MMKQ(ka, qa, 2);
            bf16x8 ahf[4][2], aqf[4][2];
#pragma unroll
            for (int mt = 0; mt < 4; ++mt)
#pragma unroll
                for (int k2 = 0; k2 < 2; ++k2) ahf[mt][k2] = J2_FRAG(AH_OFF + (16 * mt + c) * 144 + (32 * k2 + 4 * q4) * 2);
            f32x4 egc[4];
#pragma unroll
            for (int mt = 0; mt < 4; ++mt) { egc[mt] = *(const LAS f32x4*)(GEX + 16 * mt + 4 * q4);
                vv[mt] = *(const LAS u32x2*)(L + VT_OFF + (16 * w + c) * 144 + (16 * mt + 4 * q4) * 2); }
            J2_SB(); J2_MMKQ(kb2, qb2, 3);
            J2_SB();
            f32x4 edl[4];
#pragma unroll
            for (int mt = 0; mt < 4; ++mt) edl[mt] = *(const LAS f32x4*)(GEX + 64 + 16 * mt + 4 * q4);
            f32x4 R[4];
#pragma unroll
            for (int mt = 0; mt < 4; ++mt) { R[mt][0] = bf_lo(vv[mt].x) - egc[mt][0] * P[mt][0]; R[mt][1] = bf_hi(vv[mt].x) - egc[mt][1] * P[mt][1]; R[mt][2] = bf_lo(vv[mt].y) - egc[mt][2] * P[mt][2]; R[mt][3] = bf_hi(vv[mt].y) - egc[mt][3] * P[mt][3]; }
            bf16x8 Rb[2];
#pragma unroll
            for (int k2 = 0; k2 < 2; ++k2) Rb[k2] = pack_acc2(R[2 * k2], R[2 * k2 + 1]);
            J2_SB();
            f32x4 Vn[4];
#pragma unroll
            for (int mt = 0; mt < 4; ++mt) { Vn[mt] = (f32x4){0.f, 0.f, 0.f, 0.f};
#pragma unroll
                for (int k2 = 0; k2 < 2; ++k2) Vn[mt] = __builtin_amdgcn_mfma_f32_16x16x32_bf16(ahf[mt][k2], Rb[k2], Vn[mt], 0, 0, 0); }
            J2_SB();
#pragma unroll
            for (int mt = 0; mt < 4; ++mt)
#pragma unroll
                for (int k2 = 0; k2 < 2; ++k2) aqf[mt][k2] = J2_FRAG(AQ_OFF + (16 * mt + c) * 144 + (32 * k2 + 4 * q4) * 2);
            bf16x8 ktf[4][2];
#pragma unroll
            for (int mt = 0; mt < 4; ++mt)
#pragma unroll
                for (int k2 = 0; k2 < 2; ++k2) ktf[mt][k2] = J2_FRAG(KT_OFF + (16 * mt + c) * 144 + (32 * k2 + 4 * q4) * 2);
            bf16x8 Vb[2], Vsb[2];
#pragma unroll
            for (int k2 = 0; k2 < 2; ++k2) { Vb[k2] = pack_acc2(Vn[2 * k2], Vn[2 * k2 + 1]); Vsb[k2] = pack_acc2(Vn[2 * k2] * edl[2 * k2], Vn[2 * k2 + 1] * edl[2 * k2 + 1]); }
            J2_SB();
            f32x4 O[4];
#pragma unroll
            for (int mt = 0; mt < 4; ++mt) { O[mt] = QS[mt] * egc[mt];
#pragma unroll
                for (int k2 = 0; k2 < 2; ++k2) O[mt] = __builtin_amdgcn_mfma_f32_16x16x32_bf16(aqf[mt][k2], Vb[k2], O[mt], 0, 0, 0); }
            J2_SB();
#pragma unroll
            for (int mt = 0; mt < 4; ++mt) { S[mt] = S[mt] * egl;
#pragma unroll
                for (int k2 = 0; k2 < 2; ++k2) S[mt] = __builtin_amdgcn_mfma_f32_16x16x32_bf16(ktf[mt][k2], Vsb[k2], S[mt], 0, 0, 0); }
            J2_SB();
#pragma unroll
            for (int mt = 0; mt < 4; ++mt)
#pragma unroll
                for (int k2 = 0; k2 < 2; ++k2) ktf[mt][k2] = J2_FRAG(KT_OFF + (16 * (mt + 4) + c) * 144 + (32 * k2 + 4 * q4) * 2);
#pragma unroll
            for (int mt = 0; mt < 4; ++mt) { f32x4 sq = O[mt] * O[mt]; sq[0] = dpp_sum16(sq[0]); sq[1] = dpp_sum16(sq[1]); sq[2] = dpp_sum16(sq[2]); sq[3] = dpp_sum16(sq[3]);
                if (c == 0) {
#pragma unroll
                    for (int e = 0; e < 4; ++e) __hip_atomic_fetch_add(ssq + 16 * mt + 4 * q4 + e, sq[e], __ATOMIC_RELAXED, __HIP_MEMORY_SCOPE_WORKGROUP); } }
            J2_SB();
#pragma unroll
            for (int mt = 0; mt < 4; ++mt) { S[mt + 4] = S[mt + 4] * egl;
#pragma unroll
                for (int k2 = 0; k2 < 2; ++k2) S[mt + 4] = __builtin_amdgcn_mfma_f32_16x16x32_bf16(ktf[mt][k2], Vsb[k2], S[mt + 4], 0, 0, 0); }
#undef J2_SB
#undef J2_LDKQ
#undef J2_MMKQ
            LDS_BARRIER();
#pragma unroll
            for (int mt = 0; mt < 4; ++mt) { const f32x4 tot = *(const LAS f32x4*)(ssq + 16 * mt + 4 * q4);
#pragma unroll
                for (int e = 0; e < 4; ++e) { const float r = rsqrtf(tot[e] * (1.0f / 128.0f) + EPS); OS[(16 * mt + 4 * q4 + e) * 136 + 16 * w + c] = (bf16_t)(cvt_pk_bf16_c(O[mt][e] * r * nw, 0.f) & 0xffffu); } }
            LDS_BARRIER();
            { const int row = tid >> 3, s8 = tid & 7; const u32x4 o0 = *(const LAS u32x4*)(L + OS_OFF + row * 272 + s8 * 32), o1 = *(const LAS u32x4*)(L + OS_OFF + row * 272 + s8 * 32 + 16);
              bf16_t* op = QKV + (t0 + row) * 4096 + 2048 + h * 128 + s8 * 16; if (!dry) { *(u32x4*)op = o0; *(u32x4*)(op + 8) = o1; } }
            if (n + 1 < nch) J2_STORE();
            if (tid < 64) SSQT[(par ^ 1) * 64 + tid] = 0.f;
            LDS_BARRIER();
        }
        { int loff = (4 * q4) * 128 + 16 * w + c; asm volatile("" : "+v"(loff));
#pragma unroll
        for (int mt = 0; mt < 8; ++mt)
#pragma unroll
            for (int e = 0; e < 4; ++e) if (!dry) sout[loff + (16 * mt + e) * 128] = S[mt][e]; }
    }
#undef J2_LOAD
#undef J2_STORE
#undef J2_FRAG
}


#define XB_TMO      128
#define XB_XCNT(j)  (256  + 64 * (j))
#define XB_XSUB(j)  (1280 + 64 * (j))
#define XB_XGEN(j)  (2304 + 64 * (j))
#define XB_TOP      3328
#define XB_TOPGEN   3392
#define XCD_BAR_WORDS 3456
#define XB_SPIN_CAP (1u << 18)
__device__ __forceinline__ unsigned xb_ld(unsigned* p)              { return __hip_atomic_load(p, __ATOMIC_RELAXED, __HIP_MEMORY_SCOPE_AGENT); }
__device__ __forceinline__ unsigned xb_add(unsigned* p, unsigned v) { return __hip_atomic_fetch_add(p, v, __ATOMIC_RELAXED, __HIP_MEMORY_SCOPE_AGENT); }
__device__ __forceinline__ unsigned xb_xcc_id() { return (unsigned)__builtin_amdgcn_s_getreg((3 << 11) | 20) & 0xFu; }
#define XB_SPIN(cond, bar) do { unsigned _sp = 0; while (cond) { __builtin_amdgcn_s_sleep(1); \
    if ((++_sp & 255u) == 0u) { if (xb_ld(&(bar)[XB_TMO])) break; if (_sp > XB_SPIN_CAP) { atomicAdd(&(bar)[XB_TMO], 1u); break; } } } } while (0)
struct XcdBarrier { unsigned* bar; unsigned x; volatile LAS unsigned* st; };
__device__ __forceinline__ XcdBarrier xcd_barrier_post(unsigned* bar, volatile LAS unsigned* st) {
    XcdBarrier b; b.bar = bar; b.x = xb_xcc_id(); b.st = st;
    if (threadIdx.x == 0) (void)xb_add(&bar[XB_XCNT(b.x)], 1u);
    return b;
}
__device__ __forceinline__ void xcd_barrier_complete(unsigned* bar, unsigned x, unsigned& nloc, unsigned& nx) {
    const unsigned G = gridDim.x * gridDim.y * gridDim.z;
    unsigned sum, cnt, mine, sp = 0u;
    for (;;) {
        sum = 0u; cnt = 0u; mine = 0u;
#pragma unroll
        for (unsigned j = 0; j < 16; ++j) { const unsigned c = xb_ld(&bar[XB_XCNT(j)]); sum += c; cnt += (c > 0u) ? 1u : 0u; mine = (j == x) ? c : mine; }
        if (sum == G) break;
        __builtin_amdgcn_s_sleep(1);
        if ((++sp & 255u) == 0u) { if (xb_ld(&bar[XB_TMO])) break; if (sp > XB_SPIN_CAP) { atomicAdd(&bar[XB_TMO], 1u); break; } }
    }
    nloc = mine > 0u ? mine : 1u; nx = cnt > 0u ? cnt : 1u;
}
__device__ __forceinline__ void xcd_barrier(const XcdBarrier& b) {
    asm volatile("s_waitcnt vmcnt(0)" ::: "memory");
    __syncthreads();
    if (threadIdx.x == 0) {
        unsigned* bar = b.bar;
        __builtin_amdgcn_s_waitcnt(0);
        unsigned nloc = b.st[0], nx = b.st[1];
        if (nloc == 0u) { xcd_barrier_complete(bar, b.x, nloc, nx); b.st[0] = nloc; b.st[1] = nx; }
        const unsigned old = xb_add(&bar[XB_XSUB(b.x)], 1u);
        const unsigned gen = old / nloc;
        if (old + 1u == (gen + 1u) * nloc) {
            __builtin_amdgcn_fence(__ATOMIC_RELEASE, "agent");
            asm volatile("s_waitcnt vmcnt(0)" ::: "memory");
            const unsigned og = xb_add(&bar[XB_TOP], 1u);
            const unsigned tg = og / nx;
            if (og + 1u == (tg + 1u) * nx) xb_add(&bar[XB_TOPGEN], 1u);
            else XB_SPIN(xb_ld(&bar[XB_TOPGEN]) == tg, bar);
            __builtin_amdgcn_fence(__ATOMIC_ACQUIRE, "agent");
            xb_add(&bar[XB_XGEN(b.x)], 1u);
            asm volatile("s_waitcnt vmcnt(0)" ::: "memory");
        } else {
            XB_SPIN(xb_ld(&bar[XB_XGEN(b.x)]) == gen, bar);
            __builtin_amdgcn_fence(__ATOMIC_ACQUIRE, "agent");
            asm volatile("s_waitcnt vmcnt(0)" ::: "memory");
        }
    }
    __syncthreads();
}

constexpr int N_PHASES = 14;
#ifndef PH_MASK
#define PH_MASK 0x3fff
#endif
#define PH_ON(n) (((PH_MASK) >> (n)) & 1)
#ifndef REP_MASK
#define REP_MASK 0
#endif
#define REP_ON(n) (((REP_MASK) >> (n)) & 1)
__global__ void __launch_bounds__(NT, 2) mega(Params p, int ph_lo, int ph_hi, int rep_mask) {
    extern __shared__ __attribute__((aligned(16))) unsigned char lds[];
    LAS unsigned char* ldsl = (LAS unsigned char*)lds;
    cg::grid_group grid = cg::this_grid();
    unsigned char* ws = p.ws;
    bf16_t* W1t = (bf16_t*)(ws + WS_W1T); bf16_t* Wgt = (bf16_t*)(ws + WS_WGT); bf16_t* W2t = (bf16_t*)(ws + WS_W2T); bf16_t* W3t = (bf16_t*)(ws + WS_W3T); bf16_t* W4t = (bf16_t*)(ws + WS_W4T);
    float* mod = (float*)(ws + WS_MOD); bf16_t* H = (bf16_t*)(ws + WS_H); bf16_t* R1 = (bf16_t*)(ws + WS_R1); bf16_t* R2 = (bf16_t*)(ws + WS_R2); bf16_t* R3 = (bf16_t*)(ws + WS_R3);
    bf16_t* X1b = (bf16_t*)(ws + WS_R3);
    const int G = gridDim.x, bid = blockIdx.x;
    volatile LAS unsigned* xst = (volatile LAS unsigned*)(ldsl + LDS_BYTES - 16);
    if (threadIdx.x == 0) { xst[0] = 0u; xst[1] = 0u; }
    __syncthreads();
    const XcdBarrier xb = xcd_barrier_post((unsigned*)(ws + WS_BAR), xst);
#define IN(k) (ph_lo <= (k) && (k) < ph_hi)
#define SEAM(k) do { if (IN(k) && IN((k) + 1)) { if (ph_lo < 0) grid.sync(); else xcd_barrier(xb); } } while (0)
    if (PH_ON(0) && IN(0)) { phase_prep(p, lds); }
    SEAM(0);
    if (PH_ON(1) && IN(1)) { phase_norm_mod(p.x_prompt, p.x_sample, p.norm_gain, mod, H); }
    SEAM(1);
    if (PH_ON(2) && IN(2)) { { pg8::Gemm g{H, W1t, T, 4096, 1024, 1024, 1024, 0, 0}; pg8::StaticOrder S; S.init(T, 4096, G, bid); pg8::EpiL0In E{R1, R2}; pg8::gemm_phase(ldsl, g, S, E); } }
    SEAM(2);
    if (PH_ON(3) && IN(3)) { phase_pool(p); }
    SEAM(3);
    if (PH_ON(4) && IN(4)) { { pg8::Gemm g{R3, Wgt, T, 2048, 512, 2048, 512, 2, 1024}; pg8::StaticOrder S; S.init(T, 2048, G, bid); pg8::EpiGrp E{R1, R2, p.pool_scale}; pg8::gemm_phase(ldsl, g, S, E); } }
    SEAM(4);
    if (PH_ON(5) && IN(5)) { { pg8::Gemm g{R1, W2t, T, 1024, 2048, 2048, 2048, 0, 0}; pg8::StaticOrder S; S.init(T, 1024, G, bid); pg8::EpiRes<false> E{p.x_prompt, p.x_sample, nullptr, X1b, mod + 2048}; pg8::gemm_phase(ldsl, g, S, E); } }
    SEAM(5);
    if (PH_ON(6) && IN(6)) { phase_norm_b<0>(X1b, p.norm_gain + 1024, mod + 48 * 3072, H, nullptr); }
    SEAM(6);
    if (PH_ON(7) && IN(7)) { { pg8::Gemm g{H, W3t, T, 4352, 1024, 1024, 1024, 0, 0}; pg8::StaticOrder S; S.init(T, 4352, G, bid); pg8::EpiL1In E{R1, (bf16_t*)(ws + WS_STASH), (float*)(ws + WS_AB)}; pg8::gemm_phase(ldsl, g, S, E); } }
    SEAM(7);
    if (PH_ON(8) && IN(8)) { phase_conv(p); }
    SEAM(8);
    if (PH_ON(9) && IN(9)) { phase_j1(p, lds); }
    SEAM(9);
    if (PH_ON(10) && IN(10)) { phase_j2(p, lds, false); }
    SEAM(10);
    if (PH_ON(11) && IN(11)) { { pg8::Gemm g{H, W3t + (size_t)4352 * 1024, T, 2048, 1024, 1024, 1024, 0, 0}; pg8::StaticOrder S; S.init(T, 2048, G, bid); pg8::EpiZ E{R1}; pg8::gemm_phase(ldsl, g, S, E); } }
    SEAM(11);
    if (PH_ON(12) && IN(12)) { { pg8::Gemm g{R1 + 2048, W4t, T, 1024, 2048, 4096, 2048, 0, 0}; pg8::StaticOrder S; S.init(T, 1024, G, bid); pg8::EpiRes<true> E{nullptr, nullptr, X1b, X1b, mod + 48 * 3072 + 2048}; pg8::gemm_phase(ldsl, g, S, E); } }
    SEAM(12);
    if (PH_ON(13) && IN(13)) { phase_norm_b<1>(X1b, p.final_gain, nullptr, nullptr, p.out + O_Y); }
    SEAM(13);
#undef IN
#undef SEAM
}

#ifndef MK_ONE_LAUNCH
#define MK_ONE_LAUNCH 1
#endif
extern "C" void kernel_launch(void* const* d_in, const int* in_sizes, int n_in, void* d_out, int out_size, void* d_ws, size_t ws_size, hipStream_t stream) {
    static int grid = 0;
    if (grid == 0) {
        if (ws_size < WS_END) { fprintf(stderr, "kernel_launch: workspace too small: %zu < %zu\n", ws_size, (size_t)WS_END); grid = -1; return; }
        int dev = 0, cus = 0, per_cu = 0;
        hipGetDevice(&dev); hipDeviceGetAttribute(&cus, hipDeviceAttributeMultiprocessorCount, dev);
        if (hipFuncSetAttribute((const void*)mega, hipFuncAttributeMaxDynamicSharedMemorySize, LDS_BYTES) != hipSuccess) { fprintf(stderr, "kernel_launch: hipFuncSetAttribute failed\n"); grid = -1; return; }
        if (hipOccupancyMaxActiveBlocksPerMultiprocessor(&per_cu, (const void*)mega, NT, LDS_BYTES) != hipSuccess || per_cu < 1) { fprintf(stderr, "kernel_launch: occupancy query gave %d\n", per_cu); per_cu = 1; }
        (void)hipGetLastError();
        grid = (cus * per_cu) & ~3;
    }
    if (grid < 0) return;
    Params p{};
    p.x_prompt = (const float*)d_in[0]; p.x_sample = (const float*)d_in[1]; p.c_prompt = (const float*)d_in[2]; p.c_sample = (const float*)d_in[3];
    p.state_pool = (const float*)d_in[4]; p.state_conv = (const float*)d_in[5]; p.state_rec = (const float*)d_in[6];
    p.norm_gain = (const float*)d_in[7]; p.ada_w = (const float*)d_in[8]; p.ada_b = (const float*)d_in[9];
    p.pool_w_in = (const float*)d_in[10]; p.pool_w_group = (const float*)d_in[11]; p.pool_scale = (const float*)d_in[12]; p.pool_w_out = (const float*)d_in[13];
    p.gdn_w_in = (const float*)d_in[14]; p.gdn_conv_w = (const float*)d_in[15]; p.gdn_a_log = (const float*)d_in[16]; p.gdn_dt_bias = (const float*)d_in[17]; p.gdn_norm_w = (const float*)d_in[18]; p.gdn_w_out = (const float*)d_in[19];
    p.final_gain = (const float*)d_in[20];
    p.out = (float*)d_out; p.ws = (unsigned char*)d_ws;
    if (hipMemsetAsync((unsigned char*)d_ws + WS_BAR, 0, 16384, stream) != hipSuccess) { fprintf(stderr, "kernel_launch: memset of barrier words failed\n"); return; }
#if MK_ONE_LAUNCH
    int lo = 0, hi = N_PHASES, rep = REP_MASK; void* args[] = {&p, &lo, &hi, &rep};
    hipError_t e = hipLaunchCooperativeKernel((const void*)mega, dim3(grid), dim3(NT), args, LDS_BYTES, stream);
    if (e != hipSuccess) fprintf(stderr, "cooperative launch failed: %s (grid %d)\n", hipGetErrorString(e), grid);
#else
    for (int ph = 0; ph < N_PHASES; ++ph) { hipLaunchKernelGGL(mega, dim3(grid), dim3(NT), LDS_BYTES, stream, p, ph, ph + 1, 0); }
#endif
}
```

```cpp
#include <hip/hip_runtime.h>
#include <hip/hip_cooperative_groups.h>
#include <cstdio>
namespace cg = cooperative_groups;

#define LAS __attribute__((address_space(3)))
typedef unsigned short bf16_t;
typedef short bf16x8 __attribute__((ext_vector_type(8)));
typedef short bf16x4 __attribute__((ext_vector_type(4)));
typedef float f32x4 __attribute__((ext_vector_type(4)));
typedef unsigned u32x4 __attribute__((ext_vector_type(4)));
typedef unsigned u32x2 __attribute__((ext_vector_type(2)));

constexpr int DM = 1024, TP = 65536, TS = 2048, T = TP + TS, NSEQ = 48, NCHUNK = T / 64;
constexpr int NT = 512, LDS_BYTES = 147456;
constexpr float EPS = 1e-6f;

constexpr size_t SZ_BIG = (size_t)T * 2048 * 2;
constexpr size_t WS_W1T = 0;
constexpr size_t WS_WGT = WS_W1T + (size_t)4096 * 1024 * 2;
constexpr size_t WS_W2T = WS_WGT + (size_t)2048 * 512 * 2;
constexpr size_t WS_W3T = WS_W2T + (size_t)1024 * 2048 * 2;
constexpr size_t WS_W4T = WS_W3T + (size_t)6400 * 1024 * 2;
constexpr size_t WS_MOD = WS_W4T + (size_t)1024 * 2048 * 2;
constexpr size_t WS_AB = WS_MOD + (size_t)2 * 48 * 3072 * 4;
constexpr size_t WS_GC = WS_AB + (size_t)T * 32 * 4;
constexpr size_t WS_BETA = WS_GC + (size_t)T * 16 * 4;
constexpr size_t WS_STASH = WS_BETA + (size_t)T * 16 * 4;
constexpr size_t WS_H = WS_STASH + (size_t)NCHUNK * 3 * 4096 * 2;
constexpr size_t WS_R1 = WS_H + (size_t)T * 1024 * 2;
constexpr size_t WS_R2 = WS_R1 + SZ_BIG;
constexpr size_t WS_R3 = WS_R2 + SZ_BIG;
constexpr size_t WS_BAR = WS_R3 + SZ_BIG;
constexpr size_t WS_END = WS_BAR + 16384;

constexpr size_t O_Y = 0;
constexpr size_t O_POOL_P = (size_t)T * 1024;
constexpr size_t O_CONV_P = O_POOL_P + (size_t)16 * 15 * 2048;
constexpr size_t O_REC_P = O_CONV_P + (size_t)16 * 3 * 4096;
constexpr size_t O_POOL_S = O_REC_P + (size_t)16 * 16 * 16384;
constexpr size_t O_CONV_S = O_POOL_S + (size_t)32 * 15 * 2048;
constexpr size_t O_REC_S = O_CONV_S + (size_t)32 * 3 * 4096;

struct Params {
    const float* x_prompt; const float* x_sample; const float* c_prompt; const float* c_sample;
    const float* state_pool; const float* state_conv; const float* state_rec;
    const float* norm_gain; const float* ada_w; const float* ada_b;
    const float* pool_w_in; const float* pool_w_group; const float* pool_scale; const float* pool_w_out;
    const float* gdn_w_in; const float* gdn_conv_w; const float* gdn_a_log; const float* gdn_dt_bias; const float* gdn_norm_w; const float* gdn_w_out;
    const float* final_gain;
    float* out; unsigned char* ws;
};

__device__ __forceinline__ unsigned cvt_pk_bf16(float lo, float hi) { unsigned r; asm("v_cvt_pk_bf16_f32 %0, %1, %2" : "=v"(r) : "v"(lo), "v"(hi)); return r; }
typedef __bf16 bf16x2_t __attribute__((ext_vector_type(2)));
__device__ __forceinline__ unsigned cvt_pk_bf16_c(float lo, float hi) { const bf16x2_t v = {(__bf16)lo, (__bf16)hi}; return __builtin_bit_cast(unsigned, v); }
__device__ __forceinline__ float bf_lo(unsigned w) { return __uint_as_float(w << 16); }
__device__ __forceinline__ float bf_hi(unsigned w) { return __uint_as_float(w & 0xffff0000u); }
__device__ __forceinline__ float silu_f(float x) { return x * __builtin_amdgcn_rcpf(1.0f + __expf(-x)); }
__device__ __forceinline__ void unpack8(const u32x4 w, float (&f)[8]) { f[0] = bf_lo(w.x); f[1] = bf_hi(w.x); f[2] = bf_lo(w.y); f[3] = bf_hi(w.y); f[4] = bf_lo(w.z); f[5] = bf_hi(w.z); f[6] = bf_lo(w.w); f[7] = bf_hi(w.w); }
__device__ __forceinline__ u32x4 pack8c(const float (&f)[8]) { u32x4 w; w.x = cvt_pk_bf16_c(f[0], f[1]); w.y = cvt_pk_bf16_c(f[2], f[3]); w.z = cvt_pk_bf16_c(f[4], f[5]); w.w = cvt_pk_bf16_c(f[6], f[7]); return w; }
__device__ __forceinline__ u32x4 pack8(const float (&f)[8]) { u32x4 w; w.x = cvt_pk_bf16(f[0], f[1]); w.y = cvt_pk_bf16(f[2], f[3]); w.z = cvt_pk_bf16(f[4], f[5]); w.w = cvt_pk_bf16(f[6], f[7]); return w; }
__device__ __forceinline__ int seq_of_row(int row) { return row < TP ? (row >> 12) : 16 + ((row - TP) >> 6); }

__device__ __forceinline__ float dpp_sum16(float v) {
    v += __int_as_float(__builtin_amdgcn_update_dpp(0, __float_as_int(v), 0xB1, 0xF, 0xF, true));
    v += __int_as_float(__builtin_amdgcn_update_dpp(0, __float_as_int(v), 0x4E, 0xF, 0xF, true));
    v += __int_as_float(__builtin_amdgcn_update_dpp(0, __float_as_int(v), 0x141, 0xF, 0xF, true));
    v += __int_as_float(__builtin_amdgcn_update_dpp(0, __float_as_int(v), 0x140, 0xF, 0xF, true));
    return v;
}
#ifndef STAGGER_US
#define STAGGER_US 0
#endif
namespace pg8 {
constexpr int BM = 256, BK = 64, HALF = 128, HTB = HALF * BK * 2, STAGE_BYTES = 8 * HTB, NXCD = 8, WGM = 8;
__device__ __forceinline__ int lds_byte(int r, int c) { const int st = (r >> 4) * 2 + (c >> 5), rr = r & 15, cc = c & 31, ob = rr * 64 + cc * 2; return st * 1024 + (ob ^ (((ob >> 9) & 1) << 5)); }
__device__ __forceinline__ void stage_rc(int b, int& R, int& C) { const int st = b / 1024, sb = b % 1024, swz = sb ^ (((sb >> 9) & 1) << 5); R = (st >> 1) * 16 + swz / 64; C = (st & 1) * 32 + (swz % 64) / 2; }
__device__ __forceinline__ int perm32(int rho) { const int n = rho >> 4, i = rho & 15; return 8 * (i >> 2) + 4 * n + (i & 3); }
struct Unit { int pm, pn; };
struct Gemm { const bf16_t* A; const bf16_t* Bt; int M, N, K, lda, ldb, a_grp_div; long a_gstride; int pm_mask = 0xffff; };
struct StaticOrder {
    int nM, nN, nwg, G, c;
    __device__ void init(int M, int N, int G_, int c_) { nM = M / BM; nN = N / BM; nwg = nM * nN; G = G_; c = c_; }
    __device__ bool next(int i, Unit& u) const {
        const long L = (long)i * G + c; if (L >= nwg) return false;
        int wgid = (int)L; { const int q = nwg / NXCD, r = nwg % NXCD, xcd = wgid % NXCD, off = wgid / NXCD; wgid = (xcd < r ? xcd * (q + 1) : r * (q + 1) + (xcd - r) * q) + off; }
        const int nig = WGM * nN, gid = wgid / nig, fm = gid * WGM, gsz = (nM - fm) < WGM ? (nM - fm) : WGM;
        u.pm = fm + ((wgid % nig) % gsz); u.pn = (wgid % nig) / gsz; return true;
    }
};

template <class Epi>
__device__ __forceinline__ void gemm_phase(LAS unsigned char* lds, const Gemm g, const StaticOrder& S, const Epi& E) {
    const int tid = threadIdx.x, wid = __builtin_amdgcn_readfirstlane(tid >> 6), lane = tid & 63, wr = wid >> 2, wc = wid & 3, fr = lane & 15, fq = lane >> 4;
    const int K = g.K, nt = K / BK;
    unsigned voffA[2], voffB[2];
#pragma unroll
    for (int i = 0; i < 2; ++i) { int R, C; stage_rc(tid * 16 + i * 8192, R, C); const int Rb = Epi::PERM ? ((R & ~31) + perm32(R & 31)) : R;
        voffA[i] = (unsigned)(R * g.lda + C) * 2u; voffB[i] = (unsigned)(Rb * g.ldb + C) * 2u; }
    const size_t kstep = (size_t)(BK * 2);
    const size_t hsA = (size_t)HALF * g.lda * 2, hsB = (size_t)HALF * g.ldb * 2;
    const size_t tsA = 2 * hsA, tsB = 2 * hsB;
    const unsigned ldsw = (unsigned)wid * 1024u;
    const int aoff = lds_byte(wr * 64 + fr, fq * 8), boff = lds_byte(wc * 32 + fr, fq * 8);
#define PG8_SA(b, h) (((b) * 2 + (h)) * HTB)
#define PG8_SB(b, h) ((4 + (b) * 2 + (h)) * HTB)
#define PG8_STAGE(bufoff, gbase, voff) do { _Pragma("unroll") for (int _i = 0; _i < 2; ++_i) \
        __builtin_amdgcn_global_load_lds((const unsigned*)((const char*)(gbase) + (voff)[_i]), (LAS unsigned*)(lds + (bufoff) + ldsw + _i * 8192), 16, 0, 0); } while (0)
#define PG8_LDA(dst, b, h) do { _Pragma("unroll") for (int m = 0; m < 4; ++m) _Pragma("unroll") for (int k = 0; k < 2; ++k) dst[m][k] = *(const LAS bf16x8*)(lds + PG8_SA(b, h) + aoff + m * 2048 + k * 1024); } while (0)
#define PG8_LDB(dst, b, h) do { _Pragma("unroll") for (int n = 0; n < 2; ++n) _Pragma("unroll") for (int k = 0; k < 2; ++k) dst[n][k] = *(const LAS bf16x8*)(lds + PG8_SB(b, h) + boff + n * 2048 + k * 1024); } while (0)
#define PG8_MMA(ai, bj, At, Bt) do { __builtin_amdgcn_s_setprio(1); _Pragma("unroll") for (int m = 0; m < 4; ++m) _Pragma("unroll") for (int n = 0; n < 2; ++n) _Pragma("unroll") for (int k = 0; k < 2; ++k) \
        acc[ai][bj][m][n] = __builtin_amdgcn_mfma_f32_16x16x32_bf16(Bt[n][k], At[m][k], acc[ai][bj][m][n], 0, 0, 0); __builtin_amdgcn_s_setprio(0); } while (0)
#define PG8_WAIT_V(n) asm volatile("s_waitcnt vmcnt(" #n ")" ::: "memory")
#define PG8_WAIT_L(n) asm volatile("s_waitcnt lgkmcnt(" #n ")" ::: "memory")
#define PG8_BAR __builtin_amdgcn_s_barrier()
#define PG8_SCHED __builtin_amdgcn_sched_barrier(0)
#define PG8_APTR(u) ((const char*)g.A + (size_t)((u).pm & g.pm_mask) * tsA + (g.a_grp_div ? (size_t)((u).pn / g.a_grp_div) * (size_t)g.a_gstride : (size_t)0))
#define PG8_BPTR(u) ((const char*)g.Bt + (size_t)(u).pn * tsB)
    Unit cur, nxt; int ui = 0;
    if (!S.next(0, cur)) return;
    if (STAGGER_US > 0 && (S.c & 1)) { const unsigned long long t0_ = __builtin_amdgcn_s_memrealtime(), dl_ = (unsigned long long)(STAGGER_US * 100); while (__builtin_amdgcn_s_memrealtime() - t0_ < dl_) __builtin_amdgcn_s_sleep(8); }
    f32x4 acc[2][2][4][2];
#pragma unroll
    for (int a = 0; a < 2; ++a)
#pragma unroll
        for (int b = 0; b < 2; ++b)
#pragma unroll
            for (int m = 0; m < 4; ++m)
#pragma unroll
                for (int n = 0; n < 2; ++n) acc[a][b][m][n] = (f32x4){0.f, 0.f, 0.f, 0.f};
    bf16x8 At[4][2], B0[2][2], B1[2][2];
    const char* cA = PG8_APTR(cur); const char* cB = PG8_BPTR(cur);
    PG8_STAGE(PG8_SB(0, 0), cB, voffB); PG8_STAGE(PG8_SA(0, 0), cA, voffA); PG8_STAGE(PG8_SB(0, 1), cB + hsB, voffB); PG8_STAGE(PG8_SA(0, 1), cA + hsA, voffA);
    if (wr == 1) PG8_BAR;
    PG8_WAIT_V(4); PG8_BAR;
    PG8_STAGE(PG8_SB(1, 0), cB + kstep, voffB); PG8_STAGE(PG8_SA(1, 0), cA + kstep, voffA); PG8_STAGE(PG8_SB(1, 1), cB + hsB + kstep, voffB);
    PG8_WAIT_V(6); PG8_BAR;
    for (;;) {
        const bool has_next = S.next(ui + 1, nxt);
        const char* nA = has_next ? PG8_APTR(nxt) : cA; const char* nB = has_next ? PG8_BPTR(nxt) : cB;
        for (int t = 0; t < nt; t += 2) {
            const bool last = (t == nt - 2);
            const char* a1 = cA + (size_t)(t + 1) * kstep;
            const char* a2 = last ? nA : cA + (size_t)(t + 2) * kstep; const char* b2 = last ? nB : cB + (size_t)(t + 2) * kstep;
            const char* a3 = a2 + kstep; const char* b3 = b2 + kstep;
            PG8_LDB(B0, 0, 0); PG8_SCHED; PG8_LDA(At, 0, 0); PG8_STAGE(PG8_SA(1, 1), a1 + hsA, voffA);
            PG8_WAIT_L(8); PG8_BAR; PG8_WAIT_L(0); PG8_MMA(0, 0, At, B0); PG8_BAR; PG8_SCHED;
            PG8_LDB(B1, 0, 1); PG8_STAGE(PG8_SB(0, 0), b2, voffB);
            PG8_BAR; PG8_WAIT_L(0); PG8_MMA(0, 1, At, B1); PG8_BAR;
            PG8_LDA(At, 0, 1); PG8_STAGE(PG8_SA(0, 0), a2, voffA);
            PG8_BAR; PG8_WAIT_L(0); PG8_MMA(1, 0, At, B0); PG8_BAR; PG8_SCHED;
            PG8_STAGE(PG8_SB(0, 1), b2 + hsB, voffB);
            PG8_WAIT_V(6); PG8_BAR; PG8_MMA(1, 1, At, B1); PG8_BAR;
            PG8_LDB(B0, 1, 0); PG8_SCHED; PG8_LDA(At, 1, 0); PG8_STAGE(PG8_SA(0, 1), a2 + hsA, voffA);
            PG8_WAIT_L(8); PG8_BAR; PG8_WAIT_L(0); PG8_MMA(0, 0, At, B0); PG8_BAR; PG8_SCHED;
            PG8_LDB(B1, 1, 1); PG8_STAGE(PG8_SB(1, 0), b3, voffB);
            PG8_BAR; PG8_WAIT_L(0); PG8_MMA(0, 1, At, B1); PG8_BAR;
            PG8_LDA(At, 1, 1); PG8_STAGE(PG8_SA(1, 0), a3, voffA);
            PG8_BAR; PG8_WAIT_L(0); PG8_MMA(1, 0, At, B0); PG8_BAR; PG8_SCHED;
            PG8_STAGE(PG8_SB(1, 1), b3 + hsB, voffB);
            PG8_WAIT_V(6); PG8_BAR; PG8_MMA(1, 1, At, B1); PG8_BAR;
        }
        E(acc, cur, wr, wc, fr, fq);
        if (!has_next) break;
#pragma unroll
        for (int a = 0; a < 2; ++a)
#pragma unroll
            for (int b = 0; b < 2; ++b)
#pragma unroll
                for (int m = 0; m < 4; ++m)
#pragma unroll
                    for (int n = 0; n < 2; ++n) acc[a][b][m][n] = (f32x4){0.f, 0.f, 0.f, 0.f};
        cur = nxt; cA = nA; cB = nB; ++ui;
    }
    PG8_WAIT_V(0);
    if (wr == 0) PG8_BAR;
    PG8_BAR;
#undef PG8_SA
#undef PG8_SB
#undef PG8_STAGE
#undef PG8_LDA
#undef PG8_LDB
#undef PG8_MMA
#undef PG8_WAIT_V
#undef PG8_WAIT_L
#undef PG8_BAR
#undef PG8_SCHED
#undef PG8_APTR
#undef PG8_BPTR
}

struct EpiL0In {
    static constexpr bool PERM = true;
    bf16_t* U; bf16_t* SZ;
    __device__ __forceinline__ void operator()(const f32x4 (&acc)[2][2][4][2], const Unit& u, int wr, int wc, int fr, int fq) const {
        const int row0 = u.pm * BM + wr * 64 + fr; const bool isz = u.pn >= 8;
        bf16_t* base = isz ? SZ : U; const int col0 = (isz ? u.pn - 8 : u.pn) * BM + wc * 32 + 8 * fq;
#pragma unroll
        for (int ai = 0; ai < 2; ++ai)
#pragma unroll
            for (int m = 0; m < 4; ++m) { bf16_t* rowp = base + (size_t)(row0 + ai * HALF + m * 16) * 2048 + col0;
#pragma unroll
                for (int bj = 0; bj < 2; ++bj) { f32x4 v0 = acc[ai][bj][m][0], v1 = acc[ai][bj][m][1];
                    if (isz) {
#pragma unroll
                        for (int j = 0; j < 4; ++j) { v0[j] = silu_f(v0[j]); v1[j] = silu_f(v1[j]); } }
                    u32x4 w; w.x = cvt_pk_bf16_c(v0[0], v0[1]); w.y = cvt_pk_bf16_c(v0[2], v0[3]); w.z = cvt_pk_bf16_c(v1[0], v1[1]); w.w = cvt_pk_bf16_c(v1[2], v1[3]);
                    __builtin_nontemporal_store(w, (u32x4*)(rowp + bj * HALF)); } }
    }
};
struct EpiGrp {
    static constexpr bool PERM = true;
    bf16_t* YY; const bf16_t* SZ; const float* scale;
    __device__ __forceinline__ void operator()(const f32x4 (&acc)[2][2][4][2], const Unit& u, int wr, int wc, int fr, int fq) const {
        const int row0 = u.pm * BM + wr * 64 + fr; const int col0 = u.pn * BM + wc * 32 + 8 * fq;
        f32x4 sc[2][2];
#pragma unroll
        for (int bj = 0; bj < 2; ++bj) { sc[bj][0] = *(const f32x4*)(scale + col0 + bj * HALF); sc[bj][1] = *(const f32x4*)(scale + col0 + bj * HALF + 4); }
#pragma unroll
        for (int ai = 0; ai < 2; ++ai) {
            u32x4 zz[4][2];
#pragma unroll
            for (int m = 0; m < 4; ++m)
#pragma unroll
                for (int bj = 0; bj < 2; ++bj) zz[m][bj] = *(const u32x4*)(SZ + (size_t)(row0 + ai * HALF + m * 16) * 2048 + col0 + bj * HALF);
#pragma unroll
            for (int m = 0; m < 4; ++m) { const size_t off = (size_t)(row0 + ai * HALF + m * 16) * 2048 + col0;
#pragma unroll
                for (int bj = 0; bj < 2; ++bj) { float zf[8]; unpack8(zz[m][bj], zf);
                    const f32x4 v0 = acc[ai][bj][m][0] * sc[bj][0], v1 = acc[ai][bj][m][1] * sc[bj][1];
                    u32x4 w; w.x = cvt_pk_bf16_c(v0[0] * zf[0], v0[1] * zf[1]); w.y = cvt_pk_bf16_c(v0[2] * zf[2], v0[3] * zf[3]); w.z = cvt_pk_bf16_c(v1[0] * zf[4], v1[1] * zf[5]); w.w = cvt_pk_bf16_c(v1[2] * zf[6], v1[3] * zf[7]);
                    __builtin_nontemporal_store(w, (u32x4*)(YY + off + bj * HALF)); } } }
    }
};
template <bool BASE_BF16> struct EpiRes {
    static constexpr bool PERM = true;
    const float* base_lo; const float* base_hi; const bf16_t* base_b; bf16_t* OUT; const float* gate;
    __device__ __forceinline__ void operator()(const f32x4 (&acc)[2][2][4][2], const Unit& u, int wr, int wc, int fr, int fq) const {
        const int row0 = u.pm * BM + wr * 64 + fr, col0 = u.pn * BM + wc * 32 + 8 * fq;
#pragma unroll
        for (int ai = 0; ai < 2; ++ai) {
            const float* gp = gate + (size_t)seq_of_row(u.pm * BM + ai * HALF + wr * 64) * 3072 + col0;
            f32x4 gv[2][2];
#pragma unroll
            for (int bj = 0; bj < 2; ++bj) { gv[bj][0] = *(const f32x4*)(gp + bj * HALF); gv[bj][1] = *(const f32x4*)(gp + bj * HALF + 4); }
            u32x4 bb[4][2]; f32x4 fb[4][2][2];
            if (!BASE_BF16) {
#pragma unroll
                for (int m = 0; m < 4; ++m) { const int row = row0 + ai * HALF + m * 16; const float* bp = (row < TP ? base_lo + (size_t)row * 1024 : base_hi + (size_t)(row - TP) * 1024) + col0;
#pragma unroll
                    for (int bj = 0; bj < 2; ++bj) { fb[m][bj][0] = *(const f32x4*)(bp + bj * HALF); fb[m][bj][1] = *(const f32x4*)(bp + bj * HALF + 4); } } }
            if (BASE_BF16) {
#pragma unroll
                for (int m = 0; m < 4; ++m)
#pragma unroll
                    for (int bj = 0; bj < 2; ++bj) bb[m][bj] = *(const u32x4*)(base_b + (size_t)(row0 + ai * HALF + m * 16) * 1024 + col0 + bj * HALF); }
#pragma unroll
            for (int m = 0; m < 4; ++m) { const int row = row0 + ai * HALF + m * 16; bf16_t* op = OUT + (size_t)row * 1024 + col0;
#pragma unroll
                for (int bj = 0; bj < 2; ++bj) { float bs[8];
                    if (BASE_BF16) unpack8(bb[m][bj], bs);
                    else { const f32x4 b0 = fb[m][bj][0], b1 = fb[m][bj][1];
                        bs[0] = b0[0]; bs[1] = b0[1]; bs[2] = b0[2]; bs[3] = b0[3]; bs[4] = b1[0]; bs[5] = b1[1]; bs[6] = b1[2]; bs[7] = b1[3]; }
                    const f32x4 v0 = acc[ai][bj][m][0] * gv[bj][0], v1 = acc[ai][bj][m][1] * gv[bj][1];
                    u32x4 w; w.x = cvt_pk_bf16_c(bs[0] + v0[0], bs[1] + v0[1]); w.y = cvt_pk_bf16_c(bs[2] + v0[2], bs[3] + v0[3]); w.z = cvt_pk_bf16_c(bs[4] + v1[0], bs[5] + v1[1]); w.w = cvt_pk_bf16_c(bs[6] + v1[2], bs[7] + v1[3]);
                    __builtin_nontemporal_store(w, (u32x4*)(op + bj * HALF)); } } }
    }
};
struct EpiL1In {
    static constexpr bool PERM = true;
    bf16_t* QKV; bf16_t* STASH; float* AB;
    __device__ __forceinline__ void operator()(const f32x4 (&acc)[2][2][4][2], const Unit& u, int wr, int wc, int fr, int fq) const {
        const int row0 = u.pm * BM + wr * 64 + fr;
        if (u.pn < 16) {
            const int col0 = u.pn * BM + wc * 32 + 8 * fq;
#pragma unroll
            for (int ai = 0; ai < 2; ++ai)
#pragma unroll
                for (int m = 0; m < 4; ++m) { const int row = row0 + ai * HALF + m * 16; bf16_t* rowp = QKV + (size_t)row * 4096 + col0; const int rl = row & 63;
#pragma unroll
                    for (int bj = 0; bj < 2; ++bj) { const f32x4 v0 = acc[ai][bj][m][0], v1 = acc[ai][bj][m][1];
                        u32x4 w; w.x = cvt_pk_bf16_c(v0[0], v0[1]); w.y = cvt_pk_bf16_c(v0[2], v0[3]); w.z = cvt_pk_bf16_c(v1[0], v1[1]); w.w = cvt_pk_bf16_c(v1[2], v1[3]);
                        __builtin_nontemporal_store(w, (u32x4*)(rowp + bj * HALF));
                        if (rl >= 61) *(u32x4*)(STASH + ((size_t)(row >> 6) * 3 + (rl - 61)) * 4096 + col0 + bj * HALF) = w; } }
        } else if (wc == 0) {
#pragma unroll
            for (int ai = 0; ai < 2; ++ai)
#pragma unroll
                for (int m = 0; m < 4; ++m) { const int row = row0 + ai * HALF + m * 16; float* rowp = AB + (size_t)row * 32 + 8 * fq;
                    *(f32x4*)(rowp) = acc[ai][0][m][0]; *(f32x4*)(rowp + 4) = acc[ai][0][m][1]; }
        }
    }
};
struct EpiZ {
    static constexpr bool PERM = true;
    bf16_t* QKV;
    __device__ __forceinline__ void operator()(const f32x4 (&acc)[2][2][4][2], const Unit& u, int wr, int wc, int fr, int fq) const {
        const int row0 = u.pm * BM + wr * 64 + fr; const int col0 = 2048 + u.pn * BM + wc * 32 + 8 * fq;
#pragma unroll
        for (int ai = 0; ai < 2; ++ai) {
            u32x4 oo[4][2];
#pragma unroll
            for (int m = 0; m < 4; ++m)
#pragma unroll
                for (int bj = 0; bj < 2; ++bj) oo[m][bj] = *(const u32x4*)(QKV + (size_t)(row0 + ai * HALF + m * 16) * 4096 + col0 + bj * HALF);
#pragma unroll
            for (int m = 0; m < 4; ++m) { bf16_t* rowp = QKV + (size_t)(row0 + ai * HALF + m * 16) * 4096 + col0;
#pragma unroll
                for (int bj = 0; bj < 2; ++bj) { float of[8]; unpack8(oo[m][bj], of);
                    const f32x4 v0 = acc[ai][bj][m][0], v1 = acc[ai][bj][m][1];
                    u32x4 w; w.x = cvt_pk_bf16_c(of[0] * silu_f(v0[0]), of[1] * silu_f(v0[1])); w.y = cvt_pk_bf16_c(of[2] * silu_f(v0[2]), of[3] * silu_f(v0[3]));
                    w.z = cvt_pk_bf16_c(of[4] * silu_f(v1[0]), of[5] * silu_f(v1[1])); w.w = cvt_pk_bf16_c(of[6] * silu_f(v1[2]), of[7] * silu_f(v1[3]));
                    __builtin_nontemporal_store(w, (u32x4*)(rowp + bj * HALF)); } } }
    }
};
struct EpiNull {
    static constexpr bool PERM = true;
    float* sink;
    __device__ __forceinline__ void operator()(const f32x4 (&acc)[2][2][4][2], const Unit& u, int wr, int wc, int fr, int fq) const {
        float t = 0.f;
#pragma unroll
        for (int ai = 0; ai < 2; ++ai)
#pragma unroll
            for (int bj = 0; bj < 2; ++bj)
#pragma unroll
                for (int m = 0; m < 4; ++m)
#pragma unroll
                    for (int n = 0; n < 2; ++n) t += acc[ai][bj][m][n][0] + acc[ai][bj][m][n][1] + acc[ai][bj][m][n][2] + acc[ai][bj][m][n][3];
        if (t == 12345.678f) sink[0] = t;
    }
};
}

__device__ void transpose_tile(const float* src, int ld_src, int k0, int ncol0, int ncols_valid, bf16_t* dst, int ld_dst, int dst_row0, float* tile) {
    const int tid = threadIdx.x;
    { const int r = tid >> 4, c4 = (tid & 15) * 4;
#pragma unroll
        for (int i = 0; i < 2; ++i) { const int row = r + 32 * i; f32x4 v = (f32x4){0.f, 0.f, 0.f, 0.f};
            if (ncol0 + c4 < ncols_valid) v = *(const f32x4*)(src + (size_t)(k0 + row) * ld_src + ncol0 + c4);
            tile[row * 65 + c4 + 0] = v[0]; tile[row * 65 + c4 + 1] = v[1]; tile[row * 65 + c4 + 2] = v[2]; tile[row * 65 + c4 + 3] = v[3]; } }
    __syncthreads();
    { const int n = tid >> 3, k8 = (tid & 7) * 8; float f[8];
#pragma unroll
        for (int j = 0; j < 8; ++j) f[j] = tile[(k8 + j) * 65 + n];
        *(u32x4*)(dst + (size_t)(dst_row0 + n) * ld_dst + k0 + k8) = pack8(f); }
    __syncthreads();
}
__device__ void phase_prep(const Params& p, unsigned char* lds_g) {
    float* tile = (float*)lds_g;
    bf16_t* W1t = (bf16_t*)(p.ws + WS_W1T); bf16_t* Wgt = (bf16_t*)(p.ws + WS_WGT); bf16_t* W2t = (bf16_t*)(p.ws + WS_W2T); bf16_t* W3t = (bf16_t*)(p.ws + WS_W3T); bf16_t* W4t = (bf16_t*)(p.ws + WS_W4T);
    float* mod = (float*)(p.ws + WS_MOD);
    const int tid = threadIdx.x;
    constexpr int N_MOD = 256, N_W1 = 1024, N_WG = 256, N_W2 = 512, N_W3 = 1600, N_W4 = 512, N_ALL = N_MOD + N_W1 + N_WG + N_W2 + N_W3 + N_W4;
    for (int it = blockIdx.x; it < N_ALL; it += gridDim.x) {
        int i = it;
        if (i < N_MOD) {
            const int colchunk = i & 63, rg = i >> 6; const int cl = tid % 96, ksl = tid / 96; const int col = colchunk * 96 + cl, layer = col / 3072, cc = col % 3072;
            for (int idx = tid; idx < 12288; idx += NT) { const int k = idx / 12, r = idx % 12, row = rg * 12 + r;
                const float cv = row < 16 ? p.c_prompt[row * 1024 + k] : p.c_sample[(row - 16) * 1024 + k]; tile[idx] = silu_f(cv); }
            __syncthreads();
            float a[12];
#pragma unroll
            for (int r = 0; r < 12; ++r) a[r] = 0.f;
            if (ksl < 4) {
                const float* wp = p.ada_w + (size_t)layer * 1024 * 3072 + (size_t)(ksl * 256) * 3072 + cc; const float* tp = tile + ksl * 256 * 12;
#pragma unroll 16
                for (int k = 0; k < 256; ++k) { const float w = wp[(size_t)k * 3072]; const f32x4 s0 = *(const f32x4*)(tp + k * 12), s1 = *(const f32x4*)(tp + k * 12 + 4), s2 = *(const f32x4*)(tp + k * 12 + 8);
                    a[0] += w * s0[0]; a[1] += w * s0[1]; a[2] += w * s0[2]; a[3] += w * s0[3]; a[4] += w * s1[0]; a[5] += w * s1[1]; a[6] += w * s1[2]; a[7] += w * s1[3]; a[8] += w * s2[0]; a[9] += w * s2[1]; a[10] += w * s2[2]; a[11] += w * s2[3]; }
            }
            __syncthreads();
            if (ksl < 4) {
#pragma unroll
                for (int r = 0; r < 12; ++r) tile[(ksl * 12 + r) * 96 + cl] = a[r]; }
            __syncthreads();
            if (tid < 96) { const float bias = p.ada_b[layer * 3072 + cc];
#pragma unroll
                for (int r = 0; r < 12; ++r) mod[((size_t)layer * 48 + rg * 12 + r) * 3072 + cc] = tile[r * 96 + tid] + tile[(12 + r) * 96 + tid] + tile[(24 + r) * 96 + tid] + tile[(36 + r) * 96 + tid] + bias; }
            __syncthreads();
            continue;
        }
        i -= N_MOD;
        if (i < N_W1) { const int kt = i & 15, ntile = i >> 4; transpose_tile(p.pool_w_in, 4096, kt * 64, ntile * 64, 4096, W1t, 1024, ntile * 64, tile); continue; }
        i -= N_W1;
        if (i < N_WG) { const int g = i >> 6, r = i & 63, kt = r & 7, ntile = r >> 3; transpose_tile(p.pool_w_group + (size_t)g * 512 * 512, 512, kt * 64, ntile * 64, 512, Wgt + (size_t)g * 512 * 512, 512, ntile * 64, tile); continue; }
        i -= N_WG;
        if (i < N_W2) { const int kt = i & 31, ntile = i >> 5; transpose_tile(p.pool_w_out, 1024, kt * 64, ntile * 64, 1024, W2t, 2048, ntile * 64, tile); continue; }
        i -= N_W2;
        if (i < N_W3) { const int kt = i & 15, ntile = i >> 4; const int n0 = ntile * 64;
            const int src0 = n0 < 4096 ? n0 : (n0 < 4352 ? 6144 + (n0 - 4096) : 4096 + (n0 - 4352));
            const int valid = (n0 >= 4096 && n0 < 4352) ? 6176 : 1 << 30;
            transpose_tile(p.gdn_w_in, 6176, kt * 64, src0, valid, W3t, 1024, n0, tile); continue; }
        i -= N_W3;
        { const int kt = i & 31, ntile = i >> 5; transpose_tile(p.gdn_w_out, 1024, kt * 64, ntile * 64, 1024, W4t, 2048, ntile * 64, tile); }
    }
}

constexpr int NR = 6;
__device__ void phase_norm_mod(const float* x_lo, const float* x_hi, const float* gain, const float* modl, bf16_t* H) {
    const int lane = threadIdx.x & 63, wid = threadIdx.x >> 6;
    for (int rp = blockIdx.x * 8 + wid; rp < T / NR; rp += gridDim.x * 8) {
        f32x4 v[NR][4]; float ss[NR];
#pragma unroll
        for (int q = 0; q < NR; ++q) { const int row = rp * NR + q; const float* xr = row < TP ? x_lo + (size_t)row * 1024 : x_hi + (size_t)(row - TP) * 1024;
#pragma unroll
            for (int j = 0; j < 4; ++j) v[q][j] = __builtin_nontemporal_load((const f32x4*)(xr + j * 256 + lane * 4)); }
#pragma unroll
        for (int q = 0; q < NR; ++q) { float a = 0.f;
#pragma unroll
            for (int j = 0; j < 4; ++j) a += v[q][j][0] * v[q][j][0] + v[q][j][1] * v[q][j][1] + v[q][j][2] * v[q][j][2] + v[q][j][3] * v[q][j][3];
#pragma unroll
            for (int o = 32; o >= 1; o >>= 1) a += __shfl_xor(a, o);
            ss[q] = a; }
#pragma unroll
        for (int q = 0; q < NR; ++q) { const int row = rp * NR + q; const float r = rsqrtf(ss[q] * (1.0f / 1024.0f) + EPS);
            const float* ms = modl + (size_t)seq_of_row(row) * 3072;
#pragma unroll
            for (int j = 0; j < 4; ++j) { const int c = j * 256 + lane * 4; const f32x4 gn = *(const f32x4*)(gain + c), sh = *(const f32x4*)(ms + c), sc = *(const f32x4*)(ms + 1024 + c);
                const f32x4 o = v[q][j] * r * gn * (sc + 1.0f) + sh; u32x2 w; w.x = cvt_pk_bf16(o[0], o[1]); w.y = cvt_pk_bf16(o[2], o[3]); *(u32x2*)(H + (size_t)row * 1024 + c) = w; } }
    }
}
template <int MODE>
__device__ void phase_norm_b(const bf16_t* X, const float* gain, const float* modl, bf16_t* H, float* out) {
    constexpr int NRB = 8;
    const int lane = threadIdx.x & 63, wid = threadIdx.x >> 6;
    for (int rp = blockIdx.x * 8 + wid; rp < T / NRB; rp += gridDim.x * 8) {
        u32x4 raw[NRB][2]; float ss[NRB];
#pragma unroll
        for (int q = 0; q < NRB; ++q) { const bf16_t* xr = X + (size_t)(rp * NRB + q) * 1024;
#pragma unroll
            for (int j = 0; j < 2; ++j) raw[q][j] = __builtin_nontemporal_load((const u32x4*)(xr + j * 512 + lane * 8)); }
#pragma unroll
        for (int q = 0; q < NRB; ++q) { float a = 0.f;
#pragma unroll
            for (int j = 0; j < 2; ++j) { float f[8]; unpack8(raw[q][j], f);
#pragma unroll
                for (int e = 0; e < 8; ++e) a += f[e] * f[e]; }
#pragma unroll
            for (int o = 32; o >= 1; o >>= 1) a += __shfl_xor(a, o);
            ss[q] = a; }
#pragma unroll
        for (int q = 0; q < NRB; ++q) { const int row = rp * NRB + q; const float r = rsqrtf(ss[q] * (1.0f / 1024.0f) + EPS);
#pragma unroll
            for (int j = 0; j < 2; ++j) { const int c = j * 512 + lane * 8; float f[8], o[8]; unpack8(raw[q][j], f);
                const f32x4 g0 = *(const f32x4*)(gain + c), g1 = *(const f32x4*)(gain + c + 4);
                if (MODE == 0) { const float* ms = modl + (size_t)seq_of_row(row) * 3072; const f32x4 sh0 = *(const f32x4*)(ms + c), sh1 = *(const f32x4*)(ms + c + 4), sc0 = *(const f32x4*)(ms + 1024 + c), sc1 = *(const f32x4*)(ms + 1024 + c + 4);
#pragma unroll
                    for (int e = 0; e < 4; ++e) { o[e] = f[e] * r * g0[e] * (sc0[e] + 1.0f) + sh0[e]; o[4 + e] = f[4 + e] * r * g1[e] * (sc1[e] + 1.0f) + sh1[e]; }
                    *(u32x4*)(H + (size_t)row * 1024 + c) = pack8(o); }
                else { __builtin_nontemporal_store((f32x4){f[0] * r * g0[0], f[1] * r * g0[1], f[2] * r * g0[2], f[3] * r * g0[3]}, (f32x4*)(out + (size_t)row * 1024 + c));
                    __builtin_nontemporal_store((f32x4){f[4] * r * g1[0], f[5] * r * g1[1], f[6] * r * g1[2], f[7] * r * g1[3]}, (f32x4*)(out + (size_t)row * 1024 + c + 4)); } }
        }
    }
}

struct SeqInfo { int sq, lc, seq_t0; bool sample, last; };
__device__ __forceinline__ SeqInfo chunk_info(int chunk) { SeqInfo s; if (chunk < 1024) { s.sq = chunk >> 6; s.lc = chunk & 63; s.seq_t0 = s.sq * 4096; s.sample = false; s.last = (s.lc == 63); } else { const int cs = chunk - 1024; s.sq = 16 + cs; s.lc = 0; s.seq_t0 = TP + cs * 64; s.sample = true; s.last = true; } return s; }
__device__ __forceinline__ void pool_fetch(const bf16_t* U, const float* spool, const SeqInfo& si, int pos, int c, float (&f)[8]) {
    if (pos >= 0) { const u32x4 w = *(const u32x4*)(U + (size_t)(si.seq_t0 + pos) * 2048 + c); unpack8(w, f); }
    else if (si.sample) { const float* sp = spool + ((size_t)(si.sq - 16) * 15 + 15 + pos) * 2048 + c; const f32x4 a = *(const f32x4*)sp, b = *(const f32x4*)(sp + 4);
        f[0] = a[0]; f[1] = a[1]; f[2] = a[2]; f[3] = a[3]; f[4] = b[0]; f[5] = b[1]; f[6] = b[2]; f[7] = b[3]; }
    else {
#pragma unroll
        for (int j = 0; j < 8; ++j) f[j] = 0.f; }
}
template <int W>
__device__ __forceinline__ void pool_fast(const Params& p, const bf16_t* U, bf16_t* D, const SeqInfo& si, int g, int col8, int rs) {
    const int c = g * 512 + col8 * 8; const int p0 = si.lc * 64 + rs * 8;
    u32x4 raw[W + 7];
#pragma unroll
    for (int k = 0; k < W + 7; ++k) { const int pos = p0 - (W - 1) + k; raw[k] = pos >= 0 ? *(const u32x4*)(U + (size_t)(si.seq_t0 + pos) * 2048 + c) : (u32x4){0u, 0u, 0u, 0u}; }
    float s[8], cur[8], old[8];
#pragma unroll
    for (int j = 0; j < 8; ++j) s[j] = 0.f;
#pragma unroll
    for (int k = 0; k < W - 1; ++k) { unpack8(raw[k], cur);
#pragma unroll
        for (int j = 0; j < 8; ++j) s[j] += cur[j]; }
#pragma unroll
    for (int i = 0; i < 8; ++i) { const int pos = p0 + i; unpack8(raw[W - 1 + i], cur);
        if (i > 0) { unpack8(raw[i - 1], old);
#pragma unroll
            for (int j = 0; j < 8; ++j) s[j] -= old[j]; }
#pragma unroll
        for (int j = 0; j < 8; ++j) s[j] += cur[j];
        const float inv = 1.0f / fminf((float)(pos + 1), (float)W);
        float d[8];
#pragma unroll
        for (int j = 0; j < 8; ++j) d[j] = s[j] * inv - cur[j];
        *(u32x4*)(D + (size_t)(si.seq_t0 + pos) * 2048 + c) = pack8(d);
        const int rl = rs * 8 + i;
        if (si.last && rl >= 49) { float* op = p.out + O_POOL_P + ((size_t)si.sq * 15 + (rl - 49)) * 2048 + c;
            *(f32x4*)op = (f32x4){cur[0], cur[1], cur[2], cur[3]}; *(f32x4*)(op + 4) = (f32x4){cur[4], cur[5], cur[6], cur[7]}; }
    }
}
__device__ void phase_pool(const Params& p) {
    const bf16_t* U = (const bf16_t*)(p.ws + WS_R1); bf16_t* D = (bf16_t*)(p.ws + WS_R3);
    const int tid = threadIdx.x, col8 = tid & 63, rs = tid >> 6;
    for (int it = blockIdx.x; it < NCHUNK * 4; it += gridDim.x) {
        const int chunk = it >> 2, g = it & 3, w = 2 << g; const SeqInfo si = chunk_info(chunk);
        if (!si.sample) {
            if (g == 0) pool_fast<2>(p, U, D, si, g, col8, rs); else if (g == 1) pool_fast<4>(p, U, D, si, g, col8, rs); else if (g == 2) pool_fast<8>(p, U, D, si, g, col8, rs); else pool_fast<16>(p, U, D, si, g, col8, rs);
            continue;
        }
        const int c = g * 512 + col8 * 8; const int p0 = si.lc * 64 + rs * 8;
        float s[8], cur[8], old[8];
#pragma unroll
        for (int j = 0; j < 8; ++j) s[j] = 0.f;
        for (int q = p0 - w + 1; q < p0; ++q) { pool_fetch(U, p.state_pool, si, q, c, cur);
#pragma unroll
            for (int j = 0; j < 8; ++j) s[j] += cur[j]; }
#pragma unroll 1
        for (int i = 0; i < 8; ++i) { const int pos = p0 + i;
            pool_fetch(U, p.state_pool, si, pos, c, cur);
            if (i > 0) { pool_fetch(U, p.state_pool, si, pos - w, c, old);
#pragma unroll
                for (int j = 0; j < 8; ++j) s[j] -= old[j]; }
#pragma unroll
            for (int j = 0; j < 8; ++j) s[j] += cur[j];
            const float inv = 1.0f / (float)w;
            float d[8];
#pragma unroll
            for (int j = 0; j < 8; ++j) d[j] = s[j] * inv - cur[j];
            *(u32x4*)(D + (size_t)(si.seq_t0 + pos) * 2048 + c) = pack8(d);
            const int rl = rs * 8 + i;
            if (rl >= 49) { float* op = p.out + O_POOL_S + ((size_t)(si.sq - 16) * 15 + (rl - 49)) * 2048 + c;
                *(f32x4*)op = (f32x4){cur[0], cur[1], cur[2], cur[3]}; *(f32x4*)(op + 4) = (f32x4){cur[4], cur[5], cur[6], cur[7]}; }
        }
    }
}

__device__ void phase_conv(const Params& p) {
    bf16_t* QKV = (bf16_t*)(p.ws + WS_R1); const bf16_t* STASH = (const bf16_t*)(p.ws + WS_STASH); const float* AB = (const float*)(p.ws + WS_AB);
    float* GC = (float*)(p.ws + WS_GC); float* BETA = (float*)(p.ws + WS_BETA);
    const int tid = threadIdx.x, stream = tid >> 7, ct = tid & 127, lane = tid & 63, wid = tid >> 6;
    const int qt = blockIdx.x & 3;
    const int ch = qt * 1024 + ct * 8; const int r0 = stream * 16;
    float wv[4][8];
#pragma unroll
    for (int t = 0; t < 4; ++t) { const f32x4 a = *(const f32x4*)(p.gdn_conv_w + t * 4096 + ch), b = *(const f32x4*)(p.gdn_conv_w + t * 4096 + ch + 4);
        wv[t][0] = a[0]; wv[t][1] = a[1]; wv[t][2] = a[2]; wv[t][3] = a[3]; wv[t][4] = b[0]; wv[t][5] = b[1]; wv[t][6] = b[2]; wv[t][7] = b[3]; }
    u32x4 nx[16], nh[3];
#define CONV_LOADX(it_, lo_) do { const size_t t0_ = (size_t)((it_) >> 2) * 64; \
        _Pragma("unroll") for (int i_ = (lo_); i_ < (lo_) + 8; ++i_) nx[i_] = *(const u32x4*)(QKV + (t0_ + r0 + i_) * 4096 + ch); } while (0)
#define CONV_LOADH(it_) do { const int chunk_ = (it_) >> 2; const SeqInfo si_ = chunk_info(chunk_); const size_t t0_ = (size_t)chunk_ * 64; \
        if (stream > 0) { _Pragma("unroll") for (int j_ = 0; j_ < 3; ++j_) nh[j_] = *(const u32x4*)(QKV + (t0_ + r0 - 3 + j_) * 4096 + ch); } \
        else if (si_.lc > 0) { _Pragma("unroll") for (int j_ = 0; j_ < 3; ++j_) nh[j_] = *(const u32x4*)(STASH + ((size_t)(chunk_ - 1) * 3 + j_) * 4096 + ch); } \
        else { _Pragma("unroll") for (int j_ = 0; j_ < 3; ++j_) nh[j_] = (u32x4){0u, 0u, 0u, 0u}; } } while (0)
    if ((int)blockIdx.x < NCHUNK * 4) { CONV_LOADH((int)blockIdx.x); CONV_LOADX((int)blockIdx.x, 0); CONV_LOADX((int)blockIdx.x, 8); }
    for (int it = blockIdx.x; it < NCHUNK * 4; it += gridDim.x) {
        const int chunk = it >> 2; const SeqInfo si = chunk_info(chunk); const int t0 = chunk * 64;
        const int nit = it + (int)gridDim.x; const bool has_next = nit < NCHUNK * 4;
        __syncthreads();
        float h0[8], h1[8], h2[8];
        unpack8(nh[0], h0); unpack8(nh[1], h1); unpack8(nh[2], h2);
        if (stream == 0 && si.lc == 0 && si.sample) { const float* sp = p.state_conv + (size_t)(si.sq - 16) * 3 * 4096 + ch;
#pragma unroll
            for (int j = 0; j < 8; ++j) { h0[j] = sp[j]; h1[j] = sp[4096 + j]; h2[j] = sp[8192 + j]; } }
        if (has_next) CONV_LOADH(nit);
#pragma unroll
        for (int i = 0; i < 16; ++i) {
            bf16_t* rp = QKV + (size_t)(t0 + r0 + i) * 4096 + ch; float x[8], o[8]; unpack8(nx[i], x);
            float ss = 0.f;
#pragma unroll
            for (int j = 0; j < 8; ++j) { const float cv = wv[0][j] * h0[j] + wv[1][j] * h1[j] + wv[2][j] * h2[j] + wv[3][j] * x[j]; o[j] = silu_f(cv); ss += o[j] * o[j]; h0[j] = h1[j]; h1[j] = h2[j]; h2[j] = x[j]; }
            if (qt < 2) { ss = dpp_sum16(ss);
                const float sc = rsqrtf(ss + EPS) * (qt == 0 ? 0.08838834764831845f : 1.0f);
#pragma unroll
                for (int j = 0; j < 8; ++j) o[j] *= sc; }
            *(u32x4*)rp = pack8c(o);
            if (si.last && stream == 3 && i >= 13) { float* op = p.out + (si.sample ? O_CONV_S + ((size_t)(si.sq - 16) * 3 + (i - 13)) * 4096 : O_CONV_P + ((size_t)si.sq * 3 + (i - 13)) * 4096) + ch;
                *(f32x4*)op = (f32x4){x[0], x[1], x[2], x[3]}; *(f32x4*)(op + 4) = (f32x4){x[4], x[5], x[6], x[7]}; }
            if (i == 7 && has_next) CONV_LOADX(nit, 0);
            if (i == 15 && has_next) CONV_LOADX(nit, 8);
        }
        if (wid < 4) {
            { const int h = qt * 4 + wid; const float a = AB[(size_t)(t0 + lane) * 32 + h], b = AB[(size_t)(t0 + lane) * 32 + 16 + h];
                const float xx = a + p.gdn_dt_bias[h]; const float sp = xx > 20.f ? xx : log1pf(expf(xx)); float g = -expf(p.gdn_a_log[h]) * sp;
#pragma unroll
                for (int o = 1; o < 64; o <<= 1) { const float t = __shfl_up(g, o); if (lane >= o) g += t; }
                GC[((size_t)chunk * 16 + h) * 64 + lane] = g; BETA[((size_t)chunk * 16 + h) * 64 + lane] = 1.0f / (1.0f + expf(-b)); }
        }
    }
#undef CONV_LOADX
#undef CONV_LOADH
}

__device__ void phase_j1(const Params& p, unsigned char* lds_g) {
    const bf16_t* QKV = (const bf16_t*)(p.ws + WS_R1); const float* GC = (const float*)(p.ws + WS_GC); const float* BETA = (const float*)(p.ws + WS_BETA);
    bf16_t* AH = (bf16_t*)(p.out + O_Y); bf16_t* AQK = AH + (size_t)NCHUNK * 16 * 4096;
    const int lane = threadIdx.x & 63, wid = threadIdx.x >> 6, c = lane & 15, q4 = lane >> 4;
    LAS unsigned char* Wl = (LAS unsigned char*)lds_g + wid * 18432;
    LAS float* Ld = (LAS float*)Wl;
    LAS bf16_t* Lb = (LAS bf16_t*)(Wl + 5120);
    LAS bf16_t* TT = (LAS bf16_t*)(Wl + 5120 + 4992);
    LAS bf16_t* Dm = (LAS bf16_t*)(Wl + 5120 + 9984);
#define J1_SYNC() asm volatile("s_waitcnt lgkmcnt(0)" ::: "memory")
#define J1_A_L(i_, j_) ({ const u32x2 a_ = *(const LAS u32x2*)(Lb + (16 * ((i_) - 1) + c) * 52 + 16 * (j_) + 4 * q4); u32x4 w_; w_.x = a_.x; w_.y = a_.y; w_.z = 0u; w_.w = 0u; __builtin_bit_cast(bf16x8, w_); })
#define J1_A_D(i_) ({ const u32x2 a_ = *(const LAS u32x2*)(Dm + (((i_) - 1) * 16 + c) * 20 + 4 * q4); u32x4 w_; w_.x = a_.x; w_.y = a_.y; w_.z = 0u; w_.w = 0u; __builtin_bit_cast(bf16x8, w_); })
#define J1_B_T(kb_, nb_) ({ const u32x2 a_ = *(const LAS u32x2*)(TT + (16 * (nb_) + c) * 52 + 16 * (kb_) + 4 * q4); u32x4 w_; w_.x = a_.x; w_.y = a_.y; w_.z = 0u; w_.w = 0u; __builtin_bit_cast(bf16x8, w_); })
#define J1_B_ACC(w4_) ({ u32x4 w_; w_.x = cvt_pk_bf16_c((w4_)[0], (w4_)[1]); w_.y = cvt_pk_bf16_c((w4_)[2], (w4_)[3]); w_.z = 0u; w_.w = 0u; __builtin_bit_cast(bf16x8, w_); })
#define J1_MM(A_, B_, acc_) __builtin_amdgcn_mfma_f32_16x16x32_bf16(A_, B_, acc_, 0, 0, 0)
    const f32x4 z4 = (f32x4){0.f, 0.f, 0.f, 0.f};
    for (int wi = blockIdx.x * 8 + wid; wi < NCHUNK * 16; wi += gridDim.x * 8) {
        const int chunk = wi >> 4, h = wi & 15, hk = h >> 1; const size_t t0 = (size_t)chunk * 64;
        const bf16_t* kb = QKV + t0 * 4096 + 1024 + hk * 128; const bf16_t* qb = QKV + t0 * 4096 + hk * 128;
        const float* gcp = GC + (size_t)wi * 64; const float* btp = BETA + (size_t)wi * 64;
        bf16_t* ahb = AH + (size_t)wi * 4096;
        bf16x8 kf[4][4];
#pragma unroll
        for (int mt = 0; mt < 4; ++mt)
#pragma unroll
            for (int ks = 0; ks < 4; ++ks) kf[mt][ks] = *(const bf16x8*)(kb + (size_t)(16 * mt + c) * 4096 + 32 * ks + 8 * q4);
        float gcc[4], btc[4];
#pragma unroll
        for (int nt = 0; nt < 4; ++nt) { gcc[nt] = gcp[16 * nt + c]; btc[nt] = btp[16 * nt + c]; }
#pragma unroll
        for (int mt = 0; mt < 4; ++mt) {
            bf16x8 qf[4];
#pragma unroll
            for (int ks = 0; ks < 4; ++ks) qf[ks] = *(const bf16x8*)(qb + (size_t)(16 * mt + c) * 4096 + 32 * ks + 8 * q4);
            const f32x4 gcr = *(const f32x4*)(gcp + 16 * mt + 4 * q4), btr = *(const f32x4*)(btp + 16 * mt + 4 * q4);
#pragma unroll
            for (int nt = 0; nt < 4; ++nt) {
                bf16_t* aq = AQK + ((size_t)wi * 64 + 16 * mt + 4 * q4) * 64 + 16 * nt + c;
                if (nt <= mt) {
                    f32x4 kk = z4, qk = z4;
#pragma unroll
                    for (int ks = 0; ks < 4; ++ks) { kk = __builtin_amdgcn_mfma_f32_16x16x32_bf16(kf[mt][ks], kf[nt][ks], kk, 0, 0, 0); qk = __builtin_amdgcn_mfma_f32_16x16x32_bf16(qf[ks], kf[nt][ks], qk, 0, 0, 0); }
                    float lv[4];
#pragma unroll
                    for (int e = 0; e < 4; ++e) { const int i = 16 * mt + 4 * q4 + e, j = 16 * nt + c; const float dec = __expf(fminf(gcr[e] - gcc[nt], 0.f));
                        lv[e] = (i > j) ? btr[e] * kk[e] * dec : 0.f;
                        const float a = (i >= j) ? qk[e] * dec : 0.f; aq[e * 64] = (bf16_t)(cvt_pk_bf16_c(a, 0.f) & 0xffffu); }
                    if (nt == mt) {
#pragma unroll
                        for (int e = 0; e < 4; ++e) Ld[(mt * 16 + 4 * q4 + e) * 20 + c] = lv[e]; }
                    else {
#pragma unroll
                        for (int e = 0; e < 4; ++e) Lb[(16 * (mt - 1) + 4 * q4 + e) * 52 + 16 * nt + c] = (bf16_t)(cvt_pk_bf16_c(lv[e], 0.f) & 0xffffu); }
                } else {
#pragma unroll
                    for (int e = 0; e < 4; ++e) aq[e * 64] = (bf16_t)0;
                }
            }
        }
        { const int bz = lane >> 4; bf16_t* zr = ahb + lane * 64; const u32x4 z = (u32x4){0u, 0u, 0u, 0u};
#pragma unroll
          for (int bb = 1; bb < 4; ++bb) if (bb > bz) { *(u32x4*)(zr + 16 * bb) = z; *(u32x4*)(zr + 16 * bb + 8) = z; } }
        J1_SYNC();
        float t[16];
#pragma unroll
        for (int i = 0; i < 16; ++i) {
            float s0 = (c == i) ? 1.f : 0.f, s1 = 0.f, s2 = 0.f, s3 = 0.f;
#pragma unroll
            for (int j4 = 0; j4 < i; j4 += 4) { const f32x4 l = *(const LAS f32x4*)(Ld + (q4 * 16 + i) * 20 + j4);
                s0 -= l[0] * t[j4]; if (j4 + 1 < i) s1 -= l[1] * t[j4 + 1]; if (j4 + 2 < i) s2 -= l[2] * t[j4 + 2]; if (j4 + 3 < i) s3 -= l[3] * t[j4 + 3]; }
            t[i] = (s0 + s1) + (s2 + s3);
        }
        {
            const float bcol = btc[0] * (q4 == 0 ? 1.f : 0.f) + btc[1] * (q4 == 1 ? 1.f : 0.f) + btc[2] * (q4 == 2 ? 1.f : 0.f) + btc[3] * (q4 == 3 ? 1.f : 0.f);
            if (q4 < 3) {
#pragma unroll
                for (int i4 = 0; i4 < 4; ++i4) { u32x2 w; w.x = cvt_pk_bf16_c(t[4 * i4], t[4 * i4 + 1]); w.y = cvt_pk_bf16_c(t[4 * i4 + 2], t[4 * i4 + 3]); *(LAS u32x2*)(TT + (16 * q4 + c) * 52 + 16 * q4 + 4 * i4) = w; } }
            if (q4 > 0) {
#pragma unroll
                for (int i = 0; i < 16; ++i) Dm[((q4 - 1) * 16 + i) * 20 + c] = (bf16_t)(cvt_pk_bf16_c(t[i], 0.f) & 0xffffu); }
#pragma unroll
            for (int i = 0; i < 16; ++i) ahb[(16 * q4 + i) * 64 + 16 * q4 + c] = (bf16_t)(cvt_pk_bf16_c(t[i] * bcol, 0.f) & 0xffffu);
        }
        J1_SYNC();
#define J1_PUT(x4_, i_, j_, keep_) do { if (keep_) { u32x2 w_; w_.x = cvt_pk_bf16_c((x4_)[0], (x4_)[1]); w_.y = cvt_pk_bf16_c((x4_)[2], (x4_)[3]); *(LAS u32x2*)(TT + (16 * (j_) + c) * 52 + 16 * (i_) + 4 * q4) = w_; } \
        _Pragma("unroll") for (int e_ = 0; e_ < 4; ++e_) ahb[(16 * (i_) + 4 * q4 + e_) * 64 + 16 * (j_) + c] = (bf16_t)(cvt_pk_bf16_c((x4_)[e_] * btc[j_], 0.f) & 0xffffu); } while (0)
        {
            f32x4 w10 = J1_MM(J1_A_L(1, 0), J1_B_T(0, 0), z4), w21 = J1_MM(J1_A_L(2, 1), J1_B_T(1, 1), z4), w32 = J1_MM(J1_A_L(3, 2), J1_B_T(2, 2), z4);
            f32x4 t10 = -J1_MM(J1_A_D(1), J1_B_ACC(w10), z4), t21 = -J1_MM(J1_A_D(2), J1_B_ACC(w21), z4), t32 = -J1_MM(J1_A_D(3), J1_B_ACC(w32), z4);
            J1_PUT(t10, 1, 0, true); J1_PUT(t21, 2, 1, true); J1_PUT(t32, 3, 2, false);
            J1_SYNC();
            f32x4 w20 = J1_MM(J1_A_L(2, 0), J1_B_T(0, 0), z4); w20 = J1_MM(J1_A_L(2, 1), J1_B_T(1, 0), w20);
            f32x4 w31 = J1_MM(J1_A_L(3, 1), J1_B_T(1, 1), z4); w31 = J1_MM(J1_A_L(3, 2), J1_B_T(2, 1), w31);
            f32x4 t20 = -J1_MM(J1_A_D(2), J1_B_ACC(w20), z4), t31 = -J1_MM(J1_A_D(3), J1_B_ACC(w31), z4);
            J1_PUT(t20, 2, 0, true); J1_PUT(t31, 3, 1, false);
            J1_SYNC();
            f32x4 w30 = J1_MM(J1_A_L(3, 0), J1_B_T(0, 0), z4); w30 = J1_MM(J1_A_L(3, 1), J1_B_T(1, 0), w30); w30 = J1_MM(J1_A_L(3, 2), J1_B_T(2, 0), w30);
            f32x4 t30 = -J1_MM(J1_A_D(3), J1_B_ACC(w30), z4);
            J1_PUT(t30, 3, 0, false);
        }
        J1_SYNC();
    }
#undef J1_SYNC
#undef J1_A_L
#undef J1_A_D
#undef J1_B_T
#undef J1_B_ACC
#undef J1_MM
#undef J1_PUT
}

__device__ __forceinline__ bf16x8 pack_acc2(const f32x4 a, const f32x4 b) { u32x4 w; w.x = cvt_pk_bf16_c(a[0], a[1]); w.y = cvt_pk_bf16_c(a[2], a[3]); w.z = cvt_pk_bf16_c(b[0], b[1]); w.w = cvt_pk_bf16_c(b[2], b[3]); return __builtin_bit_cast(bf16x8, w); }
__device__ __forceinline__ bf16x8 ld_perm(const bf16_t* ptr) { const u32x2 a = *(const u32x2*)ptr, b = *(const u32x2*)(ptr + 16); u32x4 w; w.x = a.x; w.y = a.y; w.z = b.x; w.w = b.y; return __builtin_bit_cast(bf16x8, w); }
#define LDS_BARRIER() do { asm volatile("s_waitcnt lgkmcnt(0)" ::: "memory"); __builtin_amdgcn_s_barrier(); asm volatile("" ::: "memory"); } while (0)
__device__ void phase_j2(const Params& p, unsigned char* lds_g, bool dry) {
    bf16_t* QKV = (bf16_t*)(p.ws + WS_R1); const float* GC = (const float*)(p.ws + WS_GC);
    const bf16_t* AH = (const bf16_t*)(p.out + O_Y); const bf16_t* AQK = AH + (size_t)NCHUNK * 16 * 4096;
    const int tid = threadIdx.x, lane = tid & 63, w = tid >> 6, c = lane & 15, q4 = lane >> 4;
    constexpr int KN_OFF = 0, QN_OFF = 17408, KT_OFF = 34816, VT_OFF = 53248, AH_OFF = 71680, AQ_OFF = 80896, OS_OFF = 90112, SSQ_OFF = 107520;
    LAS unsigned char* L = (LAS unsigned char*)lds_g;
    LAS bf16_t* KT = (LAS bf16_t*)(L + KT_OFF); LAS bf16_t* VT = (LAS bf16_t*)(L + VT_OFF); LAS bf16_t* OS = (LAS bf16_t*)(L + OS_OFF);
    LAS float* SSQ = (LAS float*)(L + SSQ_OFF);
    const float nw = p.gdn_norm_w[16 * w + c];
    const int rowl = tid & 63, seg = tid >> 6;
    int par = 0;
    if (tid < 128) ((LAS float*)(L + 111616 + 1024))[tid] = 0.f;
    u32x4 rk0, rk1, rq0, rq1, rv0, rv1, ra, rqk; float ngate, ngl;
    LAS float* GEX = (LAS float*)(L + 111616);
    LAS float* SSQT = (LAS float*)(L + 111616 + 1024);
#define J2_LOAD(chunk_) do { const size_t t0_ = (size_t)(chunk_) * 64; const size_t ci_ = (size_t)(chunk_) * 16 + h; \
        const bf16_t* kb_ = QKV + (t0_ + rowl) * 4096 + 1024 + hk * 128 + seg * 16; const bf16_t* qb_ = QKV + (t0_ + rowl) * 4096 + hk * 128 + seg * 16; const bf16_t* vb_ = QKV + (t0_ + rowl) * 4096 + 2048 + h * 128 + seg * 16; \
        rk0 = *(const u32x4*)kb_; rk1 = *(const u32x4*)(kb_ + 8); rq0 = *(const u32x4*)qb_; rq1 = *(const u32x4*)(qb_ + 8); rv0 = *(const u32x4*)vb_; rv1 = *(const u32x4*)(vb_ + 8); \
        ra = *(const u32x4*)(AH + ci_ * 4096 + tid * 8); rqk = *(const u32x4*)(AQK + ci_ * 4096 + tid * 8); \
        ngate = GC[ci_ * 64 + rowl]; ngl = GC[ci_ * 64 + 63]; } while (0)
#define J2_STORE() do { *(LAS u32x4*)(L + KN_OFF + rowl * 272 + seg * 32) = rk0; *(LAS u32x4*)(L + KN_OFF + rowl * 272 + seg * 32 + 16) = rk1; \
        *(LAS u32x4*)(L + QN_OFF + rowl * 272 + seg * 32) = rq0; *(LAS u32x4*)(L + QN_OFF + rowl * 272 + seg * 32 + 16) = rq1; \
        { const unsigned kw_[8] = {rk0.x, rk0.y, rk0.z, rk0.w, rk1.x, rk1.y, rk1.z, rk1.w}; const unsigned vw_[8] = {rv0.x, rv0.y, rv0.z, rv0.w, rv1.x, rv1.y, rv1.z, rv1.w}; \
          _Pragma("unroll") for (int j_ = 0; j_ < 8; ++j_) { KT[(seg * 16 + 2 * j_) * 72 + rowl] = (bf16_t)(kw_[j_] & 0xffffu); KT[(seg * 16 + 2 * j_ + 1) * 72 + rowl] = (bf16_t)(kw_[j_] >> 16); \
              VT[(seg * 16 + 2 * j_) * 72 + rowl] = (bf16_t)(vw_[j_] & 0xffffu); VT[(seg * 16 + 2 * j_ + 1) * 72 + rowl] = (bf16_t)(vw_[j_] >> 16); } } \
        *(LAS u32x4*)(L + AH_OFF + (tid >> 3) * 144 + (tid & 7) * 16) = ra; *(LAS u32x4*)(L + AQ_OFF + (tid >> 3) * 144 + (tid & 7) * 16) = rqk; if (tid < 64) { GEX[tid] = __expf(ngate); GEX[64 + tid] = __expf(ngl - ngate); if (tid == 63) GEX[128] = __expf(ngl); } } while (0)
#define J2_FRAG(off_) ({ const u32x2 a_ = *(const LAS u32x2*)(L + (off_)); const u32x2 b_ = *(const LAS u32x2*)(L + (off_) + 32); u32x4 w_; w_.x = a_.x; w_.y = a_.y; w_.z = b_.x; w_.w = b_.y; __builtin_bit_cast(bf16x8, w_); })
    for (int it0 = blockIdx.x; it0 < 768; it0 += gridDim.x) {
        const int item = (gridDim.x == 256) ? ((it0 & ~255) | ((it0 & 7) << 5) | ((it0 & 255) >> 3)) : it0;
        int chunk0, nch, h; const float* s0 = nullptr; float* sout;
        if (item < 256) { const int b = item >> 4; h = item & 15; chunk0 = b * 64; nch = 64; sout = p.out + O_REC_P + ((size_t)b * 16 + h) * 16384; }
        else { const int b = (item - 256) >> 4; h = item & 15; chunk0 = 1024 + b; nch = 1; s0 = p.state_rec + ((size_t)b * 16 + h) * 16384; sout = p.out + O_REC_S + ((size_t)b * 16 + h) * 16384; }
        const int hk = h >> 1;
        f32x4 S[8];
        { int loff = (4 * q4) * 128 + 16 * w + c; asm volatile("" : "+v"(loff));
#pragma unroll
        for (int mt = 0; mt < 8; ++mt) {
            if (s0) {
#pragma unroll
                for (int e = 0; e < 4; ++e) S[mt][e] = s0[loff + (16 * mt + e) * 128]; }
            else S[mt] = (f32x4){0.f, 0.f, 0.f, 0.f};
        } }
        J2_LOAD(chunk0);
        LDS_BARRIER();
        J2_STORE();
        LDS_BARRIER();
        for (int n = 0; n < nch; ++n, par ^= 1) {
            const int chunk = chunk0 + n; const size_t t0 = (size_t)chunk * 64; const size_t ci = (size_t)chunk * 16 + h;
            const float egl = GEX[128];
            if (n + 1 < nch) J2_LOAD(chunk + 1);
            LAS float* ssq = SSQT + par * 64;
            bf16x8 Sb[4];
#pragma unroll
            for (int ks = 0; ks < 4; ++ks) Sb[ks] = pack_acc2(S[2 * ks], S[2 * ks + 1]);
#define J2_SB() __builtin_amdgcn_sched_barrier(0)
#define J2_LDKQ(dstk, dstq, mt_) do { _Pragma("unroll") for (int ks_ = 0; ks_ < 4; ++ks_) { const int o_ = (16 * (mt_) + c) * 272 + (32 * ks_ + 4 * q4) * 2; dstk[ks_] = J2_FRAG(KN_OFF + o_); dstq[ks_] = J2_FRAG(QN_OFF + o_); } } while (0)
#define J2_MMKQ(srck, srcq, mt_) do { _Pragma("unroll") for (int ks_ = 0; ks_ < 4; ++ks_) { P[mt_] = __builtin_amdgcn_mfma_f32_16x16x32_bf16(srck[ks_], Sb[ks_], P[mt_], 0, 0, 0); QS[mt_] = __builtin_amdgcn_mfma_f32_16x16x32_bf16(srcq[ks_], Sb[ks_], QS[mt_], 0, 0, 0); } } while (0)
            f32x4 P[4], QS[4];
#pragma unroll
            for (int mt = 0; mt < 4; ++mt) { P[mt] = (f32x4){0.f, 0.f, 0.f, 0.f}; QS[mt] = (f32x4){0.f, 0.f, 0.f, 0.f}; }
            bf16x8 ka[4], qa[4], kb2[4], qb2[4]; u32x2 vv[4];
            J2_LDKQ(ka, qa, 0); J2_LDKQ(kb2, qb2, 1);
            J2_SB(); J2_MMKQ(ka, qa, 0); J2_LDKQ(ka, qa, 2);
            J2_SB(); J2_MMKQ(kb2, qb2, 1); J2_LDKQ(kb2, qb2, 3);
            J2_SB(); J2_MMKQ(ka, qa, 2);
            bf16x8 ahf[4][2], aqf[4][2];
#pragma unroll
            for (int mt = 0; mt < 4; ++mt)
#pragma unroll
                for (int k2 = 0; k2 < 2; ++k2) ahf[mt][k2] = J2_FRAG(AH_OFF + (16 * mt + c) * 144 + (32 * k2 + 4 * q4) * 2);
            f32x4 egc[4];
#pragma unroll
            for (int mt = 0; mt < 4; ++mt) { egc[mt] = *(const LAS f32x4*)(GEX + 16 * mt + 4 * q4);
                vv[mt] = *(const LAS u32x2*)(L + VT_OFF + (16 * w + c) * 144 + (16 * mt + 4 * q4) * 2); }
            J2_SB(); J2_MMKQ(kb2, qb2, 3);
            J2_SB();
            f32x4 edl[4];
#pragma unroll
            for (int mt = 0; mt < 4; ++mt) edl[mt] = *(const LAS f32x4*)(GEX + 64 + 16 * mt + 4 * q4);
            f32x4 R[4];
#pragma unroll
            for (int mt = 0; mt < 4; ++mt) { R[mt][0] = bf_lo(vv[mt].x) - egc[mt][0] * P[mt][0]; R[mt][1] = bf_hi(vv[mt].x) - egc[mt][1] * P[mt][1]; R[mt][2] = bf_lo(vv[mt].y) - egc[mt][2] * P[mt][2]; R[mt][3] = bf_hi(vv[mt].y) - egc[mt][3] * P[mt][3]; }
            bf16x8 Rb[2];
#pragma unroll
            for (int k2 = 0; k2 < 2; ++k2) Rb[k2] = pack_acc2(R[2 * k2], R[2 * k2 + 1]);
            J2_SB();
            f32x4 Vn[4];
#pragma unroll
            for (int mt = 0; mt < 4; ++mt) { Vn[mt] = (f32x4){0.f, 0.f, 0.f, 0.f};
#pragma unroll
                for (int k2 = 0; k2 < 2; ++k2) Vn[mt] = __builtin_amdgcn_mfma_f32_16x16x32_bf16(ahf[mt][k2], Rb[k2], Vn[mt], 0, 0, 0); }
            J2_SB();
#pragma unroll
            for (int mt = 0; mt < 4; ++mt)
#pragma unroll
                for (int k2 = 0; k2 < 2; ++k2) aqf[mt][k2] = J2_FRAG(AQ_OFF + (16 * mt + c) * 144 + (32 * k2 + 4 * q4) * 2);
            bf16x8 ktf[4][2];
#pragma unroll
            for (int mt = 0; mt < 4; ++mt)
#pragma unroll
                for (int k2 = 0; k2 < 2; ++k2) ktf[mt][k2] = J2_FRAG(KT_OFF + (16 * mt + c) * 144 + (32 * k2 + 4 * q4) * 2);
            bf16x8 Vb[2], Vsb[2];
#pragma unroll
            for (int k2 = 0; k2 < 2; ++k2) { Vb[k2] = pack_acc2(Vn[2 * k2], Vn[2 * k2 + 1]); Vsb[k2] = pack_acc2(Vn[2 * k2] * edl[2 * k2], Vn[2 * k2 + 1] * edl[2 * k2 + 1]); }
            J2_SB();
            f32x4 O[4];
#pragma unroll
            for (int mt = 0; mt < 4; ++mt) { O[mt] = QS[mt] * egc[mt];
#pragma unroll
                for (int k2 = 0; k2 < 2; ++k2) O[mt] = __builtin_amdgcn_mfma_f32_16x16x32_bf16(aqf[mt][k2], Vb[k2], O[mt], 0, 0, 0); }
            J2_SB();
#pragma unroll
            for (int mt = 0; mt < 4; ++mt) { S[mt] = S[mt] * egl;
#pragma unroll
                for (int k2 = 0; k2 < 2; ++k2) S[mt] = __builtin_amdgcn_mfma_f32_16x16x32_bf16(ktf[mt][k2], Vsb[k2], S[mt], 0, 0, 0); }
            J2_SB();
#pragma unroll
            for (int mt = 0; mt < 4; ++mt)
#pragma unroll
                for (int k2 = 0; k2 < 2; ++k2) ktf[mt][k2] = J2_FRAG(KT_OFF + (16 * (mt + 4) + c) * 144 + (32 * k2 + 4 * q4) * 2);
#pragma unroll
            for (int mt = 0; mt < 4; ++mt) { f32x4 sq = O[mt] * O[mt]; sq[0] = dpp_sum16(sq[0]); sq[1] = dpp_sum16(sq[1]); sq[2] = dpp_sum16(sq[2]); sq[3] = dpp_sum16(sq[3]);
                if (c == 0) {
#pragma unroll
                    for (int e = 0; e < 4; ++e) __hip_atomic_fetch_add(ssq + 16 * mt + 4 * q4 + e, sq[e], __ATOMIC_RELAXED, __HIP_MEMORY_SCOPE_WORKGROUP); } }
            J2_SB();
#pragma unroll
            for (int mt = 0; mt < 4; ++mt) { S[mt + 4] = S[mt + 4] * egl;
#pragma unroll
                for (int k2 = 0; k2 < 2; ++k2) S[mt + 4] = __builtin_amdgcn_mfma_f32_16x16x32_bf16(ktf[mt][k2], Vsb[k2], S[mt + 4], 0, 0, 0); }
#undef J2_SB
#undef J2_LDKQ
#undef J2_MMKQ
            LDS_BARRIER();
#pragma unroll
            for (int mt = 0; mt < 4; ++mt) { const f32x4 tot = *(const LAS f32x4*)(ssq + 16 * mt + 4 * q4);
#pragma unroll
                for (int e = 0; e < 4; ++e) { const float r = rsqrtf(tot[e] * (1.0f / 128.0f) + EPS); OS[(16 * mt + 4 * q4 + e) * 136 + 16 * w + c] = (bf16_t)(cvt_pk_bf16_c(O[mt][e] * r * nw, 0.f) & 0xffffu); } }
            LDS_BARRIER();
            { const int row = tid >> 3, s8 = tid & 7; const u32x4 o0 = *(const LAS u32x4*)(L + OS_OFF + row * 272 + s8 * 32), o1 = *(const LAS u32x4*)(L + OS_OFF + row * 272 + s8 * 32 + 16);
              bf16_t* op = QKV + (t0 + row) * 4096 + 2048 + h * 128 + s8 * 16; if (!dry) { *(u32x4*)op = o0; *(u32x4*)(op + 8) = o1; } }
            if (n + 1 < nch) J2_STORE();
            if (tid < 64) SSQT[(par ^ 1) * 64 + tid] = 0.f;
            LDS_BARRIER();
        }
        { int loff = (4 * q4) * 128 + 16 * w + c; asm volatile("" : "+v"(loff));
#pragma unroll
        for (int mt = 0; mt < 8; ++mt)
#pragma unroll
            for (int e = 0; e < 4; ++e) if (!dry) sout[loff + (16 * mt + e) * 128] = S[mt][e]; }
    }
#undef J2_LOAD
#undef J2_STORE
#undef J2_FRAG
}


#define XB_TMO      128
#define XB_XCNT(j)  (256  + 64 * (j))
#define XB_XSUB(j)  (1280 + 64 * (j))
#define XB_XGEN(j)  (2304 + 64 * (j))
#define XB_TOP      3328
#define XB_TOPGEN   3392
#define XCD_BAR_WORDS 3456
#define XB_SPIN_CAP (1u << 18)
__device__ __forceinline__ unsigned xb_ld(unsigned* p)              { return __hip_atomic_load(p, __ATOMIC_RELAXED, __HIP_MEMORY_SCOPE_AGENT); }
__device__ __forceinline__ unsigned xb_add(unsigned* p, unsigned v) { return __hip_atomic_fetch_add(p, v, __ATOMIC_RELAXED, __HIP_MEMORY_SCOPE_AGENT); }
__device__ __forceinline__ unsigned xb_xcc_id() { return (unsigned)__builtin_amdgcn_s_getreg((3 << 11) | 20) & 0xFu; }
#define XB_SPIN(cond, bar) do { unsigned _sp = 0; while (cond) { __builtin_amdgcn_s_sleep(1); \
    if ((++_sp & 255u) == 0u) { if (xb_ld(&(bar)[XB_TMO])) break; if (_sp > XB_SPIN_CAP) { atomicAdd(&(bar)[XB_TMO], 1u); break; } } } } while (0)
struct XcdBarrier { unsigned* bar; unsigned x; volatile LAS unsigned* st; };
__device__ __forceinline__ XcdBarrier xcd_barrier_post(unsigned* bar, volatile LAS unsigned* st) {
    XcdBarrier b; b.bar = bar; b.x = xb_xcc_id(); b.st = st;
    if (threadIdx.x == 0) (void)xb_add(&bar[XB_XCNT(b.x)], 1u);
    return b;
}
__device__ __forceinline__ void xcd_barrier_complete(unsigned* bar, unsigned x, unsigned& nloc, unsigned& nx) {
    const unsigned G = gridDim.x * gridDim.y * gridDim.z;
    unsigned sum, cnt, mine, sp = 0u;
    for (;;) {
        sum = 0u; cnt = 0u; mine = 0u;
#pragma unroll
        for (unsigned j = 0; j < 16; ++j) { const unsigned c = xb_ld(&bar[XB_XCNT(j)]); sum += c; cnt += (c > 0u) ? 1u : 0u; mine = (j == x) ? c : mine; }
        if (sum == G) break;
        __builtin_amdgcn_s_sleep(1);
        if ((++sp & 255u) == 0u) { if (xb_ld(&bar[XB_TMO])) break; if (sp > XB_SPIN_CAP) { atomicAdd(&bar[XB_TMO], 1u); break; } }
    }
    nloc = mine > 0u ? mine : 1u; nx = cnt > 0u ? cnt : 1u;
}
__device__ __forceinline__ void xcd_barrier(const XcdBarrier& b) {
    asm volatile("s_waitcnt vmcnt(0)" ::: "memory");
    __syncthreads();
    if (threadIdx.x == 0) {
        unsigned* bar = b.bar;
        __builtin_amdgcn_s_waitcnt(0);
        unsigned nloc = b.st[0], nx = b.st[1];
        if (nloc == 0u) { xcd_barrier_complete(bar, b.x, nloc, nx); b.st[0] = nloc; b.st[1] = nx; }
        const unsigned old = xb_add(&bar[XB_XSUB(b.x)], 1u);
        const unsigned gen = old / nloc;
        if (old + 1u == (gen + 1u) * nloc) {
            __builtin_amdgcn_fence(__ATOMIC_RELEASE, "agent");
            asm volatile("s_waitcnt vmcnt(0)" ::: "memory");
            const unsigned og = xb_add(&bar[XB_TOP], 1u);
            const unsigned tg = og / nx;
            if (og + 1u == (tg + 1u) * nx) xb_add(&bar[XB_TOPGEN], 1u);
            else XB_SPIN(xb_ld(&bar[XB_TOPGEN]) == tg, bar);
            __builtin_amdgcn_fence(__ATOMIC_ACQUIRE, "agent");
            xb_add(&bar[XB_XGEN(b.x)], 1u);
            asm volatile("s_waitcnt vmcnt(0)" ::: "memory");
        } else {
            XB_SPIN(xb_ld(&bar[XB_XGEN(b.x)]) == gen, bar);
            __builtin_amdgcn_fence(__ATOMIC_ACQUIRE, "agent");
            asm volatile("s_waitcnt vmcnt(0)" ::: "memory");
        }
    }
    __syncthreads();
}

constexpr int N_PHASES = 14;
#ifndef PH_MASK
#define PH_MASK 0x3fff
#endif
#define PH_ON(n) (((PH_MASK) >> (n)) & 1)
#ifndef REP_MASK
#define REP_MASK 0
#endif
#define REP_ON(n) (((REP_MASK) >> (n)) & 1)
__global__ void __launch_bounds__(NT, 2) mega(Params p, int ph_lo, int ph_hi, int rep_mask) {
    extern __shared__ __attribute__((aligned(16))) unsigned char lds[];
    LAS unsigned char* ldsl = (LAS unsigned char*)lds;
    cg::grid_group grid = cg::this_grid();
    unsigned char* ws = p.ws;
    bf16_t* W1t = (bf16_t*)(ws + WS_W1T); bf16_t* Wgt = (bf16_t*)(ws + WS_WGT); bf16_t* W2t = (bf16_t*)(ws + WS_W2T); bf16_t* W3t = (bf16_t*)(ws + WS_W3T); bf16_t* W4t = (bf16_t*)(ws + WS_W4T);
    float* mod = (float*)(ws + WS_MOD); bf16_t* H = (bf16_t*)(ws + WS_H); bf16_t* R1 = (bf16_t*)(ws + WS_R1); bf16_t* R2 = (bf16_t*)(ws + WS_R2); bf16_t* R3 = (bf16_t*)(ws + WS_R3);
    bf16_t* X1b = (bf16_t*)(ws + WS_R3);
    const int G = gridDim.x, bid = blockIdx.x;
    volatile LAS unsigned* xst = (volatile LAS unsigned*)(ldsl + LDS_BYTES - 16);
    if (threadIdx.x == 0) { xst[0] = 0u; xst[1] = 0u; }
    __syncthreads();
    const XcdBarrier xb = xcd_barrier_post((unsigned*)(ws + WS_BAR), xst);
#define IN(k) (ph_lo <= (k) && (k) < ph_hi)
#define SEAM(k) do { if (IN(k) && IN((k) + 1)) { if (ph_lo < 0) grid.sync(); else xcd_barrier(xb); } } while (0)
    if (PH_ON(0) && IN(0)) { phase_prep(p, lds); }
    SEAM(0);
    if (PH_ON(1) && IN(1)) { phase_norm_mod(p.x_prompt, p.x_sample, p.norm_gain, mod, H); }
    SEAM(1);
    if (PH_ON(2) && IN(2)) { { pg8::Gemm g{H, W1t, T, 4096, 1024, 1024, 1024, 0, 0}; pg8::StaticOrder S; S.init(T, 4096, G, bid); pg8::EpiL0In E{R1, R2}; pg8::gemm_phase(ldsl, g, S, E); } }
    SEAM(2);
    if (PH_ON(3) && IN(3)) { phase_pool(p); }
    SEAM(3);
    if (PH_ON(4) && IN(4)) { { pg8::Gemm g{R3, Wgt, T, 2048, 512, 2048, 512, 2, 1024}; pg8::StaticOrder S; S.init(T, 2048, G, bid); pg8::EpiGrp E{R1, R2, p.pool_scale}; pg8::gemm_phase(ldsl, g, S, E); } }
    SEAM(4);
    if (PH_ON(5) && IN(5)) { { pg8::Gemm g{R1, W2t, T, 1024, 2048, 2048, 2048, 0, 0}; pg8::StaticOrder S; S.init(T, 1024, G, bid); pg8::EpiRes<false> E{p.x_prompt, p.x_sample, nullptr, X1b, mod + 2048}; pg8::gemm_phase(ldsl, g, S, E); } }
    SEAM(5);
    if (PH_ON(6) && IN(6)) { phase_norm_b<0>(X1b, p.norm_gain + 1024, mod + 48 * 3072, H, nullptr); }
    SEAM(6);
    if (PH_ON(7) && IN(7)) { { pg8::Gemm g{H, W3t, T, 4352, 1024, 1024, 1024, 0, 0}; pg8::StaticOrder S; S.init(T, 4352, G, bid); pg8::EpiL1In E{R1, (bf16_t*)(ws + WS_STASH), (float*)(ws + WS_AB)}; pg8::gemm_phase(ldsl, g, S, E); } }
    SEAM(7);
    if (PH_ON(8) && IN(8)) { phase_conv(p); }
    SEAM(8);
    if (PH_ON(9) && IN(9)) { phase_j1(p, lds); }
    SEAM(9);
    if (PH_ON(10) && IN(10)) { phase_j2(p, lds, false); }
    SEAM(10);
    if (PH_ON(11) && IN(11)) { { pg8::Gemm g{H, W3t + (size_t)4352 * 1024, T, 2048, 1024, 1024, 1024, 0, 0}; pg8::StaticOrder S; S.init(T, 2048, G, bid); pg8::EpiZ E{R1}; pg8::gemm_phase(ldsl, g, S, E); } }
    SEAM(11);
    if (PH_ON(12) && IN(12)) { { pg8::Gemm g{R1 + 2048, W4t, T, 1024, 2048, 4096, 2048, 0, 0}; pg8::StaticOrder S; S.init(T, 1024, G, bid); pg8::EpiRes<true> E{nullptr, nullptr, X1b, X1b, mod + 48 * 3072 + 2048}; pg8::gemm_phase(ldsl, g, S, E); } }
    SEAM(12);
    if (PH_ON(13) && IN(13)) { phase_norm_b<1>(X1b, p.final_gain, nullptr, nullptr, p.out + O_Y); }
    SEAM(13);
#undef IN
#undef SEAM
}

#ifndef MK_ONE_LAUNCH
#define MK_ONE_LAUNCH 1
#endif
extern "C" void kernel_launch(void* const* d_in, const int* in_sizes, int n_in, void* d_out, int out_size, void* d_ws, size_t ws_size, hipStream_t stream) {
    static int grid = 0;
    if (grid == 0) {
        if (ws_size < WS_END) { fprintf(stderr, "kernel_launch: workspace too small: %zu < %zu\n", ws_size, (size_t)WS_END); grid = -1; return; }
        int dev = 0, cus = 0, per_cu = 0;
        hipGetDevice(&dev); hipDeviceGetAttribute(&cus, hipDeviceAttributeMultiprocessorCount, dev);
        if (hipFuncSetAttribute((const void*)mega, hipFuncAttributeMaxDynamicSharedMemorySize, LDS_BYTES) != hipSuccess) { fprintf(stderr, "kernel_launch: hipFuncSetAttribute failed\n"); grid = -1; return; }
        if (hipOccupancyMaxActiveBlocksPerMultiprocessor(&per_cu, (const void*)mega, NT, LDS_BYTES) != hipSuccess || per_cu < 1) { fprintf(stderr, "kernel_launch: occupancy query gave %d\n", per_cu); per_cu = 1; }
        (void)hipGetLastError();
        grid = (cus * per_cu) & ~3;
    }
    if (grid < 0) return;
    Params p{};
    p.x_prompt = (const float*)d_in[0]; p.x_sample = (const float*)d_in[1]; p.c_prompt = (const float*)d_in[2]; p.c_sample = (const float*)d_in[3];
    p.state_pool = (const float*)d_in[4]; p.state_conv = (const float*)d_in[5]; p.state_rec = (const float*)d_in[6];
    p.norm_gain = (const float*)d_in[7]; p.ada_w = (const float*)d_in[8]; p.ada_b = (const float*)d_in[9];
    p.pool_w_in = (const float*)d_in[10]; p.pool_w_group = (const float*)d_in[11]; p.pool_scale = (const float*)d_in[12]; p.pool_w_out = (const float*)d_in[13];
    p.gdn_w_in = (const float*)d_in[14]; p.gdn_conv_w = (const float*)d_in[15]; p.gdn_a_log = (const float*)d_in[16]; p.gdn_dt_bias = (const float*)d_in[17]; p.gdn_norm_w = (const float*)d_in[18]; p.gdn_w_out = (const float*)d_in[19];
    p.final_gain = (const float*)d_in[20];
    p.out = (float*)d_out; p.ws = (unsigned char*)d_ws;
    if (hipMemsetAsync((unsigned char*)d_ws + WS_BAR, 0, 16384, stream) != hipSuccess) { fprintf(stderr, "kernel_launch: memset of barrier words failed\n"); return; }
#if MK_ONE_LAUNCH
    int lo = 0, hi = N_PHASES, rep = REP_MASK; void* args[] = {&p, &lo, &hi, &rep};
    hipError_t e = hipLaunchCooperativeKernel((const void*)mega, dim3(grid), dim3(NT), args, LDS_BYTES, stream);
    if (e != hipSuccess) fprintf(stderr, "cooperative launch failed: %s (grid %d)\n", hipGetErrorString(e), grid);
#else
    for (int ph = 0; ph < N_PHASES; ++ph) { hipLaunchKernelGGL(mega, dim3(grid), dim3(NT), LDS_BYTES, stream, p, ph, ph + 1, 0); }
#endif
}
```
